# Optimizing an MI355X kernel written in HIP

```python
import math
import jax, jax.numpy as jnp
from jax import lax
import numpy as np

D_MODEL = 2048
BATCH = 4
SEQ = 4096
DEPTH = 4

WIDTH_A = D_MODEL // 4
WIDTH_B = D_MODEL // 2
WIDTH_C = D_MODEL // 4
MIX_WIDTH = WIDTH_A + WIDTH_B + WIDTH_C
CHUNK = 128
GROUP_A = 128
N_GROUPS_A = WIDTH_A // GROUP_A
DIFF_HEAD_DIM = 64
V_HEAD_DIM = 2 * DIFF_HEAD_DIM
N_HEADS_B = WIDTH_B // V_HEAD_DIM
Q_BLOCK = 128
CONV_WIDTH = 3
N_GROUPS_C = WIDTH_C // 128
D_FF = ((8 * D_MODEL // 3 + 255) // 256) * 256
EPS = 1e-6

SPLIT_SIZES = [WIDTH_A, WIDTH_A,
               WIDTH_B, WIDTH_B, WIDTH_B,
               WIDTH_C, WIDTH_C, WIDTH_C]
IN_COLS = sum(SPLIT_SIZES)

kernel_name = "hybrid_gmlp_diffattn_shortconv_macaron"


def rms_norm(x, g):
    xf = x.astype(jnp.float32)
    y = xf * lax.rsqrt(jnp.mean(xf * xf, axis=-1, keepdims=True) + EPS)
    return (y * g.astype(jnp.float32)).astype(x.dtype)


def swiglu(h, w_gate, w_up, w_down):
    return (jax.nn.silu(h @ w_gate) * (h @ w_up)) @ w_down


def alibi_slopes(n_heads):
    return jnp.exp2(-8.0 * jnp.arange(1, n_heads + 1, dtype=jnp.float32) / n_heads)


def spatial_gating(u, v, g_v, w_s, b_s):
    bsz, s_len, _ = u.shape
    v = rms_norm(v, g_v)
    vc = v.reshape(bsz, s_len // CHUNK, CHUNK, N_GROUPS_A, GROUP_A)
    causal = jnp.tril(jnp.ones((CHUNK, CHUNK), dtype=bool))
    ws = jnp.where(causal[None], w_s, jnp.zeros_like(w_s))
    mixed = jnp.einsum('gts,bnsgc->bntgc', ws, vc) + b_s.T[None, None, :, :, None]
    return u * mixed.reshape(bsz, s_len, WIDTH_A)


def diff_attention(q, k, v, lam, g_sub, lambda_init):
    bsz, s_len, _ = q.shape
    nb = s_len // Q_BLOCK
    scale = DIFF_HEAD_DIM ** -0.5
    qb = q.reshape(bsz, nb, Q_BLOCK, N_HEADS_B, 2, DIFF_HEAD_DIM).transpose(1, 0, 3, 4, 2, 5)
    k = k.reshape(bsz, s_len, N_HEADS_B, 2, DIFF_HEAD_DIM)
    v = v.reshape(bsz, s_len, N_HEADS_B, V_HEAD_DIM)
    slopes = alibi_slopes(N_HEADS_B)
    kpos = jnp.arange(s_len)

    def block(args):
        q_blk, start = args
        s = jnp.einsum('bhmqd,bkhmd->bhmqk', q_blk, k).astype(jnp.float32) * scale
        dist = (start + jnp.arange(Q_BLOCK))[:, None] - kpos[None, :]
        bias = -slopes[:, None, None] * dist.astype(jnp.float32)
        s = jnp.where((dist >= 0)[None, None, None], s + bias[None, :, None], -jnp.inf)
        p = jax.nn.softmax(s, axis=-1)
        a = p[:, :, 0] - lam * p[:, :, 1]
        return jnp.einsum('bhqk,bkhe->bqhe', a.astype(v.dtype), v)

    starts = jnp.arange(nb) * Q_BLOCK
    out = lax.map(block, (qb, starts))
    out = out.transpose(1, 0, 2, 3, 4).reshape(bsz, s_len, N_HEADS_B, V_HEAD_DIM)
    out = rms_norm(out, g_sub) * (1.0 - lambda_init)
    return out.reshape(bsz, s_len, WIDTH_B)


def short_gated_conv(b_gate, c_gate, x_c, w_conv):
    s_len = x_c.shape[1]
    z = c_gate * x_c
    zp = jnp.pad(z, ((0, 0), (CONV_WIDTH - 1, 0), (0, 0)))
    y = zp[:, 0:s_len] * w_conv[0]
    for j in range(1, CONV_WIDTH):
        y = y + zp[:, j:j + s_len] * w_conv[j]
    return b_gate * y


def setup_inputs(seed: int = 0) -> dict:
    key = jax.random.key(seed)
    ks = jax.random.split(key, 20)
    f32 = jnp.float32
    n = lambda k, shape, s: jax.random.normal(k, shape, f32) * s
    gain = lambda k, shape: 1.0 + 0.01 * jax.random.normal(k, shape, f32)
    return {
        "x": jax.random.normal(ks[0], (BATCH, SEQ, D_MODEL), f32),
        "g_ffn1": gain(ks[1], (DEPTH, D_MODEL)),
        "w_ffn1_gate": n(ks[2], (DEPTH, D_MODEL, D_FF), D_MODEL ** -0.5),
        "w_ffn1_up": n(ks[3], (DEPTH, D_MODEL, D_FF), D_MODEL ** -0.5),
        "w_ffn1_down": n(ks[4], (DEPTH, D_FF, D_MODEL), D_FF ** -0.5),
        "g_mix": gain(ks[5], (DEPTH, D_MODEL)),
        "w_in": n(ks[6], (DEPTH, D_MODEL, IN_COLS), D_MODEL ** -0.5),
        "g_sga_v": gain(ks[7], (DEPTH, WIDTH_A)),
        "w_sga_s": n(ks[8], (DEPTH, N_GROUPS_A, CHUNK, CHUNK), CHUNK ** -0.5),
        "b_sga_s": 1.0 + 0.1 * jax.random.normal(ks[9], (DEPTH, N_GROUPS_A, CHUNK), f32),
        "lambda_qk": n(ks[10], (DEPTH, 4, DIFF_HEAD_DIM), 0.1),
        "g_diff_sub": gain(ks[11], (DEPTH, V_HEAD_DIM)),
        "w_conv": n(ks[12], (DEPTH, CONV_WIDTH, WIDTH_C), CONV_WIDTH ** -0.5),
        "w_out": n(ks[13], (DEPTH, MIX_WIDTH, D_MODEL), MIX_WIDTH ** -0.5),
        "g_ffn2": gain(ks[14], (DEPTH, D_MODEL)),
        "w_ffn2_gate": n(ks[15], (DEPTH, D_MODEL, D_FF), D_MODEL ** -0.5),
        "w_ffn2_up": n(ks[16], (DEPTH, D_MODEL, D_FF), D_MODEL ** -0.5),
        "w_ffn2_down": n(ks[17], (DEPTH, D_FF, D_MODEL), D_FF ** -0.5),
        "g_final": gain(ks[18], (D_MODEL,)),
    }


def reference(x, g_ffn1, w_ffn1_gate, w_ffn1_up, w_ffn1_down, g_mix, w_in, g_sga_v,
              w_sga_s, b_sga_s, lambda_qk, g_diff_sub, w_conv, w_out, g_ffn2,
              w_ffn2_gate, w_ffn2_up, w_ffn2_down, g_final):
    split_points = [int(p) for p in np.cumsum(SPLIT_SIZES)[:-1]]
    for l in range(DEPTH):
        h = rms_norm(x, g_ffn1[l])
        x = x + 0.5 * swiglu(h, w_ffn1_gate[l], w_ffn1_up[l], w_ffn1_down[l])

        h = rms_norm(x, g_mix[l])
        proj = h @ w_in[l]
        u, v, q, k, vv, b_gate, c_gate, x_c = jnp.split(proj, split_points, axis=-1)

        y_a = spatial_gating(u, v, g_sga_v[l], w_sga_s[l], b_sga_s[l])

        lambda_init = 0.8 - 0.6 * math.exp(-0.3 * l)
        lq = lambda_qk[l].astype(jnp.float32)
        lam = jnp.exp(jnp.sum(lq[0] * lq[1])) - jnp.exp(jnp.sum(lq[2] * lq[3])) + lambda_init
        y_b = diff_attention(q, k, vv, lam, g_diff_sub[l], lambda_init)

        y_c = short_gated_conv(b_gate, c_gate, x_c, w_conv[l])

        x = x + jnp.concatenate([y_a, y_b, y_c], axis=-1) @ w_out[l]

        h = rms_norm(x, g_ffn2[l])
        x = x + 0.5 * swiglu(h, w_ffn2_gate[l], w_ffn2_up[l], w_ffn2_down[l])
    return rms_norm(x, g_final)
```

```cpp
#include <hip/hip_runtime.h>
#include <cstdio>
#include <cstdint>
namespace pg8 {
#define PG8_LAS __attribute__((address_space(3)))
typedef unsigned short bf16_t;
typedef short bf16x8 __attribute__((ext_vector_type(8)));
typedef float f32x4 __attribute__((ext_vector_type(4)));
typedef unsigned u32x4 __attribute__((ext_vector_type(4)));
constexpr int BM = 256, BK = 64, HALF = 128, HTB = HALF * BK * 2  , STAGE_BYTES = 8 * HTB, NXCD = 8, WGM = 8;

__host__ __device__ __forceinline__ int lds_byte(int r, int c) { const int st = (r >> 4) * 2 + (c >> 5), rr = r & 15, cc = c & 31, ob = rr * 64 + cc * 2; return st * 1024 + (ob ^ (((ob >> 9) & 1) << 5)); }
__host__ __device__ __forceinline__ void stage_rc(int b, int& R, int& C) { const int st = b / 1024, sb = b % 1024, swz = sb ^ (((sb >> 9) & 1) << 5); R = (st >> 1) * 16 + swz / 64; C = (st & 1) * 32 + (swz % 64) / 2; }
__host__ __device__ __forceinline__ int perm32(int rho) { const int n = rho >> 4, i = rho & 15; return 8 * (i >> 2) + 4 * n + (i & 3); }

struct Unit { int pm, pn; };
struct Gemm { const bf16_t* A; const bf16_t* Bt; int M, N, K; };

struct StaticOrder {
    int nM, nN, nwg, G, c;
    __host__ __device__ void init(int M, int N, int G_, int c_) { nM = M / BM; nN = N / BM; nwg = nM * nN; G = G_; c = c_; }
    __host__ __device__ bool next(int i, Unit& u) const {
        const long L = (long)i * G + c; if (L >= nwg) return false;
        int wgid = (int)L; { const int q = nwg / NXCD, r = nwg % NXCD, xcd = wgid % NXCD, off = wgid / NXCD; wgid = (xcd < r ? xcd * (q + 1) : r * (q + 1) + (xcd - r) * q) + off; }
        const int nig = WGM * nN, gid = wgid / nig, fm = gid * WGM, gsz = (nM - fm) < WGM ? (nM - fm) : WGM;
        u.pm = fm + ((wgid % nig) % gsz); u.pn = (wgid % nig) / gsz; return true;
    }
    __device__ __forceinline__ void a_ready(const Unit&) const {}
    __device__ __forceinline__ void done(const Unit&) const {}
};

__device__ __forceinline__ unsigned cvt_pk_bf16(float lo, float hi) { unsigned r; asm volatile("v_cvt_pk_bf16_f32 %0, %1, %2" : "=v"(r) : "v"(lo), "v"(hi)); return r; }
typedef float f32x2 __attribute__((ext_vector_type(2)));
constexpr float RMS_EPS = 1e-6f;
typedef unsigned long long ssq_t;
constexpr float SSQ_SCALE = 1073741824.0f, SSQ_INV = 1.0f / 1073741824.0f;
__device__ __forceinline__ ssq_t ssq_enc(float v) { return (ssq_t)(long long)(v * SSQ_SCALE); }
__device__ __forceinline__ float ssq_dec(ssq_t v) { return (float)(long long)v * SSQ_INV; }
__device__ __forceinline__ void ssq_add(ssq_t* p, float v) { (void)__hip_atomic_fetch_add(p, ssq_enc(v), __ATOMIC_RELAXED, __HIP_MEMORY_SCOPE_AGENT); }
struct EpiSwiGLU {
    static constexpr bool PERM = true, AFTER_DRAIN = false;
    bf16_t* O; int ldc; const ssq_t* ss; float inv_k;
    __device__ __forceinline__ void operator()(const f32x4 (&acc)[2][2][4][2], const Unit& u, int wr, int wc, int fr, int fq) const {
        const int row0 = u.pm * BM + wr * 64 + fr, col0 = u.pn * HALF + wc * 32 + 8 * fq;
#pragma unroll
        for (int ai = 0; ai < 2; ++ai)
#pragma unroll
            for (int m = 0; m < 4; ++m) { const int row = row0 + ai * HALF + m * 16; const float rs = __builtin_amdgcn_rsqf(ssq_dec(ss[row]) * inv_k + RMS_EPS);
                float o[8];
#pragma unroll
                for (int n = 0; n < 2; ++n)
#pragma unroll
                    for (int i = 0; i < 4; ++i) { const float g = acc[ai][0][m][n][i] * rs, up = acc[ai][1][m][n][i] * rs;
                        const float e = __builtin_amdgcn_exp2f(g * -1.4426950408889634f); o[4 * n + i] = g * __builtin_amdgcn_rcpf(1.0f + e) * up; }
                u32x4 w; w.x = cvt_pk_bf16(o[0], o[1]); w.y = cvt_pk_bf16(o[2], o[3]); w.z = cvt_pk_bf16(o[4], o[5]); w.w = cvt_pk_bf16(o[6], o[7]);
                *(u32x4*)(O + (size_t)row * ldc + col0) = w; }
    }
};
struct EpiProj {
    static constexpr bool PERM = true, AFTER_DRAIN = false;
    bf16_t* O; int ldc; const ssq_t* ss; float inv_k; ssq_t* ssv; float qscale; int q_lo, q_hi, v_lo, v_hi;
    __device__ __forceinline__ void operator()(const f32x4 (&acc)[2][2][4][2], const Unit& u, int wr, int wc, int fr, int fq) const {
        const int row0 = u.pm * BM + wr * 64 + fr, col0 = u.pn * BM + wc * 32 + 8 * fq;
        const float cs = (u.pn >= q_lo && u.pn < q_hi) ? qscale : 1.0f; const bool isv = (u.pn >= v_lo && u.pn < v_hi);
#pragma unroll
        for (int ai = 0; ai < 2; ++ai)
#pragma unroll
            for (int m = 0; m < 4; ++m) { const int row = row0 + ai * HALF + m * 16; const float rs = __builtin_amdgcn_rsqf(ssq_dec(ss[row]) * inv_k + RMS_EPS) * cs; float sq = 0.f;
#pragma unroll
                for (int bj = 0; bj < 2; ++bj) { const f32x4 v0 = acc[ai][bj][m][0] * rs, v1 = acc[ai][bj][m][1] * rs;
                    sq += (v0[0] * v0[0] + v0[1] * v0[1]) + (v0[2] * v0[2] + v0[3] * v0[3]) + (v1[0] * v1[0] + v1[1] * v1[1]) + (v1[2] * v1[2] + v1[3] * v1[3]);
                    u32x4 w; w.x = cvt_pk_bf16(v0[0], v0[1]); w.y = cvt_pk_bf16(v0[2], v0[3]); w.z = cvt_pk_bf16(v1[0], v1[1]); w.w = cvt_pk_bf16(v1[2], v1[3]);
                    *(u32x4*)(O + (size_t)row * ldc + col0 + bj * HALF) = w; }
                if (isv) { sq += __shfl_xor(sq, 16); sq += __shfl_xor(sq, 32); if (fq == 0) ssq_add(ssv + row, sq); } }
    }
};
struct EpiResid {
    static constexpr bool PERM = true, AFTER_DRAIN = false;
    const float* xin; float* xout; bf16_t* xb; ssq_t* ss_out; float alpha; int ldc;
    __device__ __forceinline__ void operator()(const f32x4 (&acc)[2][2][4][2], const Unit& u, int wr, int wc, int fr, int fq) const {
        const int row0 = u.pm * BM + wr * 64 + fr, col0 = u.pn * BM + wc * 32 + 8 * fq;
#pragma unroll
        for (int ai = 0; ai < 2; ++ai)
#pragma unroll
            for (int m = 0; m < 4; ++m) { const int row = row0 + ai * HALF + m * 16; const size_t off = (size_t)row * ldc + col0; float sq = 0.f;
#pragma unroll
                for (int bj = 0; bj < 2; ++bj) { const f32x4 b0 = *(const f32x4*)(xin + off + bj * HALF), b1 = *(const f32x4*)(xin + off + bj * HALF + 4);
                    const f32x4 v0 = b0 + acc[ai][bj][m][0] * alpha, v1 = b1 + acc[ai][bj][m][1] * alpha;
                    sq += (v0[0] * v0[0] + v0[1] * v0[1]) + (v0[2] * v0[2] + v0[3] * v0[3]) + (v1[0] * v1[0] + v1[1] * v1[1]) + (v1[2] * v1[2] + v1[3] * v1[3]);
                    *(f32x4*)(xout + off + bj * HALF) = v0; *(f32x4*)(xout + off + bj * HALF + 4) = v1;
                    u32x4 w; w.x = cvt_pk_bf16(v0[0], v0[1]); w.y = cvt_pk_bf16(v0[2], v0[3]); w.z = cvt_pk_bf16(v1[0], v1[1]); w.w = cvt_pk_bf16(v1[2], v1[3]);
                    *(u32x4*)(xb + off + bj * HALF) = w; }
                sq += __shfl_xor(sq, 16); sq += __shfl_xor(sq, 32); if (fq == 0) ssq_add(ss_out + row, sq);
                if (m & 1) asm volatile("" ::: "memory"); }
    }
};

template <class Epi, class Sched, bool ALIGN_EPI = false, bool SP2 = false>
__device__ __forceinline__ void gemm_phase(PG8_LAS unsigned char* lds, const Gemm g, const Sched& S, const Epi& E) {
    int tid_ = threadIdx.x; asm volatile("" : "+v"(tid_));
    const int tid = tid_, wid = __builtin_amdgcn_readfirstlane(tid >> 6), lane = tid & 63, wr = wid >> 2, wc = wid & 3, fr = lane & 15, fq = lane >> 4;
    const int K = g.K, nt = K / BK;
    unsigned voffA[2], voffB[2];
#pragma unroll
    for (int i = 0; i < 2; ++i) { int R, C; stage_rc(tid * 16 + i * 8192, R, C); const int Rb = Epi::PERM ? ((R & ~31) + perm32(R & 31)) : R;
        voffA[i] = (unsigned)(R * K + C) * 2u; voffB[i] = (unsigned)(Rb * K + C) * 2u; }
    const size_t kstep = (size_t)(BK * 2);
    const size_t hstep = (size_t)HALF * K * 2;
    const size_t tstep = 2 * hstep;
    const unsigned ldsw = (unsigned)wid * 1024u;
    const int aoff = lds_byte(wr * 64 + fr, fq * 8), boff = lds_byte(wc * 32 + fr, fq * 8);
#define PG8_SA(b, h) (((b) * 2 + (h)) * HTB)
#define PG8_SB(b, h) ((4 + (b) * 2 + (h)) * HTB)
#define PG8_STAGE(bufoff, gbase, voff) do { _Pragma("unroll") for (int _i = 0; _i < 2; ++_i) \
        __builtin_amdgcn_global_load_lds((const unsigned*)((const char*)(gbase) + (voff)[_i]), (PG8_LAS unsigned*)(lds + (bufoff) + ldsw + _i * 8192), 16, 0, 0); } while (0)
#define PG8_LDA(dst, b, h) do { _Pragma("unroll") for (int m = 0; m < 4; ++m) _Pragma("unroll") for (int k = 0; k < 2; ++k) dst[m][k] = *(const PG8_LAS bf16x8*)(lds + PG8_SA(b, h) + aoff + m * 2048 + k * 1024); } while (0)
#define PG8_LDB(dst, b, h) do { _Pragma("unroll") for (int n = 0; n < 2; ++n) _Pragma("unroll") for (int k = 0; k < 2; ++k) dst[n][k] = *(const PG8_LAS bf16x8*)(lds + PG8_SB(b, h) + boff + n * 2048 + k * 1024); } while (0)
#define PG8_MMA(ai, bj, At, Bt) do { __builtin_amdgcn_s_setprio(1); _Pragma("unroll") for (int m = 0; m < 4; ++m) _Pragma("unroll") for (int n = 0; n < 2; ++n) _Pragma("unroll") for (int k = 0; k < 2; ++k) \
        acc[ai][bj][m][n] = __builtin_amdgcn_mfma_f32_16x16x32_bf16(Bt[n][k], At[m][k], acc[ai][bj][m][n], 0, 0, 0); __builtin_amdgcn_s_setprio(0); } while (0)
#define PG8_WAIT_V(n) asm volatile("s_waitcnt vmcnt(" #n ")" ::: "memory")
#define PG8_WAIT_L(n) asm volatile("s_waitcnt lgkmcnt(" #n ")" ::: "memory")
#define PG8_BAR __builtin_amdgcn_s_barrier()
#define PG8_SCHED __builtin_amdgcn_sched_barrier(0)
    Unit cur, nxt; int ui = 0;
    if (!S.next(0, cur)) return;
    f32x4 acc[2][2][4][2];
#pragma unroll
    for (int a = 0; a < 2; ++a)
#pragma unroll
        for (int b = 0; b < 2; ++b)
#pragma unroll
            for (int m = 0; m < 4; ++m)
#pragma unroll
                for (int n = 0; n < 2; ++n) acc[a][b][m][n] = (f32x4){0.f, 0.f, 0.f, 0.f};
    bf16x8 At[4][2], B0[2][2], B1[2][2];
    const char* cA = (const char*)g.A + (size_t)cur.pm * tstep; const char* cB = (const char*)g.Bt + (size_t)cur.pn * tstep;
    S.a_ready(cur);
    if constexpr (SP2) {
        PG8_STAGE(PG8_SB(0, 0), cB, voffB); PG8_STAGE(PG8_SB(0, 1), cB + hstep, voffB); PG8_STAGE(PG8_SA(0, 0), cA, voffA); PG8_STAGE(PG8_SA(0, 1), cA + hstep, voffA);
        if (wr == 1) PG8_BAR;
        PG8_WAIT_V(2); PG8_BAR;
        PG8_STAGE(PG8_SB(1, 0), cB + kstep, voffB); PG8_STAGE(PG8_SA(1, 0), cA + kstep, voffA); PG8_STAGE(PG8_SB(1, 1), cB + hstep + kstep, voffB);
        PG8_WAIT_V(6); PG8_BAR;
    } else {
        PG8_STAGE(PG8_SB(0, 0), cB, voffB); PG8_STAGE(PG8_SA(0, 0), cA, voffA); PG8_STAGE(PG8_SB(0, 1), cB + hstep, voffB); PG8_STAGE(PG8_SA(0, 1), cA + hstep, voffA);
        if (wr == 1) PG8_BAR;
        PG8_WAIT_V(4); PG8_BAR;
        PG8_STAGE(PG8_SB(1, 0), cB + kstep, voffB); PG8_STAGE(PG8_SA(1, 0), cA + kstep, voffA); PG8_STAGE(PG8_SB(1, 1), cB + hstep + kstep, voffB);
        PG8_WAIT_V(6); PG8_BAR;
    }
    for (;;) {
        const bool has_next = S.next(ui + 1, nxt);
        const char* nA = has_next ? (const char*)g.A + (size_t)nxt.pm * tstep : cA; const char* nB = has_next ? (const char*)g.Bt + (size_t)nxt.pn * tstep : cB;
        for (int t = 0; t < nt; t += 2) {
            const bool last = (t == nt - 2);
            const char* a1 = cA + (size_t)(t + 1) * kstep;
            const char* a2 = last ? nA : cA + (size_t)(t + 2) * kstep; const char* b2 = last ? nB : cB + (size_t)(t + 2) * kstep;
            const char* a3 = a2 + kstep; const char* b3 = b2 + kstep;
            if (last && has_next) S.a_ready(nxt);
            if constexpr (SP2) {
            PG8_LDB(B0, 0, 0); PG8_LDB(B1, 0, 1); PG8_SCHED; PG8_LDA(At, 0, 0); PG8_STAGE(PG8_SA(1, 1), a1 + hstep, voffA);
            PG8_WAIT_V(8); PG8_WAIT_L(0); PG8_BAR; PG8_MMA(0, 0, At, B0); PG8_MMA(0, 1, At, B1); PG8_BAR; PG8_SCHED;
            PG8_LDA(At, 0, 1); PG8_STAGE(PG8_SB(0, 0), b2, voffB); PG8_STAGE(PG8_SB(0, 1), b2 + hstep, voffB); PG8_STAGE(PG8_SA(0, 0), a2, voffA);
            PG8_WAIT_V(8); PG8_WAIT_L(0); PG8_BAR; PG8_MMA(1, 0, At, B0); PG8_MMA(1, 1, At, B1); PG8_BAR; PG8_SCHED;
            PG8_LDB(B0, 1, 0); PG8_LDB(B1, 1, 1); PG8_SCHED; PG8_LDA(At, 1, 0); PG8_STAGE(PG8_SA(0, 1), a2 + hstep, voffA);
            PG8_WAIT_V(8); PG8_WAIT_L(0); PG8_BAR; PG8_MMA(0, 0, At, B0); PG8_MMA(0, 1, At, B1); PG8_BAR; PG8_SCHED;
            PG8_LDA(At, 1, 1); PG8_STAGE(PG8_SB(1, 0), b3, voffB); PG8_STAGE(PG8_SB(1, 1), b3 + hstep, voffB); PG8_STAGE(PG8_SA(1, 0), a3, voffA);
            PG8_WAIT_V(8); PG8_WAIT_L(0); PG8_BAR; PG8_MMA(1, 0, At, B0); PG8_MMA(1, 1, At, B1); PG8_BAR; PG8_SCHED;
            } else {
            PG8_LDB(B0, 0, 0); PG8_SCHED; PG8_LDA(At, 0, 0); PG8_STAGE(PG8_SA(1, 1), a1 + hstep, voffA);
            PG8_WAIT_L(8); PG8_BAR; PG8_WAIT_L(0); PG8_MMA(0, 0, At, B0); PG8_BAR; PG8_SCHED;
            PG8_LDB(B1, 0, 1); PG8_STAGE(PG8_SB(0, 0), b2, voffB);
            PG8_BAR; PG8_WAIT_L(0); PG8_MMA(0, 1, At, B1); PG8_BAR;
            PG8_LDA(At, 0, 1); PG8_STAGE(PG8_SA(0, 0), a2, voffA);
            PG8_BAR; PG8_WAIT_L(0); PG8_MMA(1, 0, At, B0); PG8_BAR; PG8_SCHED;
            PG8_STAGE(PG8_SB(0, 1), b2 + hstep, voffB);
            PG8_WAIT_V(6); PG8_BAR; PG8_MMA(1, 1, At, B1); PG8_BAR;
            PG8_LDB(B0, 1, 0); PG8_SCHED; PG8_LDA(At, 1, 0); PG8_STAGE(PG8_SA(0, 1), a2 + hstep, voffA);
            PG8_WAIT_L(8); PG8_BAR; PG8_WAIT_L(0); PG8_MMA(0, 0, At, B0); PG8_BAR; PG8_SCHED;
            PG8_LDB(B1, 1, 1); PG8_STAGE(PG8_SB(1, 0), b3, voffB);
            PG8_BAR; PG8_WAIT_L(0); PG8_MMA(0, 1, At, B1); PG8_BAR;
            PG8_LDA(At, 1, 1); PG8_STAGE(PG8_SA(1, 0), a3, voffA);
            PG8_BAR; PG8_WAIT_L(0); PG8_MMA(1, 0, At, B0); PG8_BAR; PG8_SCHED;
            PG8_STAGE(PG8_SB(1, 1), b3 + hstep, voffB);
            PG8_WAIT_V(6); PG8_BAR; PG8_MMA(1, 1, At, B1); PG8_BAR;
            }
        }
        if constexpr (ALIGN_EPI) { if (wr == 0) PG8_BAR; }
        if constexpr (!Epi::AFTER_DRAIN) { E(acc, cur, wr, wc, fr, fq); S.done(cur); }
        if (!has_next) break;
#pragma unroll
        for (int a = 0; a < 2; ++a)
#pragma unroll
            for (int b = 0; b < 2; ++b)
#pragma unroll
                for (int m = 0; m < 4; ++m)
#pragma unroll
                    for (int n = 0; n < 2; ++n) acc[a][b][m][n] = (f32x4){0.f, 0.f, 0.f, 0.f};
        cur = nxt; cA = nA; cB = nB; ++ui;
        if constexpr (ALIGN_EPI) { if (wr == 1) PG8_BAR; }
    }
    PG8_WAIT_V(0);
    if constexpr (!ALIGN_EPI) { if (wr == 0) PG8_BAR; }
    PG8_BAR;
    if constexpr (Epi::AFTER_DRAIN) { E.fused(acc, cur, wr, wc, fr, fq, lds, wid, lane); S.done(cur); }
#undef PG8_SA
#undef PG8_SB
#undef PG8_STAGE
#undef PG8_LDA
#undef PG8_LDB
#undef PG8_MMA
#undef PG8_WAIT_V
#undef PG8_WAIT_L
#undef PG8_BAR
#undef PG8_SCHED
}
}
#include <hip/hip_bf16.h>
#include <cmath>
namespace attn_body {
using bf16=__hip_bfloat16;
using bf16x8=__attribute__((ext_vector_type(8)))short;
using s16x4=__attribute__((ext_vector_type(4)))short;
using f32x16=__attribute__((ext_vector_type(16)))float;
using u32x4=__attribute__((ext_vector_type(4)))unsigned;
constexpr int SEQ=4096,D=64,DM=5632,DMO=2048;
constexpr int NW=8,QBLK=32,QB=QBLK*NW,KVBLK=64,NQB=SEQ/QB;
constexpr int ATTN_PITCH=DM, ATTN_UNIT_ROWS=QB;
constexpr float LOG2E=1.4426950408889634f;
__device__ __forceinline__ int crow(int r,int hi){return (r&3)+8*(r>>2)+4*hi;}
#define SBAR() __builtin_amdgcn_sched_barrier(0)
__device__ __forceinline__ void cmask(f32x16&p0,f32x16&p1,int jb,int qrel,int hi){
  const float NEG=-INFINITY; int kb=64*jb+4*hi;
  #pragma unroll
  for(int r=0;r<16;++r){int kv=kb+(r&3)+8*(r>>2); if(kv>qrel)p0[r]=NEG; if(kv+32>qrel)p1[r]=NEG;}
}

constexpr int NSLOT=3, SLOTB=8192;
constexpr int LDS_K=0, LDS_V=NSLOT*SLOTB, LDS_WS=2*NSLOT*SLOTB, LDS_OST=LDS_WS+NW*64*4, LDS_BYTES=LDS_OST+NW*4096;
constexpr float C2=0.125f*1.4426950408889634f;
__device__ __forceinline__ void glds16(const void*gsrc,unsigned lds_dst){unsigned keep;
  asm volatile("s_mov_b32 %0, m0\n\ts_mov_b32 m0, %2\n\ts_nop 0\n\tglobal_load_lds_dwordx4 %1, off\n\ts_mov_b32 m0, %0":"=&s"(keep):"v"(gsrc),"s"(lds_dst):"memory");}
__device__ __forceinline__ float max3f(float a,float b,float c){float r;asm("v_max3_f32 %0, %1, %2, %3":"=v"(r):"v"(a),"v"(b),"v"(c));return r;}
__device__ __forceinline__ float max2f(float a,float b){float r;asm("v_max_f32_e32 %0, %1, %2":"=v"(r):"v"(a),"v"(b));return r;}
__device__ __forceinline__ float fadd_s(float a,float b){float r;asm("v_add_f32_e32 %0, %1, %2":"=v"(r):"v"(a),"v"(b));return r;}
__device__ __forceinline__ float fsub_s(float a,float b){float r;asm("v_sub_f32_e32 %0, %1, %2":"=v"(r):"v"(a),"v"(b));return r;}
typedef float f32x2_t __attribute__((ext_vector_type(2))); typedef __bf16 bf16x2_t __attribute__((ext_vector_type(2)));
__device__ __forceinline__ unsigned cvtpk_s(float lo,float hi){f32x2_t v={lo,hi};bf16x2_t b=__builtin_convertvector(v,bf16x2_t);return __builtin_bit_cast(unsigned,b);}
#define WAIT_BAR(N) asm volatile("s_waitcnt vmcnt(" #N ") lgkmcnt(0)\n\ts_barrier":::"memory")

__device__ __forceinline__ void qkt(f32x16&p0,f32x16&p1,const char*Kslot,const bf16x8*qr,const f32x16&negm,int r32,int hi){
  const char*kb=Kslot+hi*1024+r32*16;
  #pragma unroll
  for(int d0=0;d0<4;++d0){
    const bf16x8 b0=*reinterpret_cast<const bf16x8*>(kb+d0*2048);
    const bf16x8 b1=*reinterpret_cast<const bf16x8*>(kb+d0*2048+512);
    if(d0==0){p0=__builtin_amdgcn_mfma_f32_32x32x16_bf16(b0,qr[0],negm,0,0,0);p1=__builtin_amdgcn_mfma_f32_32x32x16_bf16(b1,qr[0],negm,0,0,0);}
    else{p0=__builtin_amdgcn_mfma_f32_32x32x16_bf16(b0,qr[d0],p0,0,0,0);p1=__builtin_amdgcn_mfma_f32_32x32x16_bf16(b1,qr[d0],p1,0,0,0);}}
}
typedef __attribute__((address_space(3))) const char* lds_cptr;
typedef short v4i16_t __attribute__((ext_vector_type(4)));
__device__ __forceinline__ void kload8(bf16x8*kf,lds_cptr kp){
  kf[0]=*(const __attribute__((address_space(3))) bf16x8*)(kp);      kf[1]=*(const __attribute__((address_space(3))) bf16x8*)(kp+512);
  kf[2]=*(const __attribute__((address_space(3))) bf16x8*)(kp+2048); kf[3]=*(const __attribute__((address_space(3))) bf16x8*)(kp+2560);
  kf[4]=*(const __attribute__((address_space(3))) bf16x8*)(kp+4096); kf[5]=*(const __attribute__((address_space(3))) bf16x8*)(kp+4608);
  kf[6]=*(const __attribute__((address_space(3))) bf16x8*)(kp+6144); kf[7]=*(const __attribute__((address_space(3))) bf16x8*)(kp+6656);
}
__device__ __forceinline__ void kload2(bf16x8*kf,lds_cptr kp,int j){ kf[2*j]=*(const __attribute__((address_space(3))) bf16x8*)(kp+j*2048); kf[2*j+1]=*(const __attribute__((address_space(3))) bf16x8*)(kp+j*2048+512); }
__device__ __forceinline__ s16x4 vtr(lds_cptr p){ return __builtin_bit_cast(s16x4,__builtin_amdgcn_ds_read_tr16_b64_v4i16((__attribute__((address_space(3))) v4i16_t*)p)); }
__device__ __forceinline__ float rowmax(const f32x16&p0,const f32x16&p1){
  float a=max3f(p0[0],p0[1],p1[0]),b=max3f(p0[2],p0[3],p1[1]);a=max3f(a,p1[2],p1[3]);
  #pragma unroll
  for(int r=4;r<16;r+=4){a=max3f(a,p0[r],p0[r+1]);b=max3f(b,p0[r+2],p0[r+3]);a=max3f(a,p1[r],p1[r+1]);b=max3f(b,p1[r+2],p1[r+3]);}
  const float m=max2f(a,b);
  auto rr=__builtin_amdgcn_permlane32_swap(__float_as_uint(m),__float_as_uint(m),false,false);
  return max2f(__uint_as_float(rr[0]),__uint_as_float(rr[1]));
}
__device__ __forceinline__ void pv(f32x16*o,int vb,bf16x8 pa0,bf16x8 pa1,bf16x8 pa2,bf16x8 pa3){
  #pragma unroll
  for(int d0=0;d0<2;++d0){s16x4 lo[4],hi[4];
    #pragma unroll
    for(int ks=0;ks<4;++ks){
      asm volatile("ds_read_b64_tr_b16 %0,%1 offset:%c2":"=&v"(lo[ks]):"v"(vb),"i"(d0*4096+ks*1024):"memory");
      asm volatile("ds_read_b64_tr_b16 %0,%1 offset:%c2":"=&v"(hi[ks]):"v"(vb),"i"(d0*4096+ks*1024+512):"memory");}
    asm volatile("s_waitcnt lgkmcnt(0)":::"memory");SBAR();
    #define PK(k) (bf16x8){lo[k][0],lo[k][1],lo[k][2],lo[k][3],hi[k][0],hi[k][1],hi[k][2],hi[k][3]}
    o[d0]=__builtin_amdgcn_mfma_f32_32x32x16_bf16(pa0,PK(0),o[d0],0,0,0);
    o[d0]=__builtin_amdgcn_mfma_f32_32x32x16_bf16(pa1,PK(1),o[d0],0,0,0);
    o[d0]=__builtin_amdgcn_mfma_f32_32x32x16_bf16(pa2,PK(2),o[d0],0,0,0);
    o[d0]=__builtin_amdgcn_mfma_f32_32x32x16_bf16(pa3,PK(3),o[d0],0,0,0);
    #undef PK
  }
}

#ifndef ATTN_STORE16
#define ATTN_STORE16(p,v) (*(u32x4*)(p)=(v))
#endif
template<int THRL> __device__ __forceinline__ void attn_unit(int qb,const bf16*Qh,const bf16*__restrict__ Kh,const bf16*__restrict__ Vh,bf16*Oh,float sl2,char*shm){
  int tid_=threadIdx.x; asm volatile("":"+v"(tid_)); const int tid=tid_,lane=tid&63,r32=lane&31,hi=lane>>5; const int wid=__builtin_amdgcn_readfirstlane(tid>>6);
  const int q0=qb*QB;
  const bf16*Qw=Qh+(long)(q0+wid*QBLK)*DM;
  const unsigned lds0=(unsigned)(uintptr_t)shm;
  float*wsf=(float*)(shm+LDS_WS)+wid*64;
  const bf16*ksrc=Kh+(long)lane*DM+wid*8;
  const bf16*vsrc=Vh+(long)(16*(wid&3)+(lane>>2))*DM+(wid>>2)*32+(lane&3)*8;
  const unsigned kdst=lds0+LDS_K+wid*1024, vdst=lds0+LDS_V+wid*1024;
  #define DMA_K(t,slot) glds16(ksrc+(long)(t)*KVBLK*DM,(unsigned)__builtin_amdgcn_readfirstlane(kdst+(slot)))
  #define DMA_V(t,slot) glds16(vsrc+(long)(t)*KVBLK*DM,(unsigned)__builtin_amdgcn_readfirstlane(vdst+(slot)))
  const int vb0=(int)(lds0+LDS_V)+((lane>>4)&1)*32+(lane&3)*8+(4*hi+((lane&15)>>2))*64;
  const char*Kbase=shm+LDS_K; bf16x8 kf[8];
  const lds_cptr shm3=(lds_cptr)shm; const lds_cptr kp0=shm3+LDS_K+hi*1024+r32*16; const lds_cptr vp0=shm3+LDS_V+((lane>>4)&1)*32+(lane&3)*8+(4*hi+((lane&15)>>2))*64;
  const int NT=(q0+QB)/KVBLK;
  DMA_K(0,0);DMA_V(0,0);DMA_K(1,SLOTB);
  bf16x8 qr[4];
  #pragma unroll
  for(int d0=0;d0<4;++d0)qr[d0]=*reinterpret_cast<const bf16x8*>(&Qw[(long)r32*DM+d0*16+hi*8]);
  float mhat=0.f,l_reg=0.f;f32x16 o[2];o[0]=f32x16{};o[1]=f32x16{};f32x16 negm;
  const int qrel=wid*QBLK+r32;
  #define CMASK(P0,P1,t) do{int jb_=(t)-(NT-4); if(jb_>=0)cmask(P0,P1,jb_,qrel,hi);}while(0)
  const float ab_l=sl2*(float)(4*hi-q0-qrel), ab_t=64.f*sl2, ab_32=32.f*sl2;
  _Pragma("unroll") for(int r=0;r<16;++r)negm[r]=ab_l+sl2*(float)((r&3)+8*(r>>2)); asm volatile("":"+v"(negm));
  #define ALIBI(P0,P1,t) do{ _Pragma("unroll") for(int r=0;r<16;++r){ P1[r]+=ab_32; negm[r]+=ab_t; } asm volatile("":"+v"(negm)); }while(0)
  bool resc=false;
  #define START(P0,P1) do{ const float rm=rowmax(P0,P1); resc=false; \
    { const float dl=rm; mhat=fadd_s(mhat,dl); \
      _Pragma("unroll") for(int r=0;r<16;++r){P0[r]=fsub_s(P0[r],dl);P1[r]=fsub_s(P1[r],dl);} \
      _Pragma("unroll") for(int r=0;r<16;++r)negm[r]-=dl; asm volatile("":"+v"(negm)); } \
    _Pragma("unroll") for(int r=0;r<16;++r)P0[r]=__builtin_amdgcn_exp2f(P0[r]); }while(0)
  #define RESC() do{ if(resc){ asm volatile("s_waitcnt lgkmcnt(0)":::"memory"); \
      _Pragma("unroll") for(int d_=0;d_<2;++d_) _Pragma("unroll") for(int r=0;r<16;++r)o[d_][r]*=wsf[crow(r,hi)]; } }while(0)
  f32x16 pA0,pA1,pB0,pB1;
  int sl_prev=0,sl_cur=0,sl_next=SLOTB;
  #define ROT() do{sl_prev=sl_cur;sl_cur=sl_next;sl_next=(sl_next==(NSLOT-1)*SLOTB)?0:sl_next+SLOTB;}while(0)
  DMA_K(2,2*SLOTB);
  WAIT_BAR(3);
  qkt(pA0,pA1,Kbase,qr,negm,r32,hi);asm volatile("s_nop 15\n\ts_nop 7":"+v"(pA0),"+v"(pA1));ALIBI(pA0,pA1,0);CMASK(pA0,pA1,0);
  START(pA0,pA1);
  _Pragma("unroll") for(int r=0;r<16;++r)pA1[r]=__builtin_amdgcn_exp2f(pA1[r]);
  WAIT_BAR(0);
  DMA_K(3,0);DMA_V(1,SLOTB);
  ROT();
  kload8(kf,kp0+sl_cur);
  WAIT_BAR(2);
  s16x4 vlo[8],vhi[8]; u32x4 pw0,pw1,pw2,pw3;
  #define PKW(P,B) cvtpk_s(P[B],P[B+1])
  #define PAF(k) __builtin_bit_cast(bf16x8,pw##k)
  #define VFR(i) (bf16x8){vlo[i][0],vlo[i][1],vlo[i][2],vlo[i][3],vhi[i][0],vhi[i][1],vhi[i][2],vhi[i][3]}
  #define PIN(x) asm volatile("":"+v"(x))
  #define MX3(a,b,c) __builtin_fmaxf(__builtin_fmaxf((a),(b)),(c))
  #define GAPA(MF,A0,A1,A2,A3,W0,W1,PW) do{ MF; sacc+=A0; sacc+=A1; sacc+=A2; sacc+=A3; PIN(sacc); W0; W1; PIN(PW); SBAR(); }while(0)
  #define EX(v) __builtin_amdgcn_exp2f(v)
  #define GAPB(MF,X,B) do{ MF; X[B]=EX(X[B]); X[B+1]=EX(X[B+1]); X[B+2]=EX(X[B+2]); X[B+3]=EX(X[B+3]); PIN(X); SBAR(); }while(0)
  #define VRD(i) do{ vlo[i]=vtr(vp_+(((i)>>2)*4096+((i)&3)*1024)); vhi[i]=vtr(vp_+(((i)>>2)*4096+((i)&3)*1024+512)); }while(0)
  #define KRD(G,j) do{ if(G){ kload2(kf,kp0+sl_next,j); SBAR(); } }while(0)
  #define STEP(C0,C1,P0,P1,t,GK,GV,GL) do{ SBAR(); \
    const lds_cptr vp_=vp0+sl_prev; \
    VRD(0); SBAR(); float sacc=(P0[0]+P0[1]); \
    GAPA(C0=__builtin_amdgcn_mfma_f32_32x32x16_bf16(kf[0],qr[0],negm,0,0,0), P0[2],P0[3],P0[4],P0[5],     pw0[0]=PKW(P0,0), pw0[1]=PKW(P0,2), pw0); \
    VRD(4); SBAR(); GAPA(C1=__builtin_amdgcn_mfma_f32_32x32x16_bf16(kf[1],qr[0],negm,0,0,0), P0[6],P0[7],P0[8],P0[9],     pw0[2]=PKW(P0,4), pw0[3]=PKW(P0,6), pw0); \
    VRD(1); SBAR(); GAPA(C0=__builtin_amdgcn_mfma_f32_32x32x16_bf16(kf[2],qr[1],C0,0,0,0),   P0[10],P0[11],P0[12],P0[13], pw1[0]=PKW(P0,8), pw1[1]=PKW(P0,10), pw1); \
    VRD(5); SBAR(); GAPA(C1=__builtin_amdgcn_mfma_f32_32x32x16_bf16(kf[3],qr[1],C1,0,0,0),   P0[14],P0[15],P1[0],P1[1],   pw1[2]=PKW(P0,12),pw1[3]=PKW(P0,14), pw1); \
    VRD(2); SBAR(); GAPA(C0=__builtin_amdgcn_mfma_f32_32x32x16_bf16(kf[4],qr[2],C0,0,0,0),   P1[2],P1[3],P1[4],P1[5],     pw2[0]=PKW(P1,0), pw2[1]=PKW(P1,2), pw2); \
    VRD(6); SBAR(); GAPA(C1=__builtin_amdgcn_mfma_f32_32x32x16_bf16(kf[5],qr[2],C1,0,0,0),   P1[6],P1[7],P1[8],P1[9],     pw2[2]=PKW(P1,4), pw2[3]=PKW(P1,6), pw2); \
    VRD(3); SBAR(); GAPA(C0=__builtin_amdgcn_mfma_f32_32x32x16_bf16(kf[6],qr[3],C0,0,0,0),   P1[10],P1[11],P1[12],P1[13], pw3[0]=PKW(P1,8), pw3[1]=PKW(P1,10), pw3); \
    VRD(7); SBAR(); GAPA(C1=__builtin_amdgcn_mfma_f32_32x32x16_bf16(kf[7],qr[3],C1,0,0,0),   P1[14],P1[15],0.f,0.f,       pw3[2]=PKW(P1,12),pw3[3]=PKW(P1,14), pw3); \
    l_reg+=sacc; \
    if(GK){DMA_K((t)+3,sl_cur);} if(GV){DMA_V((t)+1,sl_next);} \
    ALIBI(C0,C1,t); CMASK(C0,C1,t); \
    { float a=MX3(C0[0],C0[1],C1[0]),b=MX3(C0[2],C0[3],C1[1]); a=MX3(a,C1[2],C1[3]); \
      _Pragma("unroll") for(int r=4;r<16;r+=4){a=MX3(a,C0[r],C0[r+1]);b=MX3(b,C0[r+2],C0[r+3]);a=MX3(a,C1[r],C1[r+1]);b=MX3(b,C1[r+2],C1[r+3]);} \
      float rm=__builtin_fmaxf(a,b); { auto rr=__builtin_amdgcn_permlane32_swap(__float_as_uint(rm),__float_as_uint(rm),false,false); rm=__builtin_fmaxf(__uint_as_float(rr[0]),__uint_as_float(rr[1])); } \
      resc=false; \
      if(__builtin_expect(__any(rm>(float)THRL),0)){ const float dl=__builtin_fmaxf(rm,0.f); mhat+=dl; \
        _Pragma("unroll") for(int r=0;r<16;++r){C0[r]-=dl;C1[r]-=dl;} \
        _Pragma("unroll") for(int r=0;r<16;++r)negm[r]-=dl; asm volatile("":"+v"(negm)); \
        const float f=__builtin_amdgcn_exp2f(-dl); l_reg*=f; if(hi==0)wsf[r32]=f; resc=true; } } \
    SBAR(); \
    GAPB(o[0]=__builtin_amdgcn_mfma_f32_32x32x16_bf16(PAF(0),VFR(0),o[0],0,0,0), C0,0); \
    GAPB(o[1]=__builtin_amdgcn_mfma_f32_32x32x16_bf16(PAF(0),VFR(4),o[1],0,0,0), C0,4); \
    KRD(GL,0); GAPB(o[0]=__builtin_amdgcn_mfma_f32_32x32x16_bf16(PAF(1),VFR(1),o[0],0,0,0), C0,8); \
    KRD(GL,1); GAPB(o[1]=__builtin_amdgcn_mfma_f32_32x32x16_bf16(PAF(1),VFR(5),o[1],0,0,0), C0,12); \
    KRD(GL,2); GAPB(o[0]=__builtin_amdgcn_mfma_f32_32x32x16_bf16(PAF(2),VFR(2),o[0],0,0,0), C1,0); \
    KRD(GL,3); GAPB(o[1]=__builtin_amdgcn_mfma_f32_32x32x16_bf16(PAF(2),VFR(6),o[1],0,0,0), C1,4); \
    GAPB(o[0]=__builtin_amdgcn_mfma_f32_32x32x16_bf16(PAF(3),VFR(3),o[0],0,0,0), C1,8); \
    GAPB(o[1]=__builtin_amdgcn_mfma_f32_32x32x16_bf16(PAF(3),VFR(7),o[1],0,0,0), C1,12); \
    }while(0)
  int t=1;
  #undef CMASK
  #define CMASK(P0,P1,t) do{}while(0)
  for(;t+5<NT;t+=2){
    STEP(pB0,pB1,pA0,pA1,t,true,true,true);     WAIT_BAR(2); RESC(); ROT();
    STEP(pA0,pA1,pB0,pB1,t+1,true,true,true);   WAIT_BAR(2); RESC(); ROT();
  }
  #undef CMASK
  #define CMASK(P0,P1,t) do{int jb_=(t)-(NT-4); if(jb_>=0)cmask(P0,P1,jb_,qrel,hi);}while(0)
  #define ENDW(tt) do{ if((tt)+3<NT){WAIT_BAR(2);} else if((tt)+2<NT){WAIT_BAR(1);} else {WAIT_BAR(0);} }while(0)
  for(;t+1<NT;t+=2){
    STEP(pB0,pB1,pA0,pA1,t,(t+3<NT),(t+1<NT),(t+1<NT));       ENDW(t);   RESC(); ROT();
    STEP(pA0,pA1,pB0,pB1,t+1,(t+4<NT),(t+2<NT),(t+2<NT));     ENDW(t+1); RESC(); ROT();
  }
  STEP(pB0,pB1,pA0,pA1,NT-1,false,false,false); RESC();
  { float sacc=pB0[0]+pB0[1]; _Pragma("unroll") for(int r=2;r<16;++r)sacc+=pB0[r]; _Pragma("unroll") for(int r=0;r<16;++r)sacc+=pB1[r]; l_reg+=sacc;
    pw0=(u32x4){PKW(pB0,0),PKW(pB0,2),PKW(pB0,4),PKW(pB0,6)};pw1=(u32x4){PKW(pB0,8),PKW(pB0,10),PKW(pB0,12),PKW(pB0,14)};pw2=(u32x4){PKW(pB1,0),PKW(pB1,2),PKW(pB1,4),PKW(pB1,6)};pw3=(u32x4){PKW(pB1,8),PKW(pB1,10),PKW(pB1,12),PKW(pB1,14)};
    SBAR(); pv(o,vb0+sl_cur,PAF(0),PAF(1),PAF(2),PAF(3)); }
  #undef PKW
  #undef PAF
  #undef VFR
  #undef PIN
  #undef MX3
  #undef GAPA
  #undef GAPB
  #undef EX
  #undef VRD
  #undef KRD
  #undef STEP
  #undef ENDW
  {auto rr=__builtin_amdgcn_permlane32_swap(__float_as_uint(l_reg),__float_as_uint(l_reg),false,false);l_reg=__uint_as_float(rr[0])+__uint_as_float(rr[1]);}
  if(hi==0)wsf[32+r32]=l_reg;asm volatile("s_waitcnt lgkmcnt(0)":::"memory");
  float rli[16];
  #pragma unroll
  for(int r=0;r<16;++r)rli[r]=__builtin_amdgcn_rcpf(wsf[32+crow(r,hi)]);
  bf16*Ow=Oh+(long)(q0+wid*QBLK)*DMO;
  { bf16*stg=(bf16*)(shm+LDS_OST)+wid*2048;
    #pragma unroll
    for(int r=0;r<16;++r){const int orow=crow(r,hi);
      #pragma unroll
      for(int d0=0;d0<2;++d0)stg[orow*64+d0*32+r32]=__float2bfloat16(o[d0][r]*rli[r]);}
    asm volatile("s_waitcnt lgkmcnt(0)":::"memory");
    #pragma unroll
    for(int i=0;i<4;++i){const int row=i*8+(lane>>3),ch=lane&7; const u32x4 v=*(const u32x4*)(stg+row*64+ch*8); ATTN_STORE16(Ow+(long)row*DMO+ch*8,v);} }
  asm volatile("s_waitcnt lgkmcnt(0)\n\ts_barrier":::"memory");
  #undef DMA_K
  #undef DMA_V
  #undef CMASK
  #undef ALIBI
  #undef START
  #undef RESC
  #undef ROT
}
constexpr int ATTN_LDS_BYTES=LDS_BYTES;
struct AttnTensors { const bf16* P; bf16* O; };
struct AttnUnit { int combo; int qb; };
struct StaticOrder {
  int vcu, G;
  __device__ __forceinline__ explicit StaticOrder(int grid,int block):vcu((grid%8==0)?(block%8)*(grid/8)+block/8:block),G(grid){}
  __device__ __forceinline__ bool next(int i,AttnUnit&u)const{
    if(G==256){ if(i>=8)return false; const int s=4*(vcu&1)+(i>>1); u.combo=vcu>>1; u.qb=(i&1)?15-s:s; return true; }
    const int L=i*G+vcu; if(L>=128*16)return false; u.combo=L>>4; u.qb=L&15; return true; }
};
template<class Sched,int THRL=8> __device__ __forceinline__ void attn_phase(char*lds,const AttnTensors&T,const Sched&S){
  AttnUnit u;
  for(int i=0;S.next(i,u);++i){
    const int half=u.combo&1, m=(u.combo>>1)&1, h=(u.combo>>2)&7, b=u.combo>>5;
    const bf16*rowp=T.P+(long)b*SEQ*DM;
    const float sl2=LOG2E*__builtin_amdgcn_exp2f(-(float)(h+1));
    attn_unit<THRL>(u.qb, rowp+1024+(2*h+m)*64, rowp+2048+(2*h+m)*64, rowp+3072+(2*h+half)*64, T.O+(long)b*SEQ*DMO+m*1024+(2*h+half)*64, sl2, lds); }
}
#undef SBAR
#undef WAIT_BAR
}
#define GAS __attribute__((address_space(1)))
#define LAS __attribute__((address_space(3)))
typedef unsigned short bf16;
typedef unsigned v4u __attribute__((ext_vector_type(4)));
typedef float f32x4 __attribute__((ext_vector_type(4)));
typedef short bf16x8 __attribute__((ext_vector_type(8)));
typedef GAS unsigned gu32;
typedef GAS unsigned long long gu64;
#define RLX_AGENT __ATOMIC_RELAXED, __HIP_MEMORY_SCOPE_AGENT
#define LDS_WAIT() asm volatile("s_waitcnt lgkmcnt(0)" ::: "memory")
#define VM_WAIT() asm volatile("s_waitcnt vmcnt(0)" ::: "memory")
__device__ __forceinline__ unsigned long long rt() { return __builtin_amdgcn_s_memrealtime(); }
__device__ __forceinline__ unsigned f2bf(float f) { unsigned u = __builtin_bit_cast(unsigned, f); return (u + 0x7fffu + ((u >> 16) & 1u)) >> 16; }
__device__ __forceinline__ unsigned pk2(float lo, float hi) { return f2bf(lo) | (f2bf(hi) << 16); }

#define XB_TMO      128
#define XB_XCNT(j)  (256  + 64 * (j))
#define XB_XSUB(j)  (1280 + 64 * (j))
#define XB_XGEN(j)  (2304 + 64 * (j))
#define XB_TOP      3328
#define XB_TOPGEN   3392
#define XCD_BAR_WORDS 3456
#define XB_SPIN_CAP (1u << 18)

__device__ __forceinline__ unsigned xb_ld(unsigned* p)              { return __hip_atomic_load(p, __ATOMIC_RELAXED, __HIP_MEMORY_SCOPE_AGENT); }
__device__ __forceinline__ unsigned xb_add(unsigned* p, unsigned v) { return __hip_atomic_fetch_add(p, v, __ATOMIC_RELAXED, __HIP_MEMORY_SCOPE_AGENT); }
__device__ __forceinline__ unsigned xb_xcc_id() { return (unsigned)__builtin_amdgcn_s_getreg((3 << 11) | 20) & 0xFu; }
#define XB_SPIN(cond, bar) do { unsigned _sp = 0; while (cond) { __builtin_amdgcn_s_sleep(1); \
    if ((++_sp & 255u) == 0u) { if (xb_ld(&(bar)[XB_TMO])) break; if (_sp > XB_SPIN_CAP) { atomicAdd(&(bar)[XB_TMO], 1u); break; } } } } while (0)

struct XcdBarrier {
    unsigned* bar; unsigned x;
    volatile LAS unsigned* st;
};

__device__ __forceinline__ XcdBarrier xcd_barrier_post(unsigned* bar, volatile LAS unsigned* st) {
    XcdBarrier b; b.bar = bar; b.x = xb_xcc_id(); b.st = st;
    if (threadIdx.x == 0) (void)xb_add(&bar[XB_XCNT(b.x)], 1u);
    return b;
}
__device__ __forceinline__ void xcd_barrier_complete(unsigned* bar, unsigned x, unsigned& nloc, unsigned& nx) {
    const unsigned G = gridDim.x * gridDim.y * gridDim.z;
    unsigned sum, cnt, mine, sp = 0u;
    for (;;) {
        sum = 0u; cnt = 0u; mine = 0u;
#pragma unroll
        for (unsigned j = 0; j < 16; ++j) { const unsigned c = xb_ld(&bar[XB_XCNT(j)]); sum += c; cnt += (c > 0u) ? 1u : 0u; mine = (j == x) ? c : mine; }
        if (sum == G) break;
        __builtin_amdgcn_s_sleep(1);
        if ((++sp & 255u) == 0u) { if (xb_ld(&bar[XB_TMO])) break; if (sp > XB_SPIN_CAP) { atomicAdd(&bar[XB_TMO], 1u); break; } }
    }
    nloc = mine > 0u ? mine : 1u; nx = cnt > 0u ? cnt : 1u;
}

__device__ __forceinline__ void xcd_barrier(const XcdBarrier& b) {
    asm volatile("s_waitcnt vmcnt(0)" ::: "memory");
    __syncthreads();
    if (threadIdx.x == 0) {
        unsigned* bar = b.bar; unsigned bx_ = b.x;
        asm volatile("" : "+s"(bar), "+s"(bx_));
        __builtin_amdgcn_s_waitcnt(0);
        unsigned nloc = b.st[0], nx = b.st[1];
        if (nloc == 0u) { xcd_barrier_complete(bar, bx_, nloc, nx); b.st[0] = nloc; b.st[1] = nx; }
        const unsigned old = xb_add(&bar[XB_XSUB(bx_)], 1u);
        const unsigned gen = old / nloc;
        if (old + 1u == (gen + 1u) * nloc) {
            __builtin_amdgcn_fence(__ATOMIC_RELEASE, "agent");
            asm volatile("s_waitcnt vmcnt(0)" ::: "memory");
            const unsigned og = xb_add(&bar[XB_TOP], 1u);
            const unsigned tg = og / nx;
            if (og + 1u == (tg + 1u) * nx) xb_add(&bar[XB_TOPGEN], 1u);
            else XB_SPIN(xb_ld(&bar[XB_TOPGEN]) == tg, bar);
            __builtin_amdgcn_fence(__ATOMIC_ACQUIRE, "agent");
            xb_add(&bar[XB_XGEN(bx_)], 1u);
            asm volatile("s_waitcnt vmcnt(0)" ::: "memory");
        } else {
            XB_SPIN(xb_ld(&bar[XB_XGEN(bx_)]) == gen, bar);
            __builtin_amdgcn_fence(__ATOMIC_ACQUIRE, "agent");
            asm volatile("s_waitcnt vmcnt(0)" ::: "memory");
        }
    }
    __syncthreads();
}

constexpr int NWAVES = 8;
struct Frame {
    LAS unsigned char* lds;
    volatile LAS unsigned* MISC;
    gu32* ctl;
    int tid, lane, wave;
    int vcu, G;
};
__device__ __forceinline__ float wave_sum(float v) {
#pragma unroll
    for (int o = 1; o < 64; o <<= 1) v += __shfl_xor(v, o);
    return v;
}
__device__ __forceinline__ float bf_lo(unsigned w) { return __uint_as_float(w << 16); }
__device__ __forceinline__ float bf_hi(unsigned w) { return __uint_as_float(w & 0xffff0000u); }

__device__ __forceinline__ void w_transpose_item(const float* W, int K, int N, const float* gain, bf16* WT, int k0, int n0, int dst_row0, LAS float* scr, int lane) {
#pragma unroll 8
    for (int i = 0; i < 32; ++i) { const int kk = 2 * i + (lane >> 5); float w = W[(size_t)(k0 + kk) * N + n0 + (lane & 31)]; if (gain) w *= gain[k0 + kk]; scr[kk * 33 + (lane & 31)] = w; }
    LDS_WAIT(); asm volatile("" ::: "memory");
    const int c = lane & 7;
#pragma unroll
    for (int j = 0; j < 4; ++j) { const int n = (lane >> 3) + 8 * j; const LAS float* s = scr + (8 * c) * 33 + n;
        v4u o; o.x = pk2(s[0 * 33], s[1 * 33]); o.y = pk2(s[2 * 33], s[3 * 33]); o.z = pk2(s[4 * 33], s[5 * 33]); o.w = pk2(s[6 * 33], s[7 * 33]);
        *(GAS v4u*)(WT + (size_t)(dst_row0 + n) * K + k0 + 8 * c) = o; }
    LDS_WAIT(); asm volatile("" ::: "memory");
}

constexpr int DM = 2048, NB = 4, SEQ = 4096, M = NB * SEQ, DEPTH = 4, FF = 5632, NIN = 5632, WA = 512, WBW = 1024, WC = 512;
constexpr float EPS = 1e-6f;
constexpr size_t MiB = 1u << 20;
constexpr size_t WS_CTL = 0, CTL_ZERO_BYTES = 4 * MiB;
constexpr int CW_BAR = 4096;
constexpr size_t SS_OFF = 64 * 1024;
static_assert(CW_BAR * 4 + XCD_BAR_WORDS * 4 <= SS_OFF && SS_OFF + 17 * (size_t)M * 8 <= CTL_ZERO_BYTES, "ctl map");
constexpr size_t WS_WGU1 = 4 * MiB, WS_WD1 = WS_WGU1 + 44 * MiB, WS_WIN = WS_WD1 + 22 * MiB, WS_WOUT = WS_WIN + 22 * MiB, WS_WGU2 = WS_WOUT + 8 * MiB, WS_WD2 = WS_WGU2 + 44 * MiB;
constexpr size_t WS_XR = WS_WD2 + 22 * MiB;
constexpr size_t WS_XB = WS_XR + 128 * MiB;
constexpr size_t WS_ACT = WS_XB + 64 * MiB;
constexpr size_t WS_OB = WS_ACT + 176 * MiB;
constexpr size_t WS_YM = WS_OB + 64 * MiB;
constexpr size_t WS_END = WS_YM + 64 * MiB;
static_assert((size_t)FF * 2 * DM * 2 == 44 * MiB && (size_t)M * FF * 2 == 176 * MiB, "sizes");
constexpr int RING_OFF = 0, RING_BYTES = 131072;
constexpr int LDSCTL_OFF = RING_BYTES, MISC_OFF = LDSCTL_OFF + 320;
constexpr int LDS_BYTES = 147456;

struct Args { const float* in[19]; float* out; unsigned char* ws; };
typedef const __attribute__((address_space(4))) Args* ArgsP;
__device__ __forceinline__ ArgsP get_args() { ArgsP p = (ArgsP)__builtin_amdgcn_kernarg_segment_ptr(); asm volatile("" : "+s"(p)); return p; }

__device__ __forceinline__ void phase_weights(Frame& F0, int l) {
    Frame F = F0; asm volatile("" : "+v"(F.tid), "+v"(F.lane));
    const ArgsP ap = get_args();
    LAS float* scr = (LAS float*)(F.lds + RING_OFF + F.wave * 16384);
    const int gw = F.vcu * NWAVES + F.wave, NGW = F.G * NWAVES;
    unsigned char* ws = ap->ws;
    constexpr int I_BIG = (DM / 64) * (FF / 32);
    constexpr int I_OUT = (DM / 64) * (DM / 32);
    constexpr int NITEMS = 7 * I_BIG + I_OUT;
    const size_t wbig = (size_t)l * DM * FF;
    for (int it = gw; it < NITEMS; it += NGW) {
        const int which = it / I_BIG, r = it % I_BIG;
        if (which == 0 || which == 1 || which == 4 || which == 5) {
            const int f2 = which >= 4, up = which & 1;
            const float* W = ap->in[(f2 ? 15 : 2) + up] + wbig; const float* g = ap->in[f2 ? 14 : 1] + (size_t)l * DM;
            bf16* WT = (bf16*)(ws + (f2 ? WS_WGU2 : WS_WGU1));
            const int nblk = FF / 32, kb = r / nblk, nb = r % nblk, n0 = 32 * nb;
            w_transpose_item(W, DM, FF, g, WT, 64 * kb, n0, (n0 / 128) * 256 + (n0 % 128) + up * 128, scr, F.lane);
        } else if (which == 2 || which == 6) {
            const int f2 = which == 6;
            const float* W = ap->in[f2 ? 17 : 4] + wbig; bf16* WT = (bf16*)(ws + (f2 ? WS_WD2 : WS_WD1));
            const int nblk = DM / 32, kb = r / nblk, nb = r % nblk;
            w_transpose_item(W, FF, DM, nullptr, WT, 64 * kb, 32 * nb, 32 * nb, scr, F.lane);
        } else if (which == 3) {
            const float* W = ap->in[6] + wbig; const float* g = ap->in[5] + (size_t)l * DM; bf16* WT = (bf16*)(ws + WS_WIN);
            const int nblk = NIN / 32, kb = r / nblk, nb = r % nblk;
            w_transpose_item(W, DM, NIN, g, WT, 64 * kb, 32 * nb, 32 * nb, scr, F.lane);
        } else {
            const float* W = ap->in[13] + (size_t)l * DM * DM; bf16* WT = (bf16*)(ws + WS_WOUT);
            const int nblk = DM / 32, kb = r / nblk, nb = r % nblk;
            w_transpose_item(W, DM, DM, nullptr, WT, 64 * kb, 32 * nb, 32 * nb, scr, F.lane);
        }
    }
    if (l == 0) {
        const float* x = ap->in[0]; bf16* xb = (bf16*)(ws + WS_XB); pg8::ssq_t* ss0 = (pg8::ssq_t*)(ws + SS_OFF);
        for (int m = gw; m < M; m += NGW) {
            const GAS f32x4* xr = (const GAS f32x4*)(x + (size_t)m * DM) + F.lane; GAS unsigned long long* o8 = (GAS unsigned long long*)(xb + (size_t)m * DM) + F.lane;
            float s = 0.f;
#pragma unroll
            for (int j = 0; j < 8; ++j) { const f32x4 v = xr[64 * j]; s += (v.x * v.x + v.y * v.y) + (v.z * v.z + v.w * v.w);
                o8[64 * j] = (unsigned long long)pk2(v.x, v.y) | ((unsigned long long)pk2(v.z, v.w) << 32); }
            s = wave_sum(s); if (F.lane == 0) ss0[m] = pg8::ssq_enc(s);
        }
    }
}

__device__ __forceinline__ void phase_mixer_post(Frame& F0, int l) {
    Frame F = F0; asm volatile("" : "+v"(F.tid), "+v"(F.lane));
    const ArgsP ap = get_args();
    unsigned char* ws = ap->ws;
    const bf16* P = (const bf16*)(ws + WS_ACT); const bf16* OB = (const bf16*)(ws + WS_OB); bf16* YM = (bf16*)(ws + WS_YM);
    const int gw = F.vcu * NWAVES + F.wave, NGW = F.G * NWAVES, lane = F.lane;
    const float* lq = ap->in[10] + (size_t)l * 4 * 64;
    const float s01 = wave_sum(lq[lane] * lq[64 + lane]), s23 = wave_sum(lq[128 + lane] * lq[192 + lane]);
    const float lam_init = 0.8f - 0.6f * __expf(-0.3f * (float)l);
    const float lam = __expf(s01) - __expf(s23) + lam_init, oml = 1.0f - lam_init;
    {
        const float* gsub = ap->in[11] + (size_t)l * 128; const float* wcv = ap->in[12] + (size_t)l * 3 * WC;
        float gs[16]; { const int c0 = (lane & 7) * 16;
#pragma unroll
            for (int i = 0; i < 16; ++i) gs[i] = gsub[c0 + i] * oml; }
        float w0[8], w1[8], w2[8]; { const int c = lane * 8;
#pragma unroll
            for (int i = 0; i < 8; ++i) { w0[i] = wcv[c + i]; w1[i] = wcv[WC + c + i]; w2[i] = wcv[2 * WC + c + i]; } }
        for (int row = gw; row < M; row += NGW) {
            { const v4u* p1 = (const v4u*)(OB + (size_t)row * 2048 + lane * 16); const v4u* p2 = (const v4u*)(OB + (size_t)row * 2048 + 1024 + lane * 16);
              const v4u a0 = p1[0], a1 = p1[1], b0 = p2[0], b1 = p2[1];
              const unsigned aw[8] = {a0.x, a0.y, a0.z, a0.w, a1.x, a1.y, a1.z, a1.w}, bw[8] = {b0.x, b0.y, b0.z, b0.w, b1.x, b1.y, b1.z, b1.w};
              float d[16]; float s = 0.f;
#pragma unroll
              for (int i = 0; i < 8; ++i) { d[2 * i] = bf_lo(aw[i]) - lam * bf_lo(bw[i]); d[2 * i + 1] = bf_hi(aw[i]) - lam * bf_hi(bw[i]); s += d[2 * i] * d[2 * i] + d[2 * i + 1] * d[2 * i + 1]; }
              s += __shfl_xor(s, 1); s += __shfl_xor(s, 2); s += __shfl_xor(s, 4);
              const float rs = __builtin_amdgcn_rsqf(s * (1.0f / 128.0f) + EPS);
              v4u o0, o1;
              o0.x = pk2(d[0] * rs * gs[0], d[1] * rs * gs[1]); o0.y = pk2(d[2] * rs * gs[2], d[3] * rs * gs[3]); o0.z = pk2(d[4] * rs * gs[4], d[5] * rs * gs[5]); o0.w = pk2(d[6] * rs * gs[6], d[7] * rs * gs[7]);
              o1.x = pk2(d[8] * rs * gs[8], d[9] * rs * gs[9]); o1.y = pk2(d[10] * rs * gs[10], d[11] * rs * gs[11]); o1.z = pk2(d[12] * rs * gs[12], d[13] * rs * gs[13]); o1.w = pk2(d[14] * rs * gs[14], d[15] * rs * gs[15]);
              v4u* yo = (v4u*)(YM + (size_t)row * 2048 + WA + lane * 16); yo[0] = o0; yo[1] = o1; }
            { const int t = row & (SEQ - 1); const bf16* pr = P + (size_t)row * NIN + lane * 8;
              const v4u bg = *(const v4u*)(pr + 4096), cg0 = *(const v4u*)(pr + 4608), xc0 = *(const v4u*)(pr + 5120);
              v4u cg1 = (v4u){0u, 0u, 0u, 0u}, xc1 = cg1, cg2 = cg1, xc2 = cg1;
              if (t >= 1) { cg1 = *(const v4u*)(pr - NIN + 4608); xc1 = *(const v4u*)(pr - NIN + 5120); }
              if (t >= 2) { cg2 = *(const v4u*)(pr - 2 * NIN + 4608); xc2 = *(const v4u*)(pr - 2 * NIN + 5120); }
              const unsigned bgw[4] = {bg.x, bg.y, bg.z, bg.w}, c0w[4] = {cg0.x, cg0.y, cg0.z, cg0.w}, x0w[4] = {xc0.x, xc0.y, xc0.z, xc0.w},
                             c1w[4] = {cg1.x, cg1.y, cg1.z, cg1.w}, x1w[4] = {xc1.x, xc1.y, xc1.z, xc1.w}, c2w[4] = {cg2.x, cg2.y, cg2.z, cg2.w}, x2w[4] = {xc2.x, xc2.y, xc2.z, xc2.w};
              unsigned ow[4];
#pragma unroll
              for (int i = 0; i < 4; ++i) {
                  const float ylo = bf_lo(bgw[i]) * (w0[2 * i] * (bf_lo(c2w[i]) * bf_lo(x2w[i])) + w1[2 * i] * (bf_lo(c1w[i]) * bf_lo(x1w[i])) + w2[2 * i] * (bf_lo(c0w[i]) * bf_lo(x0w[i])));
                  const float yhi = bf_hi(bgw[i]) * (w0[2 * i + 1] * (bf_hi(c2w[i]) * bf_hi(x2w[i])) + w1[2 * i + 1] * (bf_hi(c1w[i]) * bf_hi(x1w[i])) + w2[2 * i + 1] * (bf_hi(c0w[i]) * bf_hi(x0w[i])));
                  ow[i] = pk2(ylo, yhi); }
              *(v4u*)(YM + (size_t)row * 2048 + WA + WBW + lane * 8) = (v4u){ow[0], ow[1], ow[2], ow[3]}; }
        }
    }
    {
        constexpr int PITCH = 136;
        LAS bf16* WT = (LAS bf16*)(F.lds + RING_OFF);
        LAS bf16* VT = (LAS bf16*)(F.lds + RING_OFF + 128 * PITCH * 2);
        LAS float* RS = (LAS float*)(F.lds + RING_OFF + 2 * 128 * PITCH * 2);
        const pg8::ssq_t* ssv = (const pg8::ssq_t*)(ws + SS_OFF) + (size_t)(13 + l) * M;
        const float* wsg = ap->in[8] + (size_t)l * 4 * 128 * 128; const float* bsg = ap->in[9] + (size_t)l * 4 * 128; const float* gv = ap->in[7] + (size_t)l * WA;
        const int tid = F.tid, wave = F.wave, fr = lane & 15, fq = lane >> 4;
        for (int unit = blockIdx.x; unit < 512; unit += F.G) {
            const int ch = unit >> 2, g = unit & 3, r0 = ch * 128;
            __syncthreads();
            if (tid < 128) RS[tid] = __builtin_amdgcn_rsqf(pg8::ssq_dec(ssv[r0 + tid]) * (1.0f / WA) + EPS);
            __syncthreads();
            { const int t = tid >> 2, s0 = (tid & 3) * 32; const float* wrow = wsg + ((size_t)g * 128 + t) * 128 + s0;
#pragma unroll
              for (int j = 0; j < 4; ++j) { const f32x4 wa = *(const f32x4*)(wrow + 8 * j), wb = *(const f32x4*)(wrow + 8 * j + 4); const int s = s0 + 8 * j;
                  float e[8] = {wa.x, wa.y, wa.z, wa.w, wb.x, wb.y, wb.z, wb.w};
#pragma unroll
                  for (int i = 0; i < 8; ++i) e[i] = (s + i <= t) ? e[i] * RS[s + i] : 0.f;
                  *(LAS v4u*)(WT + t * PITCH + s) = (v4u){pk2(e[0], e[1]), pk2(e[2], e[3]), pk2(e[4], e[5]), pk2(e[6], e[7])}; } }
            { const int s = tid >> 2, c0 = (tid & 3) * 32; const bf16* vrow = P + (size_t)(r0 + s) * NIN + WA + g * 128 + c0;
#pragma unroll
              for (int j = 0; j < 4; ++j) { const v4u v = *(const v4u*)(vrow + 8 * j); const unsigned vw[4] = {v.x, v.y, v.z, v.w};
#pragma unroll
                  for (int i = 0; i < 4; ++i) { VT[(c0 + 8 * j + 2 * i) * PITCH + s] = (bf16)(vw[i] & 0xffffu); VT[(c0 + 8 * j + 2 * i + 1) * PITCH + s] = (bf16)(vw[i] >> 16); } } }
            __syncthreads();
            f32x4 acc[8];
#pragma unroll
            for (int j = 0; j < 8; ++j) acc[j] = (f32x4){0.f, 0.f, 0.f, 0.f};
#pragma unroll
            for (int kk = 0; kk < 4; ++kk) { const bf16x8 af = *(const LAS bf16x8*)(WT + (16 * wave + fr) * PITCH + kk * 32 + fq * 8);
#pragma unroll
                for (int j = 0; j < 8; ++j) { const bf16x8 bfv = *(const LAS bf16x8*)(VT + (16 * j + fr) * PITCH + kk * 32 + fq * 8);
                    acc[j] = __builtin_amdgcn_mfma_f32_16x16x32_bf16(bfv, af, acc[j], 0, 0, 0); } }
            const int t = 16 * wave + fr; const float bt = bsg[g * 128 + t];
#pragma unroll
            for (int j = 0; j < 8; ++j) { const int c = 16 * j + 4 * fq; const f32x4 gvv = *(const f32x4*)(gv + g * 128 + c);
                const unsigned long long uu = *(const unsigned long long*)(P + (size_t)(r0 + t) * NIN + g * 128 + c); const unsigned ulo = (unsigned)uu, uhi = (unsigned)(uu >> 32);
                const float y0 = bf_lo(ulo) * (acc[j][0] * gvv.x + bt), y1 = bf_hi(ulo) * (acc[j][1] * gvv.y + bt), y2 = bf_lo(uhi) * (acc[j][2] * gvv.z + bt), y3 = bf_hi(uhi) * (acc[j][3] * gvv.w + bt);
                *(unsigned long long*)(YM + (size_t)(r0 + t) * 2048 + g * 128 + c) = (unsigned long long)pk2(y0, y1) | ((unsigned long long)pk2(y2, y3) << 32); }
        }
        __syncthreads();
    }
}

__device__ __forceinline__ void phase_final(Frame& F0) {
    Frame F = F0; asm volatile("" : "+v"(F.tid), "+v"(F.lane));
    const ArgsP ap = get_args();
    const int gw = F.vcu * NWAVES + F.wave, NGW = F.G * NWAVES;
    const float* xr = (const float*)(ap->ws + WS_XR); const pg8::ssq_t* ss = (const pg8::ssq_t*)(ap->ws + SS_OFF) + (size_t)12 * M; const float* gf = ap->in[18];
    f32x4 g[8];
#pragma unroll
    for (int j = 0; j < 8; ++j) g[j] = ((const f32x4*)gf)[F.lane + 64 * j];
    for (int m = gw; m < M; m += NGW) { const float rs = __builtin_amdgcn_rsqf(pg8::ssq_dec(ss[m]) * (1.0f / DM) + EPS);
        const GAS f32x4* xi = (const GAS f32x4*)(xr + (size_t)m * DM) + F.lane; GAS f32x4* xo = (GAS f32x4*)(ap->out + (size_t)m * DM) + F.lane;
#pragma unroll
        for (int j = 0; j < 8; ++j) xo[64 * j] = xi[64 * j] * rs * g[j]; }
}

__global__ void __launch_bounds__(NWAVES * 64, 2) mega_fwd(Args args) {
    extern __shared__ __attribute__((aligned(16))) unsigned char lds[];
    Frame F;
    F.lds = (LAS unsigned char*)lds;
    F.MISC = (volatile LAS unsigned*)(F.lds + MISC_OFF);
    F.tid = threadIdx.x; F.lane = F.tid & 63; F.wave = __builtin_amdgcn_readfirstlane(F.tid >> 6);
    F.G = gridDim.x; { const int bx = blockIdx.x; F.vcu = (F.G % 8 == 0) ? (bx % 8) * (F.G / 8) + bx / 8 : bx; }
    F.ctl = (gu32*)(get_args()->ws + WS_CTL);
    for (int u = F.tid; u < (LDS_BYTES - LDSCTL_OFF) / 4; u += NWAVES * 64) ((LAS unsigned*)(F.lds + LDSCTL_OFF))[u] = 0u;
    __syncthreads();
    XcdBarrier bar = xcd_barrier_post((unsigned*)(F.ctl + CW_BAR), F.MISC + 8);
#define GRID_BAR() xcd_barrier(bar)
#define WSP(T, off) ((T*)(ws + (off)))

    for (int l = 0; l < DEPTH; ++l) {
#ifndef SKIP_W
        phase_weights(F, l);
#endif
        GRID_BAR();
        for (int half = 0; half < 2; ++half) {
            if (half == 1) {
#ifndef SKIP_GIN
                { unsigned char* ws = get_args()->ws; pg8::ssq_t* SS = WSP(pg8::ssq_t, SS_OFF);
                  pg8::Gemm g{WSP(bf16, WS_XB), WSP(const bf16, WS_WIN), M, NIN, DM}; pg8::StaticOrder S; S.init(M, NIN, F.G, (int)blockIdx.x);
                  pg8::EpiProj E{WSP(bf16, WS_ACT), NIN, SS + (size_t)(3 * l + 1) * M, 1.0f / DM, SS + (size_t)(13 + l) * M, attn_body::C2, 4, 8, 2, 4};
                  pg8::gemm_phase<pg8::EpiProj, pg8::StaticOrder, true, true>(F.lds + RING_OFF, g, S, E); }
#endif
                GRID_BAR();
#ifndef SKIP_ATT
                { unsigned char* ws = get_args()->ws;
                  const attn_body::AttnTensors AT{WSP(const attn_body::bf16, WS_ACT), WSP(attn_body::bf16, WS_OB)};
                  const attn_body::StaticOrder S((int)F.G, (int)blockIdx.x);
                  attn_body::attn_phase<attn_body::StaticOrder>((char*)lds + RING_OFF, AT, S); }
#endif
                GRID_BAR();
#ifndef SKIP_MIX
                phase_mixer_post(F, l);
#endif
                GRID_BAR();
#ifndef SKIP_GOUT
                { unsigned char* ws = get_args()->ws; pg8::ssq_t* SS = WSP(pg8::ssq_t, SS_OFF);
                  pg8::Gemm g{WSP(bf16, WS_YM), WSP(const bf16, WS_WOUT), M, DM, DM}; pg8::StaticOrder S; S.init(M, DM, F.G, (int)blockIdx.x);
                  pg8::EpiResid E{WSP(float, WS_XR), WSP(float, WS_XR), WSP(bf16, WS_XB), SS + (size_t)(3 * l + 2) * M, 1.0f, DM};
                  pg8::gemm_phase<pg8::EpiResid, pg8::StaticOrder, true, true>(F.lds + RING_OFF, g, S, E); }
#endif
                GRID_BAR();
            }
#ifndef SKIP_GGU
            { unsigned char* ws = get_args()->ws; pg8::ssq_t* SS = WSP(pg8::ssq_t, SS_OFF);
              pg8::Gemm g{WSP(bf16, WS_XB), (const bf16*)(ws + (half ? WS_WGU2 : WS_WGU1)), M, 2 * FF, DM}; pg8::StaticOrder S; S.init(M, 2 * FF, F.G, (int)blockIdx.x);
              pg8::EpiSwiGLU E{WSP(bf16, WS_ACT), FF, SS + (size_t)(3 * l + 2 * half) * M, 1.0f / DM};
              pg8::gemm_phase<pg8::EpiSwiGLU, pg8::StaticOrder, true, true>(F.lds + RING_OFF, g, S, E); }
#endif
            GRID_BAR();
#ifndef SKIP_GDN
            { const ArgsP ap = get_args(); unsigned char* ws = ap->ws; pg8::ssq_t* SS = WSP(pg8::ssq_t, SS_OFF);
              pg8::Gemm g{WSP(bf16, WS_ACT), (const bf16*)(ws + (half ? WS_WD2 : WS_WD1)), M, DM, FF}; pg8::StaticOrder S; S.init(M, DM, F.G, (int)blockIdx.x);
              pg8::EpiResid E{(l == 0 && half == 0) ? ap->in[0] : WSP(const float, WS_XR), WSP(float, WS_XR), WSP(bf16, WS_XB), SS + (size_t)(3 * l + 2 * half + 1) * M, 0.5f, DM};
              pg8::gemm_phase<pg8::EpiResid, pg8::StaticOrder, true, true>(F.lds + RING_OFF, g, S, E); }
#endif
            GRID_BAR();
        }
    }
#ifndef SKIP_FIN
    phase_final(F);
#endif
}

extern "C" void kernel_launch(void* const* d_in, const int* in_sizes, int n_in, void* d_out, int out_size, void* d_ws, size_t ws_size, hipStream_t stream) {
    static int grid = 0;
    if (grid == 0) {
        if (n_in != 19 || in_sizes[0] != M * DM || out_size != M * DM || ws_size < WS_END) { fprintf(stderr, "kernel_launch: unexpected shapes / workspace (%zu < %zu)\n", ws_size, (size_t)WS_END); grid = -1; return; }
        int dev = 0, cus = 0, per_cu = 0;
        if (hipGetDevice(&dev) != hipSuccess || hipDeviceGetAttribute(&cus, hipDeviceAttributeMultiprocessorCount, dev) != hipSuccess) { grid = -1; return; }
        if (hipFuncSetAttribute((const void*)mega_fwd, hipFuncAttributeMaxDynamicSharedMemorySize, LDS_BYTES) != hipSuccess) { grid = -1; return; }
        if (hipOccupancyMaxActiveBlocksPerMultiprocessor(&per_cu, (const void*)mega_fwd, NWAVES * 64, LDS_BYTES) != hipSuccess || per_cu < 1) { fprintf(stderr, "kernel_launch: occupancy query says %d\n", per_cu); }
        (void)hipGetLastError();
        grid = cus;
    }
    if (grid < 0) return;
    if (hipMemsetAsync((char*)d_ws + WS_CTL, 0, CTL_ZERO_BYTES, stream) != hipSuccess) return;
    Args a{};
    for (int i = 0; i < 19; ++i) a.in[i] = (const float*)d_in[i];
    a.out = (float*)d_out; a.ws = (unsigned char*)d_ws;
    hipLaunchKernelGGL(mega_fwd, dim3(grid), dim3(NWAVES * 64), LDS_BYTES, stream, a);
}
```

```cpp
#include <hip/hip_runtime.h>
#include <cstdio>
#include <cstdint>
#ifndef PROBE_W
#define PROBE_W 0
#endif
#ifndef PROBE_ATT
#define PROBE_ATT 0
#endif
#ifndef PROBE_MIX
#define PROBE_MIX 0
#endif
#ifndef PROBE_GGU
#define PROBE_GGU 0
#endif
#ifndef PROBE_GDN
#define PROBE_GDN 0
#endif
#ifndef PROBE_GOUT
#define PROBE_GOUT 0
#endif
#ifndef PROBE_GIN
#define PROBE_GIN 0
#endif
#ifndef PROBE_BAR
#define PROBE_BAR 0
#endif
#ifndef PROBE_SPLIT
#define PROBE_SPLIT 0
#endif
#ifndef W_UPFRONT
#define W_UPFRONT 1
#endif
namespace pg8 {
#define PG8_LAS __attribute__((address_space(3)))
typedef unsigned short bf16_t;
typedef short bf16x8 __attribute__((ext_vector_type(8)));
typedef float f32x4 __attribute__((ext_vector_type(4)));
typedef unsigned u32x4 __attribute__((ext_vector_type(4)));
constexpr int BM = 256, BK = 64, HALF = 128, HTB = HALF * BK * 2  , STAGE_BYTES = 8 * HTB, NXCD = 8, WGM = 8;

__host__ __device__ __forceinline__ int lds_byte(int r, int c) { const int st = (r >> 4) * 2 + (c >> 5), rr = r & 15, cc = c & 31, ob = rr * 64 + cc * 2; return st * 1024 + (ob ^ (((ob >> 9) & 1) << 5)); }
__host__ __device__ __forceinline__ void stage_rc(int b, int& R, int& C) { const int st = b / 1024, sb = b % 1024, swz = sb ^ (((sb >> 9) & 1) << 5); R = (st >> 1) * 16 + swz / 64; C = (st & 1) * 32 + (swz % 64) / 2; }
__host__ __device__ __forceinline__ int perm32(int rho) { const int n = rho >> 4, i = rho & 15; return 8 * (i >> 2) + 4 * n + (i & 3); }

struct Unit { int pm, pn; };
struct Gemm { const bf16_t* A; const bf16_t* Bt; int M, N, K; };

struct StaticOrder {
    int nM, nN, nwg, G, c, i_lo = 0, i_hi = 1 << 30;
    int tail = 0, tail_vcu = 0, pn_off = 0;
    __host__ __device__ void init(int M, int N, int G_, int c_) { nM = M / BM; nN = N / BM; nwg = nM * nN; G = G_; c = c_; }
    __host__ __device__ bool next(int i, Unit& u) const {
        if (tail) { if (tail != 1 || i > 0 || (tail_vcu & 1)) return false; u.pm = tail_vcu >> 2; u.pn = pn_off + ((tail_vcu >> 1) & 1); return true; }
        if (i + i_lo >= i_hi) return false;
        const long L = (long)(i + i_lo) * G + c; if (L >= nwg) return false;
        int wgid = (int)L; { const int q = nwg / NXCD, r = nwg % NXCD, xcd = wgid % NXCD, off = wgid / NXCD; wgid = (xcd < r ? xcd * (q + 1) : r * (q + 1) + (xcd - r) * q) + off; }
        const int nig = WGM * nN, gid = wgid / nig, fm = gid * WGM, gsz = (nM - fm) < WGM ? (nM - fm) : WGM;
        u.pm = fm + ((wgid % nig) % gsz); u.pn = (wgid % nig) / gsz; return true;
    }
    __device__ __forceinline__ void a_ready(const Unit&) const {}
    __device__ __forceinline__ void done(const Unit&) const {}
};

__device__ __forceinline__ unsigned cvt_pk_bf16(float lo, float hi) { unsigned r; asm volatile("v_cvt_pk_bf16_f32 %0, %1, %2" : "=v"(r) : "v"(lo), "v"(hi)); return r; }
typedef float f32x2 __attribute__((ext_vector_type(2)));
constexpr float RMS_EPS = 1e-6f;
typedef unsigned long long ssq_t;
constexpr float SSQ_SCALE = 1073741824.0f, SSQ_INV = 1.0f / 1073741824.0f;
__device__ __forceinline__ ssq_t ssq_enc(float v) { return (ssq_t)(long long)(v * SSQ_SCALE); }
__device__ __forceinline__ float ssq_dec(ssq_t v) { return (float)(long long)v * SSQ_INV; }
__device__ __forceinline__ void ssq_add(ssq_t* p, float v) { (void)__hip_atomic_fetch_add(p, ssq_enc(v), __ATOMIC_RELAXED, __HIP_MEMORY_SCOPE_AGENT); }
struct EpiSwiGLU {
    static constexpr bool PERM = true, AFTER_DRAIN = false;
    bf16_t* O; int ldc; const ssq_t* ss; float inv_k;
    const PG8_LAS float* rstab; int rowbase;
    __device__ __forceinline__ void operator()(const f32x4 (&acc)[2][2][4][2], const Unit& u, int wr, int wc, int fr, int fq) const {
        const int row0 = u.pm * BM + wr * 64 + fr, col0 = u.pn * HALF + wc * 32 + 8 * fq;
        float rsv[8];
        if (rstab) {
#pragma unroll
            for (int i = 0; i < 8; ++i) rsv[i] = rstab[row0 - rowbase + (i >> 2) * HALF + (i & 3) * 16];
        } else { ssq_t sv[8];
#pragma unroll
            for (int i = 0; i < 8; ++i) sv[i] = ss[row0 + (i >> 2) * HALF + (i & 3) * 16];
#pragma unroll
            for (int i = 0; i < 8; ++i) rsv[i] = __builtin_amdgcn_rsqf(ssq_dec(sv[i]) * inv_k + RMS_EPS); }
#pragma unroll
        for (int ai = 0; ai < 2; ++ai)
#pragma unroll
            for (int m = 0; m < 4; ++m) { const int row = row0 + ai * HALF + m * 16; const float rs = rsv[ai * 4 + m];
                const float k1 = rs * -1.4426950408889634f, k2 = rs * rs; f32x2 o[4];
#pragma unroll
                for (int n = 0; n < 2; ++n)
#pragma unroll
                    for (int h = 0; h < 2; ++h) { const f32x2 g = (f32x2){acc[ai][0][m][n][2 * h], acc[ai][0][m][n][2 * h + 1]}, up = (f32x2){acc[ai][1][m][n][2 * h], acc[ai][1][m][n][2 * h + 1]};
                        const f32x2 t = g * k1; f32x2 e; e.x = __builtin_amdgcn_exp2f(t.x); e.y = __builtin_amdgcn_exp2f(t.y);
                        const f32x2 d = e + 1.0f; f32x2 r; r.x = __builtin_amdgcn_rcpf(d.x); r.y = __builtin_amdgcn_rcpf(d.y);
                        o[2 * n + h] = ((g * up) * k2) * r; }
                u32x4 w; w.x = cvt_pk_bf16(o[0].x, o[0].y); w.y = cvt_pk_bf16(o[1].x, o[1].y); w.z = cvt_pk_bf16(o[2].x, o[2].y); w.w = cvt_pk_bf16(o[3].x, o[3].y);
                *(u32x4*)(O + (size_t)row * ldc + col0) = w; }
    }
};
constexpr int NRM_K_WORD = 64 * 32;
struct EpiProj {
    static constexpr bool PERM = true, AFTER_DRAIN = false;
    bf16_t* O; int ldc; const ssq_t* ss; float inv_k; ssq_t* ssv; float qscale; int q_lo, q_hi, v_lo, v_hi;
    const PG8_LAS float* rstab; int rowbase;
    unsigned* nrm = nullptr;
    __device__ __forceinline__ void operator()(const f32x4 (&acc)[2][2][4][2], const Unit& u, int wr, int wc, int fr, int fq) const {
        const int row0 = u.pm * BM + wr * 64 + fr, col0 = u.pn * BM + wc * 32 + 8 * fq;
        const float cs = (u.pn >= q_lo && u.pn < q_hi) ? qscale : 1.0f; const bool isv = (u.pn >= v_lo && u.pn < v_hi);
        const bool isn = nrm && (u.pn >= q_lo && u.pn < 2 * q_hi - q_lo); float nmx0 = 0.f, nmx1 = 0.f;
        float rsv[8];
        if (rstab) {
#pragma unroll
            for (int i = 0; i < 8; ++i) rsv[i] = rstab[row0 - rowbase + (i >> 2) * HALF + (i & 3) * 16];
        } else { ssq_t sv[8];
#pragma unroll
            for (int i = 0; i < 8; ++i) sv[i] = ss[row0 + (i >> 2) * HALF + (i & 3) * 16];
#pragma unroll
            for (int i = 0; i < 8; ++i) rsv[i] = __builtin_amdgcn_rsqf(ssq_dec(sv[i]) * inv_k + RMS_EPS); }
#pragma unroll
        for (int ai = 0; ai < 2; ++ai)
#pragma unroll
            for (int m = 0; m < 4; ++m) { const int row = row0 + ai * HALF + m * 16; const float rs = rsv[ai * 4 + m] * cs; float sqb[2];
#pragma unroll
                for (int bj = 0; bj < 2; ++bj) { const f32x4 v0 = acc[ai][bj][m][0] * rs, v1 = acc[ai][bj][m][1] * rs;
                    sqb[bj] = (v0[0] * v0[0] + v0[1] * v0[1]) + (v0[2] * v0[2] + v0[3] * v0[3]) + (v1[0] * v1[0] + v1[1] * v1[1]) + (v1[2] * v1[2] + v1[3] * v1[3]);
                    u32x4 w; w.x = cvt_pk_bf16(v0[0], v0[1]); w.y = cvt_pk_bf16(v0[2], v0[3]); w.z = cvt_pk_bf16(v1[0], v1[1]); w.w = cvt_pk_bf16(v1[2], v1[3]);
                    *(u32x4*)(O + (size_t)row * ldc + col0 + bj * HALF) = w; }
                if (isv) { float sq = sqb[0] + sqb[1]; sq += __shfl_xor(sq, 16); sq += __shfl_xor(sq, 32); if (fq == 0) ssq_add(ssv + row, sq); }
                if (isn) { float a = sqb[0], b = sqb[1]; a += __shfl_xor(a, 16); b += __shfl_xor(b, 16); a += __shfl_xor(a, 32); b += __shfl_xor(b, 32);
                    nmx0 = fmaxf(nmx0, a); nmx1 = fmaxf(nmx1, b); } }
        if (isn) {
#pragma unroll
            for (int d = 1; d < 16; d <<= 1) { nmx0 = fmaxf(nmx0, __shfl_xor(nmx0, d)); nmx1 = fmaxf(nmx1, __shfl_xor(nmx1, d)); }
            const bool isq = u.pn < q_hi; const int g8 = (u.pn - (isq ? q_lo : q_hi)) * 8 + wc;
            unsigned* t = nrm + (isq ? (u.pm * 32) : (NRM_K_WORD + (u.pm >> 4) * 32)) + g8;
            if (fr == 0 && fq == 0) { (void)__hip_atomic_fetch_max(t, __float_as_uint(nmx0), __ATOMIC_RELAXED, __HIP_MEMORY_SCOPE_AGENT); (void)__hip_atomic_fetch_max(t + 4, __float_as_uint(nmx1), __ATOMIC_RELAXED, __HIP_MEMORY_SCOPE_AGENT); } }
    }
};
struct EpiResid {
    static constexpr bool PERM = true, AFTER_DRAIN = false;
    const float* xin_f32; bf16_t* xb; ssq_t* ss_out; float alpha; int ldc; int do_ss;
    __device__ __forceinline__ void operator()(const f32x4 (&acc)[2][2][4][2], const Unit& u, int wr, int wc, int fr, int fq) const {
        const int row0 = u.pm * BM + wr * 64 + fr, col0 = u.pn * BM + wc * 32 + 8 * fq;
#pragma unroll
        for (int ai = 0; ai < 2; ++ai)
#pragma unroll
            for (int m = 0; m < 4; ++m) { const int row = row0 + ai * HALF + m * 16; const size_t off = (size_t)row * ldc + col0; float sq = 0.f;
#pragma unroll
                for (int bj = 0; bj < 2; ++bj) { f32x4 b0, b1;
                    if (xin_f32) { b0 = *(const f32x4*)(xin_f32 + off + bj * HALF); b1 = *(const f32x4*)(xin_f32 + off + bj * HALF + 4); }
                    else { const u32x4 x = *(const u32x4*)(xb + off + bj * HALF);
                        b0 = (f32x4){__uint_as_float(x.x << 16), __uint_as_float(x.x & 0xffff0000u), __uint_as_float(x.y << 16), __uint_as_float(x.y & 0xffff0000u)};
                        b1 = (f32x4){__uint_as_float(x.z << 16), __uint_as_float(x.z & 0xffff0000u), __uint_as_float(x.w << 16), __uint_as_float(x.w & 0xffff0000u)}; }
                    const f32x4 v0 = b0 + acc[ai][bj][m][0] * alpha, v1 = b1 + acc[ai][bj][m][1] * alpha;
                    u32x4 w; w.x = cvt_pk_bf16(v0[0], v0[1]); w.y = cvt_pk_bf16(v0[2], v0[3]); w.z = cvt_pk_bf16(v1[0], v1[1]); w.w = cvt_pk_bf16(v1[2], v1[3]);
                    *(u32x4*)(xb + off + bj * HALF) = w;
                    const float r0 = __uint_as_float(w.x << 16), r1 = __uint_as_float(w.x & 0xffff0000u), r2 = __uint_as_float(w.y << 16), r3 = __uint_as_float(w.y & 0xffff0000u),
                                r4 = __uint_as_float(w.z << 16), r5 = __uint_as_float(w.z & 0xffff0000u), r6 = __uint_as_float(w.w << 16), r7 = __uint_as_float(w.w & 0xffff0000u);
                    sq += (r0 * r0 + r1 * r1) + (r2 * r2 + r3 * r3) + (r4 * r4 + r5 * r5) + (r6 * r6 + r7 * r7); }
                sq += __shfl_xor(sq, 16); sq += __shfl_xor(sq, 32); if (fq == 0 && do_ss) ssq_add(ss_out + row, sq);
                if (m & 1) asm volatile("" ::: "memory"); }
    }
};

template <class Epi, class Sched, bool ALIGN_EPI = false, bool SP2 = false>
__device__ __forceinline__ void gemm_phase(PG8_LAS unsigned char* lds, const Gemm g, const Sched& S, const Epi& E) {
    int tid_ = threadIdx.x; asm volatile("" : "+v"(tid_));
    const int tid = tid_, wid = __builtin_amdgcn_readfirstlane(tid >> 6), lane = tid & 63, wr = wid >> 2, wc = wid & 3, fr = lane & 15, fq = lane >> 4;
    const int K = g.K, nt = K / BK;
    unsigned voffA[2], voffB[2];
#pragma unroll
    for (int i = 0; i < 2; ++i) { int R, C; stage_rc(tid * 16 + i * 8192, R, C); const int Rb = Epi::PERM ? ((R & ~31) + perm32(R & 31)) : R;
        voffA[i] = (unsigned)(R * K + C) * 2u; voffB[i] = (unsigned)(Rb * K + C) * 2u; }
    const size_t kstep = (size_t)(BK * 2);
    const size_t hstep = (size_t)HALF * K * 2;
    const size_t tstep = 2 * hstep;
    const unsigned ldsw = (unsigned)wid * 1024u;
    const int aoff = lds_byte(wr * 64 + fr, fq * 8), boff = lds_byte(wc * 32 + fr, fq * 8);
#define PG8_SA(b, h) (((b) * 2 + (h)) * HTB)
#define PG8_SB(b, h) ((4 + (b) * 2 + (h)) * HTB)
#define PG8_STAGE(bufoff, gbase, voff) do { _Pragma("unroll") for (int _i = 0; _i < 2; ++_i) \
        __builtin_amdgcn_global_load_lds((const unsigned*)((const char*)(gbase) + (voff)[_i]), (PG8_LAS unsigned*)(lds + (bufoff) + ldsw + _i * 8192), 16, 0, 0); } while (0)
#define PG8_LDA(dst, b, h) do { _Pragma("unroll") for (int m = 0; m < 4; ++m) _Pragma("unroll") for (int k = 0; k < 2; ++k) dst[m][k] = *(const PG8_LAS bf16x8*)(lds + PG8_SA(b, h) + aoff + m * 2048 + k * 1024); } while (0)
#define PG8_LDB(dst, b, h) do { _Pragma("unroll") for (int n = 0; n < 2; ++n) _Pragma("unroll") for (int k = 0; k < 2; ++k) dst[n][k] = *(const PG8_LAS bf16x8*)(lds + PG8_SB(b, h) + boff + n * 2048 + k * 1024); } while (0)
#define PG8_MMA(ai, bj, At, Bt) do { __builtin_amdgcn_s_setprio(1); _Pragma("unroll") for (int n = 0; n < 2; ++n) _Pragma("unroll") for (int m = 0; m < 4; ++m) _Pragma("unroll") for (int k = 0; k < 2; ++k) { \
        acc[ai][bj][m][n] = __builtin_amdgcn_mfma_f32_16x16x32_bf16(Bt[n][k], At[m][k], acc[ai][bj][m][n], 0, 0, 0); __builtin_amdgcn_sched_barrier(0); } __builtin_amdgcn_s_setprio(0); } while (0)
#define PG8_MFMA1(ai, bj, Bt, m, n, k) do { acc[ai][bj][m][n] = __builtin_amdgcn_mfma_f32_16x16x32_bf16(Bt[n][k], At[m][k], acc[ai][bj][m][n], 0, 0, 0); __builtin_amdgcn_sched_barrier(0); } while (0)
#define PG8_MMA2(ai) do { __builtin_amdgcn_s_setprio(1); _Pragma("unroll") for (int m = 0; m < 4; ++m) { PG8_MFMA1(ai, 0, B0, m, 0, 0); PG8_MFMA1(ai, 0, B0, m, 0, 1); PG8_MFMA1(ai, 0, B0, m, 1, 1); PG8_MFMA1(ai, 0, B0, m, 1, 0); \
        PG8_MFMA1(ai, 1, B1, m, 0, 0); PG8_MFMA1(ai, 1, B1, m, 0, 1); PG8_MFMA1(ai, 1, B1, m, 1, 1); PG8_MFMA1(ai, 1, B1, m, 1, 0); } __builtin_amdgcn_s_setprio(0); } while (0)
#define PG8_WAIT_V(n) asm volatile("s_waitcnt vmcnt(" #n ")" ::: "memory")
#define PG8_WAIT_L(n) asm volatile("s_waitcnt lgkmcnt(" #n ")" ::: "memory")
#define PG8_BAR __builtin_amdgcn_s_barrier()
#define PG8_SCHED __builtin_amdgcn_sched_barrier(0)
    Unit cur, nxt; int ui = 0;
    if (!S.next(0, cur)) return;
    f32x4 acc[2][2][4][2];
#pragma unroll
    for (int a = 0; a < 2; ++a)
#pragma unroll
        for (int b = 0; b < 2; ++b)
#pragma unroll
            for (int m = 0; m < 4; ++m)
#pragma unroll
                for (int n = 0; n < 2; ++n) acc[a][b][m][n] = (f32x4){0.f, 0.f, 0.f, 0.f};
    bf16x8 At[4][2], B0[2][2], B1[2][2];
    const char* cA = (const char*)g.A + (size_t)cur.pm * tstep; const char* cB = (const char*)g.Bt + (size_t)cur.pn * tstep;
    S.a_ready(cur);
    if constexpr (SP2) {
        PG8_STAGE(PG8_SB(0, 0), cB, voffB); PG8_STAGE(PG8_SB(0, 1), cB + hstep, voffB); PG8_STAGE(PG8_SA(0, 0), cA, voffA); PG8_STAGE(PG8_SA(0, 1), cA + hstep, voffA);
        if (wr == 1) PG8_BAR;
        PG8_WAIT_V(2); PG8_BAR;
        PG8_STAGE(PG8_SB(1, 0), cB + kstep, voffB); PG8_STAGE(PG8_SA(1, 0), cA + kstep, voffA); PG8_STAGE(PG8_SB(1, 1), cB + hstep + kstep, voffB);
        PG8_WAIT_V(6); PG8_BAR;
    } else {
        PG8_STAGE(PG8_SB(0, 0), cB, voffB); PG8_STAGE(PG8_SA(0, 0), cA, voffA); PG8_STAGE(PG8_SB(0, 1), cB + hstep, voffB); PG8_STAGE(PG8_SA(0, 1), cA + hstep, voffA);
        if (wr == 1) PG8_BAR;
        PG8_WAIT_V(4); PG8_BAR;
        PG8_STAGE(PG8_SB(1, 0), cB + kstep, voffB); PG8_STAGE(PG8_SA(1, 0), cA + kstep, voffA); PG8_STAGE(PG8_SB(1, 1), cB + hstep + kstep, voffB);
        PG8_WAIT_V(6); PG8_BAR;
    }
    for (;;) {
        const bool has_next = S.next(ui + 1, nxt);
        const char* nA = has_next ? (const char*)g.A + (size_t)nxt.pm * tstep : cA; const char* nB = has_next ? (const char*)g.Bt + (size_t)nxt.pn * tstep : cB;
        for (int t = 0; t < nt; t += 2) {
            const bool last = (t == nt - 2);
            const char* a1 = cA + (size_t)(t + 1) * kstep;
            const char* a2 = last ? nA : cA + (size_t)(t + 2) * kstep; const char* b2 = last ? nB : cB + (size_t)(t + 2) * kstep;
            const char* a3 = a2 + kstep; const char* b3 = b2 + kstep;
            if (last && has_next) S.a_ready(nxt);
            if constexpr (SP2) {
            PG8_LDB(B0, 0, 0); PG8_LDB(B1, 0, 1); PG8_SCHED; PG8_LDA(At, 0, 0); PG8_STAGE(PG8_SA(1, 1), a1 + hstep, voffA);
            PG8_WAIT_V(8); PG8_WAIT_L(0); PG8_BAR; PG8_MMA2(0); PG8_BAR; PG8_SCHED;
            PG8_LDA(At, 0, 1); PG8_STAGE(PG8_SB(0, 0), b2, voffB); PG8_STAGE(PG8_SB(0, 1), b2 + hstep, voffB); PG8_STAGE(PG8_SA(0, 0), a2, voffA);
            PG8_WAIT_V(8); PG8_WAIT_L(0); PG8_BAR; PG8_MMA2(1); PG8_BAR; PG8_SCHED;
            PG8_LDB(B0, 1, 0); PG8_LDB(B1, 1, 1); PG8_SCHED; PG8_LDA(At, 1, 0); PG8_STAGE(PG8_SA(0, 1), a2 + hstep, voffA);
            PG8_WAIT_V(8); PG8_WAIT_L(0); PG8_BAR; PG8_MMA2(0); PG8_BAR; PG8_SCHED;
            PG8_LDA(At, 1, 1); PG8_STAGE(PG8_SB(1, 0), b3, voffB); PG8_STAGE(PG8_SB(1, 1), b3 + hstep, voffB); PG8_STAGE(PG8_SA(1, 0), a3, voffA);
            PG8_WAIT_V(8); PG8_WAIT_L(0); PG8_BAR; PG8_MMA2(1); PG8_BAR; PG8_SCHED;
            } else {
            PG8_LDB(B0, 0, 0); PG8_SCHED; PG8_LDA(At, 0, 0); PG8_STAGE(PG8_SA(1, 1), a1 + hstep, voffA);
            PG8_WAIT_L(8); PG8_BAR; PG8_WAIT_L(0); PG8_MMA(0, 0, At, B0); PG8_BAR; PG8_SCHED;
            PG8_LDB(B1, 0, 1); PG8_STAGE(PG8_SB(0, 0), b2, voffB);
            PG8_BAR; PG8_WAIT_L(0); PG8_MMA(0, 1, At, B1); PG8_BAR;
            PG8_LDA(At, 0, 1); PG8_STAGE(PG8_SA(0, 0), a2, voffA);
            PG8_BAR; PG8_WAIT_L(0); PG8_MMA(1, 0, At, B0); PG8_BAR; PG8_SCHED;
            PG8_STAGE(PG8_SB(0, 1), b2 + hstep, voffB);
            PG8_WAIT_V(6); PG8_BAR; PG8_MMA(1, 1, At, B1); PG8_BAR;
            PG8_LDB(B0, 1, 0); PG8_SCHED; PG8_LDA(At, 1, 0); PG8_STAGE(PG8_SA(0, 1), a2 + hstep, voffA);
            PG8_WAIT_L(8); PG8_BAR; PG8_WAIT_L(0); PG8_MMA(0, 0, At, B0); PG8_BAR; PG8_SCHED;
            PG8_LDB(B1, 1, 1); PG8_STAGE(PG8_SB(1, 0), b3, voffB);
            PG8_BAR; PG8_WAIT_L(0); PG8_MMA(0, 1, At, B1); PG8_BAR;
            PG8_LDA(At, 1, 1); PG8_STAGE(PG8_SA(1, 0), a3, voffA);
            PG8_BAR; PG8_WAIT_L(0); PG8_MMA(1, 0, At, B0); PG8_BAR; PG8_SCHED;
            PG8_STAGE(PG8_SB(1, 1), b3 + hstep, voffB);
            PG8_WAIT_V(6); PG8_BAR; PG8_MMA(1, 1, At, B1); PG8_BAR;
            }
        }
        if constexpr (ALIGN_EPI) { if (wr == 0) PG8_BAR; }
        if constexpr (!Epi::AFTER_DRAIN) { E(acc, cur, wr, wc, fr, fq); S.done(cur); }
        if (!has_next) break;
#pragma unroll
        for (int a = 0; a < 2; ++a)
#pragma unroll
            for (int b = 0; b < 2; ++b)
#pragma unroll
                for (int m = 0; m < 4; ++m)
#pragma unroll
                    for (int n = 0; n < 2; ++n) acc[a][b][m][n] = (f32x4){0.f, 0.f, 0.f, 0.f};
        cur = nxt; cA = nA; cB = nB; ++ui;
        if constexpr (ALIGN_EPI) { if (wr == 1) PG8_BAR; }
    }
    PG8_WAIT_V(0);
    if constexpr (!ALIGN_EPI) { if (wr == 0) PG8_BAR; }
    PG8_BAR;
    if constexpr (Epi::AFTER_DRAIN) { E.fused(acc, cur, wr, wc, fr, fq, lds, wid, lane); S.done(cur); }
#undef PG8_SA
#undef PG8_SB
#undef PG8_STAGE
#undef PG8_LDA
#undef PG8_LDB
#undef PG8_MMA
#undef PG8_MMA2
#undef PG8_MFMA1
#undef PG8_WAIT_V
#undef PG8_WAIT_L
#undef PG8_BAR
#undef PG8_SCHED
}
}
#include <hip/hip_bf16.h>
#include <cmath>
namespace attn_body {
using bf16=__hip_bfloat16;
using bf16x8=__attribute__((ext_vector_type(8)))short;
using s16x4=__attribute__((ext_vector_type(4)))short;
using f32x16=__attribute__((ext_vector_type(16)))float;
using u32x4=__attribute__((ext_vector_type(4)))unsigned;
constexpr int SEQ=4096,D=64,DM=5632,DMO=2048;
constexpr int NW=8,QBLK=32,QB=QBLK*NW,KVBLK=64,NQB=SEQ/QB;
constexpr int ATTN_PITCH=DM, ATTN_UNIT_ROWS=QB;
constexpr float LOG2E=1.4426950408889634f;
__device__ __forceinline__ int crow(int r,int hi){return (r&3)+8*(r>>2)+4*hi;}
#define SBAR() __builtin_amdgcn_sched_barrier(0)
__device__ __forceinline__ void cmask(f32x16&p0,f32x16&p1,int jb,int qrel,int hi){
  const float NEG=-INFINITY; int kb=64*jb+4*hi;
  #pragma unroll
  for(int r=0;r<16;++r){int kv=kb+(r&3)+8*(r>>2); if(kv>qrel)p0[r]=NEG; if(kv+32>qrel)p1[r]=NEG;}
}

constexpr int NSLOT=3, SLOTB=8192, VSLOTB=16384;
constexpr int LDS_K=0, LDS_V=NSLOT*SLOTB, LDS_WS=LDS_V+NSLOT*VSLOTB, LDS_OST=LDS_WS+NW*64*4, LDS_BYTES=LDS_OST+NW*4096;
constexpr float C2=0.125f*1.4426950408889634f;
__device__ __forceinline__ void glds16(const void*gsrc,unsigned lds_dst){unsigned keep;
  asm volatile("s_mov_b32 %0, m0\n\ts_mov_b32 m0, %2\n\ts_nop 0\n\tglobal_load_lds_dwordx4 %1, off\n\ts_mov_b32 m0, %0":"=&s"(keep):"v"(gsrc),"s"(lds_dst):"memory");}
__device__ __forceinline__ float max3f(float a,float b,float c){float r;asm("v_max3_f32 %0, %1, %2, %3":"=v"(r):"v"(a),"v"(b),"v"(c));return r;}
__device__ __forceinline__ float max2f(float a,float b){float r;asm("v_max_f32_e32 %0, %1, %2":"=v"(r):"v"(a),"v"(b));return r;}
__device__ __forceinline__ float fadd_s(float a,float b){float r;asm("v_add_f32_e32 %0, %1, %2":"=v"(r):"v"(a),"v"(b));return r;}
__device__ __forceinline__ float fsub_s(float a,float b){float r;asm("v_sub_f32_e32 %0, %1, %2":"=v"(r):"v"(a),"v"(b));return r;}
typedef float f32x2_t __attribute__((ext_vector_type(2))); typedef __bf16 bf16x2_t __attribute__((ext_vector_type(2)));
__device__ __forceinline__ unsigned cvtpk_s(float lo,float hi){f32x2_t v={lo,hi};bf16x2_t b=__builtin_convertvector(v,bf16x2_t);return __builtin_bit_cast(unsigned,b);}
#define WAIT_BAR(N) asm volatile("s_waitcnt vmcnt(" #N ") lgkmcnt(0)\n\ts_barrier":::"memory")

__device__ __forceinline__ void qkt(f32x16&p0,f32x16&p1,const char*Kslot,const bf16x8*qr,bf16x8 ka0,bf16x8 ka1,bf16x8 qa,int r32,int hi){
  const char*kb=Kslot+hi*1024+r32*16;
  const f32x16 z=f32x16{};
  p0=__builtin_amdgcn_mfma_f32_32x32x16_bf16(ka0,qa,z,0,0,0);p1=__builtin_amdgcn_mfma_f32_32x32x16_bf16(ka1,qa,z,0,0,0);
  #pragma unroll
  for(int d0=0;d0<4;++d0){
    const bf16x8 b0=*reinterpret_cast<const bf16x8*>(kb+d0*2048);
    const bf16x8 b1=*reinterpret_cast<const bf16x8*>(kb+d0*2048+512);
    p0=__builtin_amdgcn_mfma_f32_32x32x16_bf16(b0,qr[d0],p0,0,0,0);p1=__builtin_amdgcn_mfma_f32_32x32x16_bf16(b1,qr[d0],p1,0,0,0);}
}
typedef __attribute__((address_space(3))) const char* lds_cptr;
typedef short v4i16_t __attribute__((ext_vector_type(4)));
__device__ __forceinline__ void kload8(bf16x8*kf,lds_cptr kp){
  kf[0]=*(const __attribute__((address_space(3))) bf16x8*)(kp);      kf[1]=*(const __attribute__((address_space(3))) bf16x8*)(kp+512);
  kf[2]=*(const __attribute__((address_space(3))) bf16x8*)(kp+2048); kf[3]=*(const __attribute__((address_space(3))) bf16x8*)(kp+2560);
  kf[4]=*(const __attribute__((address_space(3))) bf16x8*)(kp+4096); kf[5]=*(const __attribute__((address_space(3))) bf16x8*)(kp+4608);
  kf[6]=*(const __attribute__((address_space(3))) bf16x8*)(kp+6144); kf[7]=*(const __attribute__((address_space(3))) bf16x8*)(kp+6656);
}
__device__ __forceinline__ void kload2(bf16x8*kf,lds_cptr kp,int j){ kf[2*j]=*(const __attribute__((address_space(3))) bf16x8*)(kp+j*2048); kf[2*j+1]=*(const __attribute__((address_space(3))) bf16x8*)(kp+j*2048+512); }
__device__ __forceinline__ s16x4 vtr(lds_cptr p){ return __builtin_bit_cast(s16x4,__builtin_amdgcn_ds_read_tr16_b64_v4i16((__attribute__((address_space(3))) v4i16_t*)p)); }
__device__ __forceinline__ float rowmax(const f32x16&p0,const f32x16&p1){
  float a=max3f(p0[0],p0[1],p1[0]),b=max3f(p0[2],p0[3],p1[1]);a=max3f(a,p1[2],p1[3]);
  #pragma unroll
  for(int r=4;r<16;r+=4){a=max3f(a,p0[r],p0[r+1]);b=max3f(b,p0[r+2],p0[r+3]);a=max3f(a,p1[r],p1[r+1]);b=max3f(b,p1[r+2],p1[r+3]);}
  const float m=max2f(a,b);
  auto rr=__builtin_amdgcn_permlane32_swap(__float_as_uint(m),__float_as_uint(m),false,false);
  return max2f(__uint_as_float(rr[0]),__uint_as_float(rr[1]));
}
__device__ __forceinline__ void pv(f32x16*o,int vb,bf16x8 pa0,bf16x8 pa1,bf16x8 pa2,bf16x8 pa3){
  #pragma unroll
  for(int d0=0;d0<4;++d0){s16x4 lo[4],hi[4];
    #pragma unroll
    for(int ks=0;ks<4;++ks){
      asm volatile("ds_read_b64_tr_b16 %0,%1 offset:%c2":"=&v"(lo[ks]):"v"(vb),"i"(d0*4096+ks*1024):"memory");
      asm volatile("ds_read_b64_tr_b16 %0,%1 offset:%c2":"=&v"(hi[ks]):"v"(vb),"i"(d0*4096+ks*1024+512):"memory");}
    asm volatile("s_waitcnt lgkmcnt(0)":::"memory");SBAR();
    #define PK(k) (bf16x8){lo[k][0],lo[k][1],lo[k][2],lo[k][3],hi[k][0],hi[k][1],hi[k][2],hi[k][3]}
    o[d0]=__builtin_amdgcn_mfma_f32_32x32x16_bf16(pa0,PK(0),o[d0],0,0,0);
    o[d0]=__builtin_amdgcn_mfma_f32_32x32x16_bf16(pa1,PK(1),o[d0],0,0,0);
    o[d0]=__builtin_amdgcn_mfma_f32_32x32x16_bf16(pa2,PK(2),o[d0],0,0,0);
    o[d0]=__builtin_amdgcn_mfma_f32_32x32x16_bf16(pa3,PK(3),o[d0],0,0,0);
    #undef PK
  }
}

#ifndef ATTN_STORE16
#define ATTN_STORE16(p,v) (*(u32x4*)(p)=(v))
#endif
template<int THRL> __device__ __forceinline__ void attn_unit(int qb,const bf16*Qh,const bf16*__restrict__ Kh,const bf16*__restrict__ Vh,bf16*Oh,float sl2,char*shm,int nte,float bnd,float inv64c){
  int tid_=threadIdx.x; asm volatile("":"+v"(tid_)); const int tid=tid_,lane=tid&63,r32=lane&31,hi=lane>>5; const int wid=__builtin_amdgcn_readfirstlane(tid>>6);
  const int q0=qb*QB;
  const bf16*Qw=Qh+(long)(q0+wid*QBLK)*DM;
  const unsigned lds0=(unsigned)(uintptr_t)shm;
  float*wsf=(float*)(shm+LDS_WS)+wid*64;
  const bf16*ksrc=Kh+(long)lane*DM+wid*8;
  const bf16*vsrc=Vh+(long)(16*(wid&3)+(lane>>2))*DM+(wid>>2)*32+(lane&3)*8;
  const unsigned kdst=lds0+LDS_K+wid*1024, vdst=lds0+LDS_V+wid*1024;
  #define DMA_K(t,slot) glds16(ksrc+(long)(NTF-1-(t))*KVBLK*DM,(unsigned)__builtin_amdgcn_readfirstlane(kdst+(slot)))
  #define DMA_V(t,slot) do{ glds16(vsrc+(long)(NTF-1-(t))*KVBLK*DM,(unsigned)__builtin_amdgcn_readfirstlane(vdst+2*(slot))); glds16(vsrc+(long)(NTF-1-(t))*KVBLK*DM+64,(unsigned)__builtin_amdgcn_readfirstlane(vdst+2*(slot)+8192)); }while(0)
  const char*Kbase=shm+LDS_K; bf16x8 kf[8];
  const lds_cptr shm3=(lds_cptr)shm; const lds_cptr kp0=shm3+LDS_K+hi*1024+r32*16; const lds_cptr vp0=shm3+LDS_V+((lane>>4)&1)*32+(lane&3)*8+(4*hi+((lane&15)>>2))*64; const int vb0=(int)(unsigned)(uintptr_t)vp0;
  const int NTF=(q0+QB)/KVBLK;
  int NT=__builtin_amdgcn_readfirstlane(nte<NTF?nte:NTF);
  DMA_K(0,0);DMA_V(0,0);DMA_K(1,SLOTB);
  bf16x8 qr[4];
  #pragma unroll
  for(int d0=0;d0<4;++d0)qr[d0]=*reinterpret_cast<const bf16x8*>(&Qw[(long)r32*DM+d0*16+hi*8]);
  float mhat=0.f,l_reg=0.f;f32x16 o[4];o[0]=f32x16{};o[1]=f32x16{};o[2]=f32x16{};o[3]=f32x16{};
  const int qrel=wid*QBLK+r32;
  #define CMASK(P0,P1,t) do{int jb_=3-(t); if(jb_>=0)cmask(P0,P1,jb_,qrel,hi);}while(0)
  const unsigned hm=hi?0u:0xffffffffu;
  const unsigned c_pk=cvtpk_s(sl2,0.f)&0xffffu; const float c_hif=__uint_as_float(c_pk<<16); const unsigned c_pl=cvtpk_s(sl2-c_hif,0.f)&0xffffu;
  const unsigned qa_c=((c_pl^0x8000u)<<16)|(c_pk^0x8000u);
  u32x4 qaw=(u32x4){qa_c,qa_c,0x80008000u,0u};
  const unsigned ka_j0=hm&(cvtpk_s((float)(63-r32),0.f)&0xffffu)*0x10001u, ka_j1=hm&(cvtpk_s((float)(31-r32),0.f)&0xffffu)*0x10001u, ka_one=hm&0x3f803f80u;
  #define KA_D0(t) (hm&((__float_as_uint((float)(64*(t)))>>16)*0x10001u))
  #define KAF(d0,j) __builtin_bit_cast(bf16x8,(u32x4){(d0),(j),ka_one,0u})
  #define QAF() __builtin_bit_cast(bf16x8,qaw)
  #define SET_REF(m,out) do{ const unsigned h_=cvtpk_s((m),0.f)&0xffffu; const float hf_=__uint_as_float(h_<<16); const unsigned l_=cvtpk_s((m)-hf_,0.f)&0xffffu; \
      out=hf_+__uint_as_float(l_<<16); qaw[2]=((l_^0x8000u)<<16)|(h_^0x8000u); }while(0)
  bool started=false;
  bool resc=false;
  #define START(P0,P1) do{ const float rm=rowmax(P0,P1); resc=false; started=(rm>-INFINITY); \
    { float dl=0.f; if(started){ SET_REF(rm,dl); } mhat=dl; \
      _Pragma("unroll") for(int r=0;r<16;++r){P0[r]=fsub_s(P0[r],dl);P1[r]=fsub_s(P1[r],dl);} } \
    _Pragma("unroll") for(int r=0;r<16;++r)P0[r]=__builtin_amdgcn_exp2f(P0[r]); }while(0)
  #define RESC() do{ if(resc){ asm volatile("s_waitcnt lgkmcnt(0)":::"memory"); \
      _Pragma("unroll") for(int d_=0;d_<4;++d_) _Pragma("unroll") for(int r=0;r<16;++r)o[d_][r]*=wsf[crow(r,hi)]; } }while(0)
  f32x16 pA0,pA1,pB0,pB1;
  int sl_prev=0,sl_cur=0,sl_next=SLOTB;
  #define ROT() do{sl_prev=sl_cur;sl_cur=sl_next;sl_next=(sl_next==(NSLOT-1)*SLOTB)?0:sl_next+SLOTB;}while(0)
  DMA_K(2,2*SLOTB);
  WAIT_BAR(4);
  qkt(pA0,pA1,Kbase,qr,KAF(0u,ka_j0),KAF(0u,ka_j1),QAF(),r32,hi);asm volatile("s_nop 15\n\ts_nop 7":"+v"(pA0),"+v"(pA1));CMASK(pA0,pA1,0);
  START(pA0,pA1);
  _Pragma("unroll") for(int r=0;r<16;++r)pA1[r]=__builtin_amdgcn_exp2f(pA1[r]);
  WAIT_BAR(0);
  DMA_K(3,0);DMA_V(1,SLOTB);
  ROT();
  kload8(kf,kp0+sl_cur);
  WAIT_BAR(3);
  s16x4 vlo[8],vhi[8]; u32x4 pw0,pw1,pw2,pw3;
  #define PKW(P,B) cvtpk_s(P[B],P[B+1])
  #define PAF(k) __builtin_bit_cast(bf16x8,pw##k)
  #define VFR(i) (bf16x8){vlo[i][0],vlo[i][1],vlo[i][2],vlo[i][3],vhi[i][0],vhi[i][1],vhi[i][2],vhi[i][3]}
  #define PIN(x) asm volatile("":"+v"(x))
  #define MX3(a,b,c) __builtin_fmaxf(__builtin_fmaxf((a),(b)),(c))
  #define GAPA(MF,A0,A1,A2,A3,W0,W1,PW) do{ MF; sacc+=A0; sacc+=A1; sacc+=A2; sacc+=A3; PIN(sacc); W0; W1; PIN(PW); SBAR(); }while(0)
  #define EX(v) __builtin_amdgcn_exp2f(v)
  #define GAPB(MF,X,B) do{ MF; X[B]=EX(X[B]); X[B+1]=EX(X[B+1]); PIN(X); SBAR(); }while(0)
  #define VRDX(i,db,ks) do{ vlo[i]=vtr(vp_+((db)*4096+(ks)*1024)); vhi[i]=vtr(vp_+((db)*4096+(ks)*1024+512)); }while(0)
  #define VRD(i) VRDX(i,(i)>>2,(i)&3)
  #define VRD2(i) do{ VRDX(i,((i)>>2)+2,(i)&3); SBAR(); }while(0)
  #define KRD(G,j) do{ if(G){ kload2(kf,kp0+sl_next,j); SBAR(); } }while(0)
  #define ROWMAX(C0,C1,rm) do{ float a=MX3(C0[0],C0[1],C1[0]),b=MX3(C0[2],C0[3],C1[1]); a=MX3(a,C1[2],C1[3]); \
      _Pragma("unroll") for(int r=4;r<16;r+=4){a=MX3(a,C0[r],C0[r+1]);b=MX3(b,C0[r+2],C0[r+3]);a=MX3(a,C1[r],C1[r+1]);b=MX3(b,C1[r+2],C1[r+3]);} \
      rm=__builtin_fmaxf(a,b); { auto rr=__builtin_amdgcn_permlane32_swap(__float_as_uint(rm),__float_as_uint(rm),false,false); rm=__builtin_fmaxf(__uint_as_float(rr[0]),__uint_as_float(rr[1])); } }while(0)
  #define DECIDE(C0,C1,rm) do{ resc=false; const bool fin_=(rm>-INFINITY); \
      if(__builtin_expect(__any(started?(rm>(float)THRL):fin_),0)){ const float want=mhat+(started?__builtin_fmaxf(rm,0.f):(fin_?rm:0.f)); float nref; SET_REF(want,nref); \
        const float dl=nref-mhat; mhat=nref; \
        _Pragma("unroll") for(int r=0;r<16;++r){C0[r]-=dl;C1[r]-=dl;} \
        const float f=started?__builtin_amdgcn_exp2f(-dl):1.f; l_reg*=f; if(hi==0)wsf[r32]=f; resc=true; } \
      started=started||fin_; }while(0)
  bool dead=false;
  #define LSTEP(C0,C1,t) do{ SBAR(); \
    { const unsigned kd0_=KA_D0(t); const f32x16 z_=f32x16{}; \
      C0=__builtin_amdgcn_mfma_f32_32x32x16_bf16(KAF(kd0_,ka_j0),QAF(),z_,0,0,0); C1=__builtin_amdgcn_mfma_f32_32x32x16_bf16(KAF(kd0_,ka_j1),QAF(),z_,0,0,0); } \
    C0=__builtin_amdgcn_mfma_f32_32x32x16_bf16(kf[0],qr[0],C0,0,0,0); C1=__builtin_amdgcn_mfma_f32_32x32x16_bf16(kf[1],qr[0],C1,0,0,0); \
    C0=__builtin_amdgcn_mfma_f32_32x32x16_bf16(kf[2],qr[1],C0,0,0,0); C1=__builtin_amdgcn_mfma_f32_32x32x16_bf16(kf[3],qr[1],C1,0,0,0); \
    C0=__builtin_amdgcn_mfma_f32_32x32x16_bf16(kf[4],qr[2],C0,0,0,0); C1=__builtin_amdgcn_mfma_f32_32x32x16_bf16(kf[5],qr[2],C1,0,0,0); \
    C0=__builtin_amdgcn_mfma_f32_32x32x16_bf16(kf[6],qr[3],C0,0,0,0); C1=__builtin_amdgcn_mfma_f32_32x32x16_bf16(kf[7],qr[3],C1,0,0,0); \
    SBAR(); kload2(kf,kp0+sl_next,0); kload2(kf,kp0+sl_next,1); kload2(kf,kp0+sl_next,2); kload2(kf,kp0+sl_next,3); SBAR();     \
    DMA_K((t)+3,sl_cur); DMA_V((t)+1,sl_next); \
    resc=false; \
    { float rm; ROWMAX(C0,C1,rm); \
      if(__builtin_expect(!__all(rm<-160.f),0)){ DECIDE(C0,C1,rm); \
        _Pragma("unroll") for(int r=0;r<16;++r){C0[r]=EX(C0[r]);C1[r]=EX(C1[r]);} dead=false; } } \
    SBAR(); \
    }while(0)
  #define STEP(C0,C1,P0,P1,t,GK,GV,GL) do{ SBAR(); \
    const lds_cptr vp_=vp0+2*sl_prev; \
    { const unsigned kd0_=KA_D0(t); const f32x16 z_=f32x16{}; \
      C0=__builtin_amdgcn_mfma_f32_32x32x16_bf16(KAF(kd0_,ka_j0),QAF(),z_,0,0,0); C1=__builtin_amdgcn_mfma_f32_32x32x16_bf16(KAF(kd0_,ka_j1),QAF(),z_,0,0,0); } \
    VRD(0); SBAR(); float sacc=(P0[0]+P0[1]); \
    GAPA(C0=__builtin_amdgcn_mfma_f32_32x32x16_bf16(kf[0],qr[0],C0,0,0,0), P0[2],P0[3],P0[4],P0[5],     pw0[0]=PKW(P0,0), pw0[1]=PKW(P0,2), pw0); \
    VRD(4); SBAR(); GAPA(C1=__builtin_amdgcn_mfma_f32_32x32x16_bf16(kf[1],qr[0],C1,0,0,0), P0[6],P0[7],P0[8],P0[9],     pw0[2]=PKW(P0,4), pw0[3]=PKW(P0,6), pw0); \
    VRD(1); SBAR(); GAPA(C0=__builtin_amdgcn_mfma_f32_32x32x16_bf16(kf[2],qr[1],C0,0,0,0),   P0[10],P0[11],P0[12],P0[13], pw1[0]=PKW(P0,8), pw1[1]=PKW(P0,10), pw1); \
    VRD(5); SBAR(); GAPA(C1=__builtin_amdgcn_mfma_f32_32x32x16_bf16(kf[3],qr[1],C1,0,0,0),   P0[14],P0[15],P1[0],P1[1],   pw1[2]=PKW(P0,12),pw1[3]=PKW(P0,14), pw1); \
    VRD(2); SBAR(); GAPA(C0=__builtin_amdgcn_mfma_f32_32x32x16_bf16(kf[4],qr[2],C0,0,0,0),   P1[2],P1[3],P1[4],P1[5],     pw2[0]=PKW(P1,0), pw2[1]=PKW(P1,2), pw2); \
    VRD(6); SBAR(); GAPA(C1=__builtin_amdgcn_mfma_f32_32x32x16_bf16(kf[5],qr[2],C1,0,0,0),   P1[6],P1[7],P1[8],P1[9],     pw2[2]=PKW(P1,4), pw2[3]=PKW(P1,6), pw2); \
    VRD(3); SBAR(); GAPA(C0=__builtin_amdgcn_mfma_f32_32x32x16_bf16(kf[6],qr[3],C0,0,0,0),   P1[10],P1[11],P1[12],P1[13], pw3[0]=PKW(P1,8), pw3[1]=PKW(P1,10), pw3); \
    VRD(7); SBAR(); GAPA(C1=__builtin_amdgcn_mfma_f32_32x32x16_bf16(kf[7],qr[3],C1,0,0,0),   P1[14],P1[15],0.f,0.f,       pw3[2]=PKW(P1,12),pw3[3]=PKW(P1,14), pw3); \
    l_reg+=sacc; \
    if(GK){DMA_K((t)+3,sl_cur);} if(GV){DMA_V((t)+1,sl_next);} \
    CMASK(C0,C1,t); \
    { float rm; ROWMAX(C0,C1,rm); DECIDE(C0,C1,rm); dead=__all(rm<-160.f); } \
    SBAR(); \
    GAPB(o[0]=__builtin_amdgcn_mfma_f32_32x32x16_bf16(PAF(0),VFR(0),o[0],0,0,0), C0,0); \
    VRD2(0); GAPB(o[1]=__builtin_amdgcn_mfma_f32_32x32x16_bf16(PAF(0),VFR(4),o[1],0,0,0), C0,2); \
    VRD2(4); GAPB(o[0]=__builtin_amdgcn_mfma_f32_32x32x16_bf16(PAF(1),VFR(1),o[0],0,0,0), C0,4); \
    VRD2(1); GAPB(o[1]=__builtin_amdgcn_mfma_f32_32x32x16_bf16(PAF(1),VFR(5),o[1],0,0,0), C0,6); \
    VRD2(5); GAPB(o[0]=__builtin_amdgcn_mfma_f32_32x32x16_bf16(PAF(2),VFR(2),o[0],0,0,0), C0,8); \
    VRD2(2); GAPB(o[1]=__builtin_amdgcn_mfma_f32_32x32x16_bf16(PAF(2),VFR(6),o[1],0,0,0), C0,10); \
    VRD2(6); GAPB(o[0]=__builtin_amdgcn_mfma_f32_32x32x16_bf16(PAF(3),VFR(3),o[0],0,0,0), C0,12); \
    VRD2(3); GAPB(o[1]=__builtin_amdgcn_mfma_f32_32x32x16_bf16(PAF(3),VFR(7),o[1],0,0,0), C0,14); \
    VRD2(7); GAPB(o[2]=__builtin_amdgcn_mfma_f32_32x32x16_bf16(PAF(0),VFR(0),o[2],0,0,0), C1,0); \
    KRD(GL,0); GAPB(o[3]=__builtin_amdgcn_mfma_f32_32x32x16_bf16(PAF(0),VFR(4),o[3],0,0,0), C1,2); \
    KRD(GL,1); GAPB(o[2]=__builtin_amdgcn_mfma_f32_32x32x16_bf16(PAF(1),VFR(1),o[2],0,0,0), C1,4); \
    KRD(GL,2); GAPB(o[3]=__builtin_amdgcn_mfma_f32_32x32x16_bf16(PAF(1),VFR(5),o[3],0,0,0), C1,6); \
    KRD(GL,3); GAPB(o[2]=__builtin_amdgcn_mfma_f32_32x32x16_bf16(PAF(2),VFR(2),o[2],0,0,0), C1,8); \
    GAPB(o[3]=__builtin_amdgcn_mfma_f32_32x32x16_bf16(PAF(2),VFR(6),o[3],0,0,0), C1,10); \
    GAPB(o[2]=__builtin_amdgcn_mfma_f32_32x32x16_bf16(PAF(3),VFR(3),o[2],0,0,0), C1,12); \
    GAPB(o[3]=__builtin_amdgcn_mfma_f32_32x32x16_bf16(PAF(3),VFR(7),o[3],0,0,0), C1,14); \
    }while(0)
  int t=1;
  #define ENDW(tt) do{ if((tt)+3<NT){WAIT_BAR(3);} else if((tt)+2<NT){WAIT_BAR(2);} else {WAIT_BAR(0);} }while(0)
  for(;t<5&&t+1<NT;t+=2){
    STEP(pB0,pB1,pA0,pA1,t,(t+3<NT),(t+1<NT),(t+1<NT));       ENDW(t);   RESC(); ROT();
    STEP(pA0,pA1,pB0,pB1,t+1,(t+4<NT),(t+2<NT),(t+2<NT));     ENDW(t+1); RESC(); ROT();
  }
  if(NT>=10){
    float v_=-mhat;
    _Pragma("unroll") for(int o_=1;o_<32;o_<<=1)v_=__builtin_fmaxf(v_,__shfl_xor(v_,o_));
    if(lane==0)wsf[48]=v_;
    asm volatile("s_waitcnt lgkmcnt(0)\n\ts_barrier":::"memory");
    const float*wsx_=(const float*)(shm+LDS_WS); float mx_=wsx_[48];
    _Pragma("unroll") for(int w_=1;w_<NW;++w_)mx_=__builtin_fmaxf(mx_,wsx_[w_*64+48]);
    const float tb_=(bnd+mx_)*inv64c; int n2_=(tb_<1000.f)?2*((int)(tb_*0.5f))+2:4096; n2_=n2_<8?8:n2_;
    NT=__builtin_amdgcn_readfirstlane(n2_<NT?n2_:NT);
  }
  #undef CMASK
  #define CMASK(P0,P1,t) do{}while(0)
  while(t+5<NT){
    STEP(pB0,pB1,pA0,pA1,t,true,true,true);     WAIT_BAR(3); RESC(); ROT();
    STEP(pA0,pA1,pB0,pB1,t+1,true,true,true);   WAIT_BAR(3); RESC(); ROT();
    t+=2; if(dead) break;
  }
  if(dead){
    for(;t+5<NT;++t){
      dead=true; LSTEP(pA0,pA1,t); WAIT_BAR(3); RESC();
      if(!dead){ float sacc=pA0[0]+pA0[1]; _Pragma("unroll") for(int r=2;r<16;++r)sacc+=pA0[r]; _Pragma("unroll") for(int r=0;r<16;++r)sacc+=pA1[r]; l_reg+=sacc;
        pw0=(u32x4){PKW(pA0,0),PKW(pA0,2),PKW(pA0,4),PKW(pA0,6)};pw1=(u32x4){PKW(pA0,8),PKW(pA0,10),PKW(pA0,12),PKW(pA0,14)};pw2=(u32x4){PKW(pA1,0),PKW(pA1,2),PKW(pA1,4),PKW(pA1,6)};pw3=(u32x4){PKW(pA1,8),PKW(pA1,10),PKW(pA1,12),PKW(pA1,14)};
        SBAR(); pv(o,vb0+2*sl_cur,PAF(0),PAF(1),PAF(2),PAF(3)); }
      ROT();
    }
    dead=true; pA0=f32x16{}; pA1=f32x16{}; pB0=f32x16{}; pB1=f32x16{};
    if(!(t&1)){   }
  }
  #undef CMASK
  #define CMASK(P0,P1,t) do{int jb_=3-(t); if(jb_>=0)cmask(P0,P1,jb_,qrel,hi);}while(0)
  for(;t+1<NT;t+=2){
    STEP(pB0,pB1,pA0,pA1,t,(t+3<NT),(t+1<NT),(t+1<NT));       ENDW(t);   RESC(); ROT();
    STEP(pA0,pA1,pB0,pB1,t+1,(t+4<NT),(t+2<NT),(t+2<NT));     ENDW(t+1); RESC(); ROT();
  }
  STEP(pB0,pB1,pA0,pA1,NT-1,false,false,false); RESC();
  { float sacc=pB0[0]+pB0[1]; _Pragma("unroll") for(int r=2;r<16;++r)sacc+=pB0[r]; _Pragma("unroll") for(int r=0;r<16;++r)sacc+=pB1[r]; l_reg+=sacc;
    pw0=(u32x4){PKW(pB0,0),PKW(pB0,2),PKW(pB0,4),PKW(pB0,6)};pw1=(u32x4){PKW(pB0,8),PKW(pB0,10),PKW(pB0,12),PKW(pB0,14)};pw2=(u32x4){PKW(pB1,0),PKW(pB1,2),PKW(pB1,4),PKW(pB1,6)};pw3=(u32x4){PKW(pB1,8),PKW(pB1,10),PKW(pB1,12),PKW(pB1,14)};
    SBAR(); pv(o,vb0+2*sl_cur,PAF(0),PAF(1),PAF(2),PAF(3)); }
  #undef PKW
  #undef PAF
  #undef VFR
  #undef PIN
  #undef MX3
  #undef GAPA
  #undef GAPB
  #undef EX
  #undef VRD
  #undef VRD2
  #undef VRDX
  #undef KRD
  #undef STEP
  #undef LSTEP
  #undef ROWMAX
  #undef DECIDE
  #undef ENDW
  {auto rr=__builtin_amdgcn_permlane32_swap(__float_as_uint(l_reg),__float_as_uint(l_reg),false,false);l_reg=__uint_as_float(rr[0])+__uint_as_float(rr[1]);}
  if(hi==0)wsf[32+r32]=l_reg;asm volatile("s_waitcnt lgkmcnt(0)":::"memory");
  float rli[16];
  #pragma unroll
  for(int r=0;r<16;++r)rli[r]=__builtin_amdgcn_rcpf(wsf[32+crow(r,hi)]);
  bf16*Ow=Oh+(long)(q0+wid*QBLK)*DMO;
  { bf16*stg=(bf16*)(shm+LDS_OST)+wid*2048;
    #pragma unroll
    for(int pass=0;pass<2;++pass){
      #pragma unroll
      for(int r=0;r<16;++r){const int orow=crow(r,hi);
        #pragma unroll
        for(int d0=0;d0<2;++d0)stg[orow*64+d0*32+r32]=__float2bfloat16(o[2*pass+d0][r]*rli[r]);}
      asm volatile("s_waitcnt lgkmcnt(0)":::"memory");
      #pragma unroll
      for(int i=0;i<4;++i){const int row=i*8+(lane>>3),ch=lane&7; const u32x4 v=*(const u32x4*)(stg+row*64+ch*8); ATTN_STORE16(Ow+(long)row*DMO+pass*64+ch*8,v);}
      asm volatile("s_waitcnt lgkmcnt(0)":::"memory"); } }
  asm volatile("s_waitcnt lgkmcnt(0)\n\ts_barrier":::"memory");
  #undef DMA_K
  #undef DMA_V
  #undef CMASK
  #undef KA_D0
  #undef KAF
  #undef QAF
  #undef SET_REF
  #undef START
  #undef RESC
  #undef ROT
}
constexpr int ATTN_LDS_BYTES=LDS_BYTES;
struct AttnTensors { const bf16* P; bf16* O; const unsigned* nrm; };
struct AttnUnit { int combo; int qb; };
__device__ const unsigned char ATT_TAB[256] = {123, 45, 21, 112, 255, 255, 255, 255, 127, 55, 50, 65, 255, 255, 255, 255, 75, 44, 20, 64, 255, 255, 255, 255, 79, 118, 115, 49, 255, 255, 255, 255, 122, 68, 29, 15, 255, 255, 255, 255, 126, 119, 67, 14, 255, 255, 255, 255, 74, 52, 28, 13, 255, 255, 255, 255, 78, 71, 51, 12, 255, 255, 255, 255, 121, 69, 27, 11, 255, 255, 255, 255, 125, 59, 114, 113, 255, 255, 255, 255, 73, 53, 26, 10, 255, 255, 255, 255, 77, 58, 66, 97, 255, 255, 255, 255, 120, 70, 25, 9, 255, 255, 255, 255, 124, 63, 41, 8, 255, 255, 255, 255, 72, 54, 24, 7, 255, 255, 255, 255, 76, 62, 40, 6, 255, 255, 255, 255, 107, 47, 23, 96, 255, 255, 255, 255, 111, 102, 39, 80, 255, 255, 255, 255, 91, 46, 22, 48, 255, 255, 255, 255, 95, 86, 38, 32, 255, 255, 255, 255, 106, 100, 34, 81, 255, 255, 255, 255, 110, 103, 37, 16, 255, 255, 255, 255, 90, 84, 31, 33, 255, 255, 255, 255, 94, 87, 36, 0, 255, 255, 255, 255, 105, 85, 30, 17, 255, 255, 255, 255, 109, 57, 99, 5, 255, 255, 255, 255, 89, 116, 83, 4, 255, 255, 255, 255, 93, 56, 35, 3, 255, 255, 255, 255, 104, 117, 98, 19, 255, 255, 255, 255, 108, 61, 43, 2, 255, 255, 255, 255, 88, 101, 82, 18, 255, 255, 255, 255, 92, 60, 42, 1, 255, 255, 255, 255};
struct StaticOrder {
  int vcu, G;
  __device__ __forceinline__ explicit StaticOrder(int grid,int block):vcu((grid%8==0)?(block%8)*(grid/8)+block/8:block),G(grid){}
  __device__ __forceinline__ bool next(int i,AttnUnit&u)const{
    if(G==256){ if(i>=8)return false; const int g=vcu>>5, c=vcu&31; const int e=__builtin_amdgcn_readfirstlane((int)ATT_TAB[((g&1)*16+(c&15))*8+i]); if(e==255)return false;
      u.combo=(((g>>1)*8+(e>>4))<<1)|(c>>4); u.qb=e&15; return true; }
    const int L=i*G+vcu; if(L>=64*16)return false; u.combo=L>>4; u.qb=L&15; return true; }
};
template<class Sched,int THRL=8> __device__ __forceinline__ void attn_phase(char*lds,const AttnTensors&T,const Sched&S){
  AttnUnit u;
  for(int i=0;S.next(i,u);++i){
    const int m=u.combo&1, h=(u.combo>>1)&7, b=u.combo>>4;
    const bf16*rowp=T.P+(long)b*SEQ*DM;
    const float sl2=LOG2E*__builtin_amdgcn_exp2f(-(float)(h+1));
    int nte; float bnd, inv64c;
    { const int hm=2*h+m; const unsigned*qt=T.nrm+(b*16+u.qb)*32+2*hm, *kt=T.nrm+64*32+b*32+2*hm;
      const float q2=__uint_as_float(__hip_atomic_load(qt,__ATOMIC_RELAXED,__HIP_MEMORY_SCOPE_AGENT))+__uint_as_float(__hip_atomic_load(qt+1,__ATOMIC_RELAXED,__HIP_MEMORY_SCOPE_AGENT));
      const float k2=__uint_as_float(__hip_atomic_load(kt,__ATOMIC_RELAXED,__HIP_MEMORY_SCOPE_AGENT))+__uint_as_float(__hip_atomic_load(kt+1,__ATOMIC_RELAXED,__HIP_MEMORY_SCOPE_AGENT));
      const float B=__builtin_sqrtf(q2*k2);
      const float tb=((170.f+2.04f*B)/(0.999f*sl2)+255.f)*(1.f/64.f);
      nte=(tb<1000.f)?2*((int)(tb*0.5f))+2:4096;
      nte=__builtin_amdgcn_readfirstlane(nte);
      bnd=162.f+1.02f*B; inv64c=1.f/(64.f*0.999f*sl2); }
    attn_unit<THRL>(u.qb, rowp+1024+(2*h+m)*64, rowp+2048+(2*h+m)*64, rowp+3072+h*128, T.O+(long)b*SEQ*DMO+m*1024+h*128, sl2, lds, nte, bnd, inv64c); }
}
#undef SBAR
#undef WAIT_BAR
}
#define GAS __attribute__((address_space(1)))
#define LAS __attribute__((address_space(3)))
typedef unsigned short bf16;
typedef unsigned v4u __attribute__((ext_vector_type(4)));
typedef float f32x4 __attribute__((ext_vector_type(4)));
typedef short bf16x8 __attribute__((ext_vector_type(8)));
typedef GAS unsigned gu32;
typedef GAS unsigned long long gu64;
#define RLX_AGENT __ATOMIC_RELAXED, __HIP_MEMORY_SCOPE_AGENT
#define LDS_WAIT() asm volatile("s_waitcnt lgkmcnt(0)" ::: "memory")
#define VM_WAIT() asm volatile("s_waitcnt vmcnt(0)" ::: "memory")
__device__ __forceinline__ unsigned long long rt() { return __builtin_amdgcn_s_memrealtime(); }
__device__ __forceinline__ unsigned f2bf(float f) { unsigned u = __builtin_bit_cast(unsigned, f); return (u + 0x7fffu + ((u >> 16) & 1u)) >> 16; }
__device__ __forceinline__ unsigned pk2(float lo, float hi) { return f2bf(lo) | (f2bf(hi) << 16); }

#define XB_TMO      128
#define XB_XCNT(j)  (256  + 64 * (j))
#define XB_XSUB(j)  (1280 + 64 * (j))
#define XB_XGEN(j)  (2304 + 64 * (j))
#define XB_TOP      3328
#define XB_TOPGEN   3392
#define XCD_BAR_WORDS 3456
#define XB_SPIN_CAP (1u << 18)

__device__ __forceinline__ unsigned xb_ld(unsigned* p)              { return __hip_atomic_load(p, __ATOMIC_RELAXED, __HIP_MEMORY_SCOPE_AGENT); }
__device__ __forceinline__ unsigned xb_add(unsigned* p, unsigned v) { return __hip_atomic_fetch_add(p, v, __ATOMIC_RELAXED, __HIP_MEMORY_SCOPE_AGENT); }
__device__ __forceinline__ unsigned xb_xcc_id() { return (unsigned)__builtin_amdgcn_s_getreg((3 << 11) | 20) & 0xFu; }
#define XB_SPIN(cond, bar) do { unsigned _sp = 0; while (cond) { __builtin_amdgcn_s_sleep(1); \
    if ((++_sp & 255u) == 0u) { if (xb_ld(&(bar)[XB_TMO])) break; if (_sp > XB_SPIN_CAP) { atomicAdd(&(bar)[XB_TMO], 1u); break; } } } } while (0)

struct XcdBarrier {
    unsigned* bar; unsigned x;
    volatile LAS unsigned* st;
};

__device__ __forceinline__ XcdBarrier xcd_barrier_post(unsigned* bar, volatile LAS unsigned* st) {
    XcdBarrier b; b.bar = bar; b.x = xb_xcc_id(); b.st = st;
    if (threadIdx.x == 0) (void)xb_add(&bar[XB_XCNT(b.x)], 1u);
    return b;
}
__device__ __forceinline__ void xcd_barrier_complete(unsigned* bar, unsigned x, unsigned& nloc, unsigned& nx) {
    const unsigned G = gridDim.x * gridDim.y * gridDim.z;
    unsigned sum, cnt, mine, sp = 0u;
    for (;;) {
        sum = 0u; cnt = 0u; mine = 0u;
#pragma unroll
        for (unsigned j = 0; j < 16; ++j) { const unsigned c = xb_ld(&bar[XB_XCNT(j)]); sum += c; cnt += (c > 0u) ? 1u : 0u; mine = (j == x) ? c : mine; }
        if (sum == G) break;
        __builtin_amdgcn_s_sleep(1);
        if ((++sp & 255u) == 0u) { if (xb_ld(&bar[XB_TMO])) break; if (sp > XB_SPIN_CAP) { atomicAdd(&bar[XB_TMO], 1u); break; } }
    }
    nloc = mine > 0u ? mine : 1u; nx = cnt > 0u ? cnt : 1u;
}

__device__ __forceinline__ void xcd_barrier(const XcdBarrier& b) {
    asm volatile("s_waitcnt vmcnt(0)" ::: "memory");
    __syncthreads();
    if (threadIdx.x == 0) {
        unsigned* bar = b.bar; unsigned bx_ = b.x;
        asm volatile("" : "+s"(bar), "+s"(bx_));
        __builtin_amdgcn_s_waitcnt(0);
        unsigned nloc = b.st[0], nx = b.st[1];
        if (nloc == 0u) { xcd_barrier_complete(bar, bx_, nloc, nx); b.st[0] = nloc; b.st[1] = nx; }
        const unsigned old = xb_add(&bar[XB_XSUB(bx_)], 1u);
        const unsigned gen = old / nloc;
        if (old + 1u == (gen + 1u) * nloc) {
            __builtin_amdgcn_fence(__ATOMIC_RELEASE, "agent");
            asm volatile("s_waitcnt vmcnt(0)" ::: "memory");
            const unsigned og = xb_add(&bar[XB_TOP], 1u);
            const unsigned tg = og / nx;
            if (og + 1u == (tg + 1u) * nx) xb_add(&bar[XB_TOPGEN], 1u);
            else XB_SPIN(xb_ld(&bar[XB_TOPGEN]) == tg, bar);
            __builtin_amdgcn_fence(__ATOMIC_ACQUIRE, "agent");
            xb_add(&bar[XB_XGEN(bx_)], 1u);
            asm volatile("s_waitcnt vmcnt(0)" ::: "memory");
        } else {
            XB_SPIN(xb_ld(&bar[XB_XGEN(bx_)]) == gen, bar);
            __builtin_amdgcn_fence(__ATOMIC_ACQUIRE, "agent");
            asm volatile("s_waitcnt vmcnt(0)" ::: "memory");
        }
    }
    __syncthreads();
}

constexpr int NWAVES = 8;
struct Frame {
    LAS unsigned char* lds;
    volatile LAS unsigned* MISC;
    gu32* ctl;
    int tid, lane, wave;
    int vcu, G;
};
__device__ __forceinline__ float wave_sum(float v) {
#pragma unroll
    for (int o = 1; o < 64; o <<= 1) v += __shfl_xor(v, o);
    return v;
}
__device__ __forceinline__ float bf_lo(unsigned w) { return __uint_as_float(w << 16); }
__device__ __forceinline__ float bf_hi(unsigned w) { return __uint_as_float(w & 0xffff0000u); }

__device__ __forceinline__ void w_transpose_item(const float* W, int K, int N, const float* gain, bf16* WT, int k0, int n0, int dst_row0, LAS float* scr, int lane) {
    const GAS float* src = (const GAS float*)W + (size_t)(k0 + (lane >> 5)) * N + n0 + (lane & 31);
    float w[32];
#pragma unroll
    for (int i = 0; i < 32; ++i) w[i] = __builtin_nontemporal_load(src + (size_t)(2 * i) * N);
    const int c = lane & 7;
    f32x4 g0 = (f32x4){1.f, 1.f, 1.f, 1.f}, g1 = g0;
    if (gain) { g0 = *(const GAS f32x4*)(gain + k0 + 8 * c); g1 = *(const GAS f32x4*)(gain + k0 + 8 * c + 4); }
#pragma unroll
    for (int i = 0; i < 32; ++i) scr[(2 * i + (lane >> 5)) * 33 + (lane & 31)] = w[i];
    LDS_WAIT(); asm volatile("" ::: "memory");
#pragma unroll
    for (int j = 0; j < 4; ++j) { const int n = (lane >> 3) + 8 * j; const LAS float* s = scr + (8 * c) * 33 + n;
        v4u o; o.x = pg8::cvt_pk_bf16(s[0 * 33] * g0.x, s[1 * 33] * g0.y); o.y = pg8::cvt_pk_bf16(s[2 * 33] * g0.z, s[3 * 33] * g0.w);
        o.z = pg8::cvt_pk_bf16(s[4 * 33] * g1.x, s[5 * 33] * g1.y); o.w = pg8::cvt_pk_bf16(s[6 * 33] * g1.z, s[7 * 33] * g1.w);
        *(GAS v4u*)(WT + (size_t)(dst_row0 + n) * K + k0 + 8 * c) = o; }
    LDS_WAIT(); asm volatile("" ::: "memory");
}

constexpr int DM = 2048, NB = 4, SEQ = 4096, M = NB * SEQ, DEPTH = 4, FF = 5632, NIN = 5632, WA = 512, WBW = 1024, WC = 512;
constexpr float EPS = 1e-6f;
constexpr size_t MiB = 1u << 20;
constexpr size_t WS_CTL = 0, CTL_ZERO_BYTES = 4 * MiB;
constexpr int CW_BAR = 4096;
constexpr size_t NRM_OFF = 3 * MiB, NRM_LAYER_BYTES = 16384;
constexpr size_t SS_OFF = 64 * 1024;
static_assert(CW_BAR * 4 + XCD_BAR_WORDS * 4 <= SS_OFF && SS_OFF + 17 * (size_t)M * 8 <= NRM_OFF && NRM_OFF + 4 * NRM_LAYER_BYTES <= CTL_ZERO_BYTES && (pg8::NRM_K_WORD + 4 * 32) * 4 <= (int)NRM_LAYER_BYTES, "ctl map");
constexpr size_t WS_WGU1 = 4 * MiB, WS_WD1 = WS_WGU1 + 44 * MiB, WS_WIN = WS_WD1 + 22 * MiB, WS_WOUT = WS_WIN + 22 * MiB, WS_WGU2 = WS_WOUT + 8 * MiB, WS_WD2 = WS_WGU2 + 44 * MiB;
constexpr size_t WL_STRIDE = 162 * MiB;
constexpr size_t WS_XB = WS_WGU1 + 4 * WL_STRIDE;
constexpr size_t WS_ACT = WS_XB + 64 * MiB;
constexpr size_t WS_OB = WS_ACT + 176 * MiB;
constexpr size_t WS_YM = WS_OB + 64 * MiB;
constexpr size_t WS_END = WS_YM + 64 * MiB;
static_assert((size_t)FF * 2 * DM * 2 == 44 * MiB && (size_t)M * FF * 2 == 176 * MiB, "sizes");
constexpr int RING_OFF = 0, RING_BYTES = 131072;
constexpr int LDSCTL_OFF = RING_BYTES, MISC_OFF = LDSCTL_OFF + 320;
constexpr int LDS_BYTES = 147456;
constexpr int RSTAB_OFF = RING_BYTES + 1024;

struct Args { const float* in[19]; float* out; unsigned char* ws; };
typedef const __attribute__((address_space(4))) Args* ArgsP;
__device__ __forceinline__ ArgsP get_args() { ArgsP p = (ArgsP)__builtin_amdgcn_kernarg_segment_ptr(); asm volatile("" : "+s"(p)); return p; }

__device__ __forceinline__ const LAS float* fill_rstab(Frame& F, const pg8::ssq_t* ss, float inv_k, int* rowbase) {
    if (F.G != 256) { *rowbase = 0; return nullptr; }
    LAS float* tab = (LAS float*)(F.lds + RSTAB_OFF); const int base = 2048 * ((int)blockIdx.x & 7); *rowbase = base;
    int t_ = threadIdx.x; asm volatile("" : "+v"(t_));
#pragma unroll
    for (int i = 0; i < 4; ++i) tab[t_ + 512 * i] = __builtin_amdgcn_rsqf(pg8::ssq_dec(ss[base + t_ + 512 * i]) * inv_k + pg8::RMS_EPS);
    __syncthreads();
    return tab;
}

__device__ __forceinline__ void phase_weights(Frame& F0, int l_in, bool do_x = true, size_t dst_shift = 0) {
    int l = l_in; asm volatile("" : "+s"(l));
    Frame F = F0; asm volatile("" : "+v"(F.tid), "+v"(F.lane));
    const ArgsP ap = get_args();
    LAS float* scr = (LAS float*)(F.lds + RING_OFF + F.wave * 16384);
    const int gw = F.vcu * NWAVES + F.wave, NGW = F.G * NWAVES;
    unsigned char* ws = ap->ws + dst_shift;
    constexpr int I_BIG = (DM / 64) * (FF / 32);
    constexpr int I_OUT = (DM / 64) * (DM / 32);
    constexpr int NITEMS = 7 * I_BIG + I_OUT;
    const size_t wbig = (size_t)l * DM * FF;
    for (int it = gw; it < NITEMS; it += NGW) {
        const int which = it / I_BIG, r = it % I_BIG;
        if (which == 0 || which == 1 || which == 4 || which == 5) {
            const int f2 = which >= 4, up = which & 1;
            const float* W = ap->in[(f2 ? 15 : 2) + up] + wbig; const float* g = ap->in[f2 ? 14 : 1] + (size_t)l * DM;
            bf16* WT = (bf16*)(ws + (f2 ? WS_WGU2 : WS_WGU1));
            const int nblk = FF / 32, kb = r / nblk, nb = r % nblk, n0 = 32 * nb;
            w_transpose_item(W, DM, FF, g, WT, 64 * kb, n0, (n0 / 128) * 256 + (n0 % 128) + up * 128, scr, F.lane);
        } else if (which == 2 || which == 6) {
            const int f2 = which == 6;
            const float* W = ap->in[f2 ? 17 : 4] + wbig; bf16* WT = (bf16*)(ws + (f2 ? WS_WD2 : WS_WD1));
            const int nblk = DM / 32, kb = r / nblk, nb = r % nblk;
            w_transpose_item(W, FF, DM, nullptr, WT, 64 * kb, 32 * nb, 32 * nb, scr, F.lane);
        } else if (which == 3) {
            const float* W = ap->in[6] + wbig; const float* g = ap->in[5] + (size_t)l * DM; bf16* WT = (bf16*)(ws + WS_WIN);
            const int nblk = NIN / 32, kb = r / nblk, nb = r % nblk;
            w_transpose_item(W, DM, NIN, g, WT, 64 * kb, 32 * nb, 32 * nb, scr, F.lane);
        } else {
            const float* W = ap->in[13] + (size_t)l * DM * DM; bf16* WT = (bf16*)(ws + WS_WOUT);
            const int nblk = DM / 32, kb = r / nblk, nb = r % nblk;
            w_transpose_item(W, DM, DM, nullptr, WT, 64 * kb, 32 * nb, 32 * nb, scr, F.lane);
        }
    }
    if (l == 0 && do_x) {
        const float* x = ap->in[0]; bf16* xb = (bf16*)(ws + WS_XB); pg8::ssq_t* ss0 = (pg8::ssq_t*)(ws + SS_OFF);
        for (int m = gw; m < M; m += NGW) {
            const GAS f32x4* xr = (const GAS f32x4*)(x + (size_t)m * DM) + F.lane; GAS unsigned long long* o8 = (GAS unsigned long long*)(xb + (size_t)m * DM) + F.lane;
            float s = 0.f; f32x4 vv[8];
#pragma unroll
            for (int j = 0; j < 8; ++j) vv[j] = xr[64 * j];
#pragma unroll
            for (int j = 0; j < 8; ++j) { const f32x4 v = vv[j]; s += (v.x * v.x + v.y * v.y) + (v.z * v.z + v.w * v.w);
                o8[64 * j] = (unsigned long long)pk2(v.x, v.y) | ((unsigned long long)pk2(v.z, v.w) << 32); }
            s = wave_sum(s); if (F.lane == 0) ss0[m] = pg8::ssq_enc(s);
        }
    }
}

__device__ __forceinline__ void phase_mixer_post(Frame& F0, int l_in) {
    int l = l_in; asm volatile("" : "+s"(l));
    Frame F = F0; asm volatile("" : "+v"(F.tid), "+v"(F.lane));
    const ArgsP ap = get_args();
    unsigned char* ws = ap->ws;
    const bf16* P = (const bf16*)(ws + WS_ACT); const bf16* OB = (const bf16*)(ws + WS_OB); bf16* YM = (bf16*)(ws + WS_YM);
    const int gw = F.vcu * NWAVES + F.wave, NGW = F.G * NWAVES, lane = F.lane;
    const float* lq = ap->in[10] + (size_t)l * 4 * 64;
    const float s01 = wave_sum(lq[lane] * lq[64 + lane]), s23 = wave_sum(lq[128 + lane] * lq[192 + lane]);
    const float lam_init = 0.8f - 0.6f * __expf(-0.3f * (float)l);
    const float lam = __expf(s01) - __expf(s23) + lam_init, oml = 1.0f - lam_init;
    {
        const float* gsub = ap->in[11] + (size_t)l * 128; const float* wcv = ap->in[12] + (size_t)l * 3 * WC;
        float gs[16]; { const int c0 = (lane & 7) * 16;
#pragma unroll
            for (int i = 0; i < 16; ++i) gs[i] = gsub[c0 + i] * oml; }
        float w0[8], w1[8], w2[8]; { const int c = lane * 8;
#pragma unroll
            for (int i = 0; i < 8; ++i) { w0[i] = wcv[c + i]; w1[i] = wcv[WC + c + i]; w2[i] = wcv[2 * WC + c + i]; } }
        for (int row = gw; row < M; row += NGW) {
            { const v4u* p1 = (const v4u*)(OB + (size_t)row * 2048 + lane * 16); const v4u* p2 = (const v4u*)(OB + (size_t)row * 2048 + 1024 + lane * 16);
              const v4u a0 = p1[0], a1 = p1[1], b0 = p2[0], b1 = p2[1];
              const unsigned aw[8] = {a0.x, a0.y, a0.z, a0.w, a1.x, a1.y, a1.z, a1.w}, bw[8] = {b0.x, b0.y, b0.z, b0.w, b1.x, b1.y, b1.z, b1.w};
              float d[16]; float s = 0.f;
#pragma unroll
              for (int i = 0; i < 8; ++i) { d[2 * i] = bf_lo(aw[i]) - lam * bf_lo(bw[i]); d[2 * i + 1] = bf_hi(aw[i]) - lam * bf_hi(bw[i]); s += d[2 * i] * d[2 * i] + d[2 * i + 1] * d[2 * i + 1]; }
              s += __shfl_xor(s, 1); s += __shfl_xor(s, 2); s += __shfl_xor(s, 4);
              const float rs = __builtin_amdgcn_rsqf(s * (1.0f / 128.0f) + EPS);
              v4u o0, o1;
              o0.x = pk2(d[0] * rs * gs[0], d[1] * rs * gs[1]); o0.y = pk2(d[2] * rs * gs[2], d[3] * rs * gs[3]); o0.z = pk2(d[4] * rs * gs[4], d[5] * rs * gs[5]); o0.w = pk2(d[6] * rs * gs[6], d[7] * rs * gs[7]);
              o1.x = pk2(d[8] * rs * gs[8], d[9] * rs * gs[9]); o1.y = pk2(d[10] * rs * gs[10], d[11] * rs * gs[11]); o1.z = pk2(d[12] * rs * gs[12], d[13] * rs * gs[13]); o1.w = pk2(d[14] * rs * gs[14], d[15] * rs * gs[15]);
              v4u* yo = (v4u*)(YM + (size_t)row * 2048 + WA + lane * 16); yo[0] = o0; yo[1] = o1; }
            { const int t = row & (SEQ - 1); const bf16* pr = P + (size_t)row * NIN + lane * 8;
              const v4u bg = *(const v4u*)(pr + 4096), cg0 = *(const v4u*)(pr + 4608), xc0 = *(const v4u*)(pr + 5120);
              v4u cg1 = (v4u){0u, 0u, 0u, 0u}, xc1 = cg1, cg2 = cg1, xc2 = cg1;
              if (t >= 1) { cg1 = *(const v4u*)(pr - NIN + 4608); xc1 = *(const v4u*)(pr - NIN + 5120); }
              if (t >= 2) { cg2 = *(const v4u*)(pr - 2 * NIN + 4608); xc2 = *(const v4u*)(pr - 2 * NIN + 5120); }
              const unsigned bgw[4] = {bg.x, bg.y, bg.z, bg.w}, c0w[4] = {cg0.x, cg0.y, cg0.z, cg0.w}, x0w[4] = {xc0.x, xc0.y, xc0.z, xc0.w},
                             c1w[4] = {cg1.x, cg1.y, cg1.z, cg1.w}, x1w[4] = {xc1.x, xc1.y, xc1.z, xc1.w}, c2w[4] = {cg2.x, cg2.y, cg2.z, cg2.w}, x2w[4] = {xc2.x, xc2.y, xc2.z, xc2.w};
              unsigned ow[4];
#pragma unroll
              for (int i = 0; i < 4; ++i) {
                  const float ylo = bf_lo(bgw[i]) * (w0[2 * i] * (bf_lo(c2w[i]) * bf_lo(x2w[i])) + w1[2 * i] * (bf_lo(c1w[i]) * bf_lo(x1w[i])) + w2[2 * i] * (bf_lo(c0w[i]) * bf_lo(x0w[i])));
                  const float yhi = bf_hi(bgw[i]) * (w0[2 * i + 1] * (bf_hi(c2w[i]) * bf_hi(x2w[i])) + w1[2 * i + 1] * (bf_hi(c1w[i]) * bf_hi(x1w[i])) + w2[2 * i + 1] * (bf_hi(c0w[i]) * bf_hi(x0w[i])));
                  ow[i] = pk2(ylo, yhi); }
              *(v4u*)(YM + (size_t)row * 2048 + WA + WBW + lane * 8) = (v4u){ow[0], ow[1], ow[2], ow[3]}; }
        }
    }
    {
        constexpr int PITCH = 136;
        LAS bf16* WT = (LAS bf16*)(F.lds + RING_OFF);
        LAS bf16* VT = (LAS bf16*)(F.lds + RING_OFF + 128 * PITCH * 2);
        LAS float* RS = (LAS float*)(F.lds + RING_OFF + 2 * 128 * PITCH * 2);
        const pg8::ssq_t* ssv = (const pg8::ssq_t*)(ws + SS_OFF) + (size_t)(13 + l) * M;
        const float* wsg = ap->in[8] + (size_t)l * 4 * 128 * 128; const float* bsg = ap->in[9] + (size_t)l * 4 * 128; const float* gv = ap->in[7] + (size_t)l * WA;
        const int tid = F.tid, wave = F.wave, fr = lane & 15, fq = lane >> 4;
        for (int unit = blockIdx.x; unit < 512; unit += F.G) {
            const int ch = unit >> 2, g = unit & 3, r0 = ch * 128;
            __syncthreads();
            if (tid < 128) RS[tid] = __builtin_amdgcn_rsqf(pg8::ssq_dec(ssv[r0 + tid]) * (1.0f / WA) + EPS);
            __syncthreads();
            { const int t = tid >> 2, s0 = (tid & 3) * 32; const float* wrow = wsg + ((size_t)g * 128 + t) * 128 + s0;
#pragma unroll
              for (int j = 0; j < 4; ++j) { const f32x4 wa = *(const f32x4*)(wrow + 8 * j), wb = *(const f32x4*)(wrow + 8 * j + 4); const int s = s0 + 8 * j;
                  float e[8] = {wa.x, wa.y, wa.z, wa.w, wb.x, wb.y, wb.z, wb.w};
#pragma unroll
                  for (int i = 0; i < 8; ++i) e[i] = (s + i <= t) ? e[i] * RS[s + i] : 0.f;
                  *(LAS v4u*)(WT + t * PITCH + s) = (v4u){pk2(e[0], e[1]), pk2(e[2], e[3]), pk2(e[4], e[5]), pk2(e[6], e[7])}; } }
            { const int s = tid >> 2, c0 = (tid & 3) * 32; const bf16* vrow = P + (size_t)(r0 + s) * NIN + WA + g * 128 + c0;
#pragma unroll
              for (int j = 0; j < 4; ++j) { const v4u v = *(const v4u*)(vrow + 8 * j); const unsigned vw[4] = {v.x, v.y, v.z, v.w};
#pragma unroll
                  for (int i = 0; i < 4; ++i) { VT[(c0 + 8 * j + 2 * i) * PITCH + s] = (bf16)(vw[i] & 0xffffu); VT[(c0 + 8 * j + 2 * i + 1) * PITCH + s] = (bf16)(vw[i] >> 16); } } }
            __syncthreads();
            f32x4 acc[8];
#pragma unroll
            for (int j = 0; j < 8; ++j) acc[j] = (f32x4){0.f, 0.f, 0.f, 0.f};
#pragma unroll
            for (int kk = 0; kk < 4; ++kk) { const bf16x8 af = *(const LAS bf16x8*)(WT + (16 * wave + fr) * PITCH + kk * 32 + fq * 8);
#pragma unroll
                for (int j = 0; j < 8; ++j) { const bf16x8 bfv = *(const LAS bf16x8*)(VT + (16 * j + fr) * PITCH + kk * 32 + fq * 8);
                    acc[j] = __builtin_amdgcn_mfma_f32_16x16x32_bf16(bfv, af, acc[j], 0, 0, 0); } }
            const int t = 16 * wave + fr; const float bt = bsg[g * 128 + t];
#pragma unroll
            for (int j = 0; j < 8; ++j) { const int c = 16 * j + 4 * fq; const f32x4 gvv = *(const f32x4*)(gv + g * 128 + c);
                const unsigned long long uu = *(const unsigned long long*)(P + (size_t)(r0 + t) * NIN + g * 128 + c); const unsigned ulo = (unsigned)uu, uhi = (unsigned)(uu >> 32);
                const float y0 = bf_lo(ulo) * (acc[j][0] * gvv.x + bt), y1 = bf_hi(ulo) * (acc[j][1] * gvv.y + bt), y2 = bf_lo(uhi) * (acc[j][2] * gvv.z + bt), y3 = bf_hi(uhi) * (acc[j][3] * gvv.w + bt);
                *(unsigned long long*)(YM + (size_t)(r0 + t) * 2048 + g * 128 + c) = (unsigned long long)pk2(y0, y1) | ((unsigned long long)pk2(y2, y3) << 32); }
        }
        __syncthreads();
    }
}

__device__ __forceinline__ void phase_final(Frame& F0) {
    Frame F = F0; asm volatile("" : "+v"(F.tid), "+v"(F.lane));
    const ArgsP ap = get_args();
    const int gw = F.vcu * NWAVES + F.wave, NGW = F.G * NWAVES;
    const bf16* xb = (const bf16*)(ap->ws + WS_XB); const pg8::ssq_t* ss = (const pg8::ssq_t*)(ap->ws + SS_OFF) + (size_t)12 * M; const float* gf = ap->in[18];
    f32x4 g[8];
#pragma unroll
    for (int j = 0; j < 4; ++j) { g[2 * j] = *(const f32x4*)(gf + 8 * F.lane + 512 * j); g[2 * j + 1] = *(const f32x4*)(gf + 8 * F.lane + 512 * j + 4); }
    for (int m = gw; m < M; m += 2 * NGW) { const int m1 = m + NGW; const bool two = m1 < M;
        const GAS v4u* xi0 = (const GAS v4u*)(xb + (size_t)m * DM) + F.lane; const GAS v4u* xi1 = (const GAS v4u*)(xb + (size_t)(two ? m1 : m) * DM) + F.lane;
        const pg8::ssq_t s0 = ss[m], s1 = ss[two ? m1 : m];
        v4u x0[4], x1[4];
#pragma unroll
        for (int j = 0; j < 4; ++j) { x0[j] = xi0[64 * j]; x1[j] = xi1[64 * j]; }
        const float rs0 = __builtin_amdgcn_rsqf(pg8::ssq_dec(s0) * (1.0f / DM) + EPS), rs1 = __builtin_amdgcn_rsqf(pg8::ssq_dec(s1) * (1.0f / DM) + EPS);
        GAS f32x4* xo0 = (GAS f32x4*)(ap->out + (size_t)m * DM) + 2 * F.lane;
#pragma unroll
        for (int j = 0; j < 4; ++j) { const v4u x = x0[j];
            xo0[128 * j] = (f32x4){bf_lo(x.x), bf_hi(x.x), bf_lo(x.y), bf_hi(x.y)} * rs0 * g[2 * j];
            xo0[128 * j + 1] = (f32x4){bf_lo(x.z), bf_hi(x.z), bf_lo(x.w), bf_hi(x.w)} * rs0 * g[2 * j + 1]; }
        if (two) { GAS f32x4* xo1 = (GAS f32x4*)(ap->out + (size_t)m1 * DM) + 2 * F.lane;
#pragma unroll
            for (int j = 0; j < 4; ++j) { const v4u x = x1[j];
                xo1[128 * j] = (f32x4){bf_lo(x.x), bf_hi(x.x), bf_lo(x.y), bf_hi(x.y)} * rs1 * g[2 * j];
                xo1[128 * j + 1] = (f32x4){bf_lo(x.z), bf_hi(x.z), bf_lo(x.w), bf_hi(x.w)} * rs1 * g[2 * j + 1]; } } }
}

__global__ void __launch_bounds__(NWAVES * 64, 2) mega_fwd(Args args) {
    extern __shared__ __attribute__((aligned(16))) unsigned char lds[];
    Frame F;
    F.lds = (LAS unsigned char*)lds;
    F.MISC = (volatile LAS unsigned*)(F.lds + MISC_OFF);
    F.tid = threadIdx.x; F.lane = F.tid & 63; F.wave = __builtin_amdgcn_readfirstlane(F.tid >> 6);
    F.G = gridDim.x; { const int bx = blockIdx.x; F.vcu = (F.G % 8 == 0) ? (bx % 8) * (F.G / 8) + bx / 8 : bx; }
    F.ctl = (gu32*)(get_args()->ws + WS_CTL);
    for (int u = F.tid; u < (LDS_BYTES - LDSCTL_OFF) / 4; u += NWAVES * 64) ((LAS unsigned*)(F.lds + LDSCTL_OFF))[u] = 0u;
    __syncthreads();
    XcdBarrier bar = xcd_barrier_post((unsigned*)(F.ctl + CW_BAR), F.MISC + 8);
#define GRID_BAR() xcd_barrier(bar)
#define WSP(T, off) ((T*)(ws + (off)))

#if W_UPFRONT
    for (int l = 0; l < DEPTH; ++l) phase_weights(F, l, l == 0, (size_t)l * WL_STRIDE);
    GRID_BAR();
#endif
    for (int l = 0; l < DEPTH; ++l) {
        const size_t wl = W_UPFRONT ? (size_t)l * WL_STRIDE : 0;
#if !W_UPFRONT
        phase_weights(F, l);
        GRID_BAR();
#endif
        for (int rep_ = 0; rep_ < PROBE_W; ++rep_) { phase_weights(F, l, false, wl); GRID_BAR(); }
        for (int half = 0; half < 2; ++half) {
            for (int rep_ = 0; rep_ < PROBE_BAR; ++rep_) GRID_BAR();
            if (half == 1) {
#ifndef SKIP_GIN
                for (int part = 0; part < 2; ++part) {
                  unsigned char* ws = get_args()->ws; pg8::ssq_t* SS = WSP(pg8::ssq_t, SS_OFF); const bool split = (F.G == 256);
                  pg8::Gemm g{WSP(bf16, WS_XB), (const bf16*)(ws + wl + WS_WIN), M, NIN, DM}; pg8::StaticOrder S; S.init(M, split ? NIN - 512 : NIN, F.G, (int)blockIdx.x);
                  if (part == 1) { S.tail = split ? 1 : 2; S.tail_vcu = F.vcu; S.pn_off = (NIN - 512) / 256; }
                  int rb_ = 0; const LAS float* rt_ = (part == 0) ? fill_rstab(F, SS + (size_t)(3 * l + 1) * M, 1.0f / DM, &rb_) : ((F.G == 256) ? (const LAS float*)(F.lds + RSTAB_OFF) : nullptr); if (part == 1) rb_ = (F.G == 256) ? 2048 * ((int)blockIdx.x & 7) : 0;
                  pg8::EpiProj E{WSP(bf16, WS_ACT), NIN, SS + (size_t)(3 * l + 1) * M, 1.0f / DM, SS + (size_t)(13 + l) * M, attn_body::C2, 4, 8, 2, 4, rt_, rb_, WSP(unsigned, NRM_OFF + (size_t)l * NRM_LAYER_BYTES)};
                  for (int rep_ = 0; rep_ < PROBE_GIN; ++rep_) { pg8::EpiProj E0 = E; E0.v_lo = 0; E0.v_hi = 0; pg8::gemm_phase<pg8::EpiProj, pg8::StaticOrder, true, true>(F.lds + RING_OFF, g, S, E0); GRID_BAR(); }
                  pg8::gemm_phase<pg8::EpiProj, pg8::StaticOrder, true, true>(F.lds + RING_OFF, g, S, E);
                  if (part == 0) GRID_BAR();
                }
#else
                GRID_BAR();
#endif
#ifndef SKIP_ATT
                { unsigned char* ws = get_args()->ws;
                  const attn_body::AttnTensors AT{WSP(const attn_body::bf16, WS_ACT), WSP(attn_body::bf16, WS_OB), WSP(const unsigned, NRM_OFF + (size_t)l * NRM_LAYER_BYTES)};
                  const attn_body::StaticOrder S((int)F.G, (int)blockIdx.x);
                  attn_body::attn_phase<attn_body::StaticOrder>((char*)lds + RING_OFF, AT, S);
                  for (int rep_ = 0; rep_ < PROBE_ATT; ++rep_) { GRID_BAR(); attn_body::attn_phase<attn_body::StaticOrder>((char*)lds + RING_OFF, AT, S); } }
#endif
                GRID_BAR();
#ifndef SKIP_MIX
                phase_mixer_post(F, l);
#endif
                GRID_BAR();
                for (int rep_ = 0; rep_ < PROBE_MIX; ++rep_) { phase_mixer_post(F, l); GRID_BAR(); }
#ifndef SKIP_GOUT
                { unsigned char* ws = get_args()->ws; pg8::ssq_t* SS = WSP(pg8::ssq_t, SS_OFF);
                  pg8::Gemm g{WSP(bf16, WS_YM), (const bf16*)(ws + wl + WS_WOUT), M, DM, DM}; pg8::StaticOrder S; S.init(M, DM, F.G, (int)blockIdx.x);
                  pg8::EpiResid E{nullptr, WSP(bf16, WS_XB), SS + (size_t)(3 * l + 2) * M, 1.0f, DM, 1};
                  for (int rep_ = 0; rep_ < PROBE_GOUT; ++rep_) { pg8::EpiResid E0 = E; E0.alpha = 0.f; E0.do_ss = 0; pg8::gemm_phase<pg8::EpiResid, pg8::StaticOrder, true, true>(F.lds + RING_OFF, g, S, E0); GRID_BAR(); }
                  pg8::gemm_phase<pg8::EpiResid, pg8::StaticOrder, true, true>(F.lds + RING_OFF, g, S, E); }
#endif
                GRID_BAR();
            }
#ifndef SKIP_GGU
            { unsigned char* ws = get_args()->ws; pg8::ssq_t* SS = WSP(pg8::ssq_t, SS_OFF);
              pg8::Gemm g{WSP(bf16, WS_XB), (const bf16*)(ws + wl + (half ? WS_WGU2 : WS_WGU1)), M, 2 * FF, DM}; pg8::StaticOrder S; S.init(M, 2 * FF, F.G, (int)blockIdx.x);
              int rb_ = 0; const LAS float* rt_ = fill_rstab(F, SS + (size_t)(3 * l + 2 * half) * M, 1.0f / DM, &rb_);
              pg8::EpiSwiGLU E{WSP(bf16, WS_ACT), FF, SS + (size_t)(3 * l + 2 * half) * M, 1.0f / DM, rt_, rb_};
#if PROBE_SPLIT
              S.i_hi = 6; pg8::gemm_phase<pg8::EpiSwiGLU, pg8::StaticOrder, true, true>(F.lds + RING_OFF, g, S, E); GRID_BAR(); S.i_lo = 6; S.i_hi = 1 << 30;
#endif
              pg8::gemm_phase<pg8::EpiSwiGLU, pg8::StaticOrder, true, true>(F.lds + RING_OFF, g, S, E);
              for (int rep_ = 0; rep_ < PROBE_GGU; ++rep_) { GRID_BAR(); pg8::gemm_phase<pg8::EpiSwiGLU, pg8::StaticOrder, true, true>(F.lds + RING_OFF, g, S, E); } }
#endif
            GRID_BAR();
#ifndef SKIP_GDN
            { const ArgsP ap = get_args(); unsigned char* ws = ap->ws; pg8::ssq_t* SS = WSP(pg8::ssq_t, SS_OFF);
              pg8::Gemm g{WSP(bf16, WS_ACT), (const bf16*)(ws + wl + (half ? WS_WD2 : WS_WD1)), M, DM, FF}; pg8::StaticOrder S; S.init(M, DM, F.G, (int)blockIdx.x);
              pg8::EpiResid E{(l == 0 && half == 0) ? ap->in[0] : (const float*)nullptr, WSP(bf16, WS_XB), SS + (size_t)(3 * l + 2 * half + 1) * M, 0.5f, DM, 1};
              for (int rep_ = 0; rep_ < PROBE_GDN; ++rep_) { pg8::EpiResid E0 = E; E0.alpha = 0.f; E0.do_ss = 0; pg8::gemm_phase<pg8::EpiResid, pg8::StaticOrder, true, true>(F.lds + RING_OFF, g, S, E0); GRID_BAR(); }
              pg8::gemm_phase<pg8::EpiResid, pg8::StaticOrder, true, true>(F.lds + RING_OFF, g, S, E); }
#endif
            GRID_BAR();
        }
    }
#ifndef SKIP_FIN
    phase_final(F);
#endif
}

extern "C" void kernel_launch(void* const* d_in, const int* in_sizes, int n_in, void* d_out, int out_size, void* d_ws, size_t ws_size, hipStream_t stream) {
    static int grid = 0;
    if (grid == 0) {
        if (n_in != 19 || in_sizes[0] != M * DM || out_size != M * DM || ws_size < WS_END) { fprintf(stderr, "kernel_launch: unexpected shapes / workspace (%zu < %zu)\n", ws_size, (size_t)WS_END); grid = -1; return; }
        int dev = 0, cus = 0, per_cu = 0;
        if (hipGetDevice(&dev) != hipSuccess || hipDeviceGetAttribute(&cus, hipDeviceAttributeMultiprocessorCount, dev) != hipSuccess) { grid = -1; return; }
        if (hipFuncSetAttribute((const void*)mega_fwd, hipFuncAttributeMaxDynamicSharedMemorySize, LDS_BYTES) != hipSuccess) { grid = -1; return; }
        if (hipOccupancyMaxActiveBlocksPerMultiprocessor(&per_cu, (const void*)mega_fwd, NWAVES * 64, LDS_BYTES) != hipSuccess || per_cu < 1) { fprintf(stderr, "kernel_launch: occupancy query says %d\n", per_cu); }
        (void)hipGetLastError();
        grid = cus;
    }
    if (grid < 0) return;
    if (hipMemsetAsync((char*)d_ws + WS_CTL, 0, CTL_ZERO_BYTES, stream) != hipSuccess) return;
    Args a{};
    for (int i = 0; i < 19; ++i) a.in[i] = (const float*)d_in[i];
    a.out = (float*)d_out; a.ws = (unsigned char*)d_ws;
    hipLaunchKernelGGL(mega_fwd, dim3(grid), dim3(NWAVES * 64), LDS_BYTES, stream, a);
}
```

```cpp
#include <hip/hip_runtime.h>
#include <cstdio>
#include <cstdint>
#ifndef PROBE_W
#define PROBE_W 0
#endif
#ifndef PROBE_ATT
#define PROBE_ATT 0
#endif
#ifndef PROBE_MIX
#define PROBE_MIX 0
#endif
#ifndef PROBE_GGU
#define PROBE_GGU 0
#endif
#ifndef PROBE_GDN
#define PROBE_GDN 0
#endif
#ifndef PROBE_GOUT
#define PROBE_GOUT 0
#endif
#ifndef PROBE_GIN
#define PROBE_GIN 0
#endif
#ifndef PROBE_BAR
#define PROBE_BAR 0
#endif
#ifndef PROBE_SPLIT
#define PROBE_SPLIT 0
#endif
#ifndef W_UPFRONT
#define W_UPFRONT 1
#endif
namespace pg8 {
#define PG8_LAS __attribute__((address_space(3)))
typedef unsigned short bf16_t;
typedef short bf16x8 __attribute__((ext_vector_type(8)));
typedef float f32x4 __attribute__((ext_vector_type(4)));
typedef unsigned u32x4 __attribute__((ext_vector_type(4)));
constexpr int BM = 256, BK = 64, HALF = 128, HTB = HALF * BK * 2  , STAGE_BYTES = 8 * HTB, NXCD = 8, WGM = 8;

__host__ __device__ __forceinline__ int lds_byte(int r, int c) { const int st = (r >> 4) * 2 + (c >> 5), rr = r & 15, cc = c & 31, ob = rr * 64 + cc * 2; return st * 1024 + (ob ^ (((ob >> 9) & 1) << 5)); }
__host__ __device__ __forceinline__ void stage_rc(int b, int& R, int& C) { const int st = b / 1024, sb = b % 1024, swz = sb ^ (((sb >> 9) & 1) << 5); R = (st >> 1) * 16 + swz / 64; C = (st & 1) * 32 + (swz % 64) / 2; }
__host__ __device__ __forceinline__ int perm32(int rho) { const int n = rho >> 4, i = rho & 15; return 8 * (i >> 2) + 4 * n + (i & 3); }

struct Unit { int pm, pn; };
struct Gemm { const bf16_t* A; const bf16_t* Bt; int M, N, K; };

struct StaticOrder {
    int nM, nN, nwg, G, c, i_lo = 0, i_hi = 1 << 30;
    int tail = 0, tail_vcu = 0, pn_off = 0;
    __host__ __device__ void init(int M, int N, int G_, int c_) { nM = M / BM; nN = N / BM; nwg = nM * nN; G = G_; c = c_; }
    __host__ __device__ bool next(int i, Unit& u) const {
        if (tail) { if (tail != 1 || i > 0 || (tail_vcu & 1)) return false; u.pm = tail_vcu >> 2; u.pn = pn_off + ((tail_vcu >> 1) & 1); return true; }
        if (i + i_lo >= i_hi) return false;
        const long L = (long)(i + i_lo) * G + c; if (L >= nwg) return false;
        int wgid = (int)L; { const int q = nwg / NXCD, r = nwg % NXCD, xcd = wgid % NXCD, off = wgid / NXCD; wgid = (xcd < r ? xcd * (q + 1) : r * (q + 1) + (xcd - r) * q) + off; }
        const int nig = WGM * nN, gid = wgid / nig, fm = gid * WGM, gsz = (nM - fm) < WGM ? (nM - fm) : WGM;
        u.pm = fm + ((wgid % nig) % gsz); u.pn = (wgid % nig) / gsz; return true;
    }
    __device__ __forceinline__ void a_ready(const Unit&) const {}
    __device__ __forceinline__ void done(const Unit&) const {}
};

__device__ __forceinline__ unsigned cvt_pk_bf16(float lo, float hi) { unsigned r; asm volatile("v_cvt_pk_bf16_f32 %0, %1, %2" : "=v"(r) : "v"(lo), "v"(hi)); return r; }
typedef float f32x2 __attribute__((ext_vector_type(2)));
constexpr float RMS_EPS = 1e-6f;
typedef unsigned long long ssq_t;
constexpr float SSQ_SCALE = 1073741824.0f, SSQ_INV = 1.0f / 1073741824.0f;
__device__ __forceinline__ ssq_t ssq_enc(float v) { return (ssq_t)(long long)(v * SSQ_SCALE); }
__device__ __forceinline__ float ssq_dec(ssq_t v) { return (float)(long long)v * SSQ_INV; }
__device__ __forceinline__ void ssq_add(ssq_t* p, float v) { (void)__hip_atomic_fetch_add(p, ssq_enc(v), __ATOMIC_RELAXED, __HIP_MEMORY_SCOPE_AGENT); }
struct EpiSwiGLU {
    static constexpr bool PERM = true, AFTER_DRAIN = false;
    bf16_t* O; int ldc; const ssq_t* ss; float inv_k;
    const PG8_LAS float* rstab; int rowbase;
    __device__ __forceinline__ void operator()(const f32x4 (&acc)[2][2][4][2], const Unit& u, int wr, int wc, int fr, int fq) const {
        const int row0 = u.pm * BM + wr * 64 + fr, col0 = u.pn * HALF + wc * 32 + 8 * fq;
        float rsv[8];
        if (rstab) {
#pragma unroll
            for (int i = 0; i < 8; ++i) rsv[i] = rstab[row0 - rowbase + (i >> 2) * HALF + (i & 3) * 16];
        } else { ssq_t sv[8];
#pragma unroll
            for (int i = 0; i < 8; ++i) sv[i] = ss[row0 + (i >> 2) * HALF + (i & 3) * 16];
#pragma unroll
            for (int i = 0; i < 8; ++i) rsv[i] = __builtin_amdgcn_rsqf(ssq_dec(sv[i]) * inv_k + RMS_EPS); }
#pragma unroll
        for (int ai = 0; ai < 2; ++ai)
#pragma unroll
            for (int m = 0; m < 4; ++m) { const int row = row0 + ai * HALF + m * 16; const float rs = rsv[ai * 4 + m];
                const float k1 = rs * -1.4426950408889634f, k2 = rs * rs; f32x2 o[4];
#pragma unroll
                for (int n = 0; n < 2; ++n)
#pragma unroll
                    for (int h = 0; h < 2; ++h) { const f32x2 g = (f32x2){acc[ai][0][m][n][2 * h], acc[ai][0][m][n][2 * h + 1]}, up = (f32x2){acc[ai][1][m][n][2 * h], acc[ai][1][m][n][2 * h + 1]};
                        const f32x2 t = g * k1; f32x2 e; e.x = __builtin_amdgcn_exp2f(t.x); e.y = __builtin_amdgcn_exp2f(t.y);
                        const f32x2 d = e + 1.0f; f32x2 r; r.x = __builtin_amdgcn_rcpf(d.x); r.y = __builtin_amdgcn_rcpf(d.y);
                        o[2 * n + h] = ((g * up) * k2) * r; }
                u32x4 w; w.x = cvt_pk_bf16(o[0].x, o[0].y); w.y = cvt_pk_bf16(o[1].x, o[1].y); w.z = cvt_pk_bf16(o[2].x, o[2].y); w.w = cvt_pk_bf16(o[3].x, o[3].y);
                *(u32x4*)(O + (size_t)row * ldc + col0) = w; }
    }
};
constexpr int NRM_K_WORD = 64 * 32;
struct EpiProj {
    static constexpr bool PERM = true, AFTER_DRAIN = false;
    bf16_t* O; int ldc; const ssq_t* ss; float inv_k; ssq_t* ssv; float qscale; int q_lo, q_hi, v_lo, v_hi;
    const PG8_LAS float* rstab; int rowbase;
    unsigned* nrm = nullptr;
    __device__ __forceinline__ void operator()(const f32x4 (&acc)[2][2][4][2], const Unit& u, int wr, int wc, int fr, int fq) const {
        const int row0 = u.pm * BM + wr * 64 + fr, col0 = u.pn * BM + wc * 32 + 8 * fq;
        const float cs = (u.pn >= q_lo && u.pn < q_hi) ? qscale : 1.0f; const bool isv = (u.pn >= v_lo && u.pn < v_hi);
        const bool isn = nrm && (u.pn >= q_lo && u.pn < 2 * q_hi - q_lo); float nmx0 = 0.f, nmx1 = 0.f;
        float rsv[8];
        if (rstab) {
#pragma unroll
            for (int i = 0; i < 8; ++i) rsv[i] = rstab[row0 - rowbase + (i >> 2) * HALF + (i & 3) * 16];
        } else { ssq_t sv[8];
#pragma unroll
            for (int i = 0; i < 8; ++i) sv[i] = ss[row0 + (i >> 2) * HALF + (i & 3) * 16];
#pragma unroll
            for (int i = 0; i < 8; ++i) rsv[i] = __builtin_amdgcn_rsqf(ssq_dec(sv[i]) * inv_k + RMS_EPS); }
#pragma unroll
        for (int ai = 0; ai < 2; ++ai)
#pragma unroll
            for (int m = 0; m < 4; ++m) { const int row = row0 + ai * HALF + m * 16; const float rs = rsv[ai * 4 + m] * cs; float sqb[2];
#pragma unroll
                for (int bj = 0; bj < 2; ++bj) { const f32x4 v0 = acc[ai][bj][m][0] * rs, v1 = acc[ai][bj][m][1] * rs;
                    sqb[bj] = (v0[0] * v0[0] + v0[1] * v0[1]) + (v0[2] * v0[2] + v0[3] * v0[3]) + (v1[0] * v1[0] + v1[1] * v1[1]) + (v1[2] * v1[2] + v1[3] * v1[3]);
                    u32x4 w; w.x = cvt_pk_bf16(v0[0], v0[1]); w.y = cvt_pk_bf16(v0[2], v0[3]); w.z = cvt_pk_bf16(v1[0], v1[1]); w.w = cvt_pk_bf16(v1[2], v1[3]);
                    *(u32x4*)(O + (size_t)row * ldc + col0 + bj * HALF) = w; }
                if (isv) { float sq = sqb[0] + sqb[1]; sq += __shfl_xor(sq, 16); sq += __shfl_xor(sq, 32); if (fq == 0) ssq_add(ssv + row, sq); }
                if (isn) { float a = sqb[0], b = sqb[1]; a += __shfl_xor(a, 16); b += __shfl_xor(b, 16); a += __shfl_xor(a, 32); b += __shfl_xor(b, 32);
                    nmx0 = fmaxf(nmx0, a); nmx1 = fmaxf(nmx1, b); } }
        if (isn) {
#pragma unroll
            for (int d = 1; d < 16; d <<= 1) { nmx0 = fmaxf(nmx0, __shfl_xor(nmx0, d)); nmx1 = fmaxf(nmx1, __shfl_xor(nmx1, d)); }
            const bool isq = u.pn < q_hi; const int g8 = (u.pn - (isq ? q_lo : q_hi)) * 8 + wc;
            unsigned* t = nrm + (isq ? (u.pm * 32) : (NRM_K_WORD + (u.pm >> 4) * 32)) + g8;
            if (fr == 0 && fq == 0) { (void)__hip_atomic_fetch_max(t, __float_as_uint(nmx0), __ATOMIC_RELAXED, __HIP_MEMORY_SCOPE_AGENT); (void)__hip_atomic_fetch_max(t + 4, __float_as_uint(nmx1), __ATOMIC_RELAXED, __HIP_MEMORY_SCOPE_AGENT); } }
    }
};
struct EpiResid {
    static constexpr bool PERM = true, AFTER_DRAIN = false;
    const float* xin_f32; bf16_t* xb; ssq_t* ss_out; float alpha; int ldc; int do_ss;
    __device__ __forceinline__ void operator()(const f32x4 (&acc)[2][2][4][2], const Unit& u, int wr, int wc, int fr, int fq) const {
        const int row0 = u.pm * BM + wr * 64 + fr, col0 = u.pn * BM + wc * 32 + 8 * fq;
#pragma unroll
        for (int ai = 0; ai < 2; ++ai)
#pragma unroll
            for (int m = 0; m < 4; ++m) { const int row = row0 + ai * HALF + m * 16; const size_t off = (size_t)row * ldc + col0; float sq = 0.f;
#pragma unroll
                for (int bj = 0; bj < 2; ++bj) { f32x4 b0, b1;
                    if (xin_f32) { b0 = *(const f32x4*)(xin_f32 + off + bj * HALF); b1 = *(const f32x4*)(xin_f32 + off + bj * HALF + 4); }
                    else { const u32x4 x = *(const u32x4*)(xb + off + bj * HALF);
                        b0 = (f32x4){__uint_as_float(x.x << 16), __uint_as_float(x.x & 0xffff0000u), __uint_as_float(x.y << 16), __uint_as_float(x.y & 0xffff0000u)};
                        b1 = (f32x4){__uint_as_float(x.z << 16), __uint_as_float(x.z & 0xffff0000u), __uint_as_float(x.w << 16), __uint_as_float(x.w & 0xffff0000u)}; }
                    const f32x4 v0 = b0 + acc[ai][bj][m][0] * alpha, v1 = b1 + acc[ai][bj][m][1] * alpha;
                    u32x4 w; w.x = cvt_pk_bf16(v0[0], v0[1]); w.y = cvt_pk_bf16(v0[2], v0[3]); w.z = cvt_pk_bf16(v1[0], v1[1]); w.w = cvt_pk_bf16(v1[2], v1[3]);
                    *(u32x4*)(xb + off + bj * HALF) = w;
                    const float r0 = __uint_as_float(w.x << 16), r1 = __uint_as_float(w.x & 0xffff0000u), r2 = __uint_as_float(w.y << 16), r3 = __uint_as_float(w.y & 0xffff0000u),
                                r4 = __uint_as_float(w.z << 16), r5 = __uint_as_float(w.z & 0xffff0000u), r6 = __uint_as_float(w.w << 16), r7 = __uint_as_float(w.w & 0xffff0000u);
                    sq += (r0 * r0 + r1 * r1) + (r2 * r2 + r3 * r3) + (r4 * r4 + r5 * r5) + (r6 * r6 + r7 * r7); }
                sq += __shfl_xor(sq, 16); sq += __shfl_xor(sq, 32); if (fq == 0 && do_ss) ssq_add(ss_out + row, sq);
                if (m & 1) asm volatile("" ::: "memory"); }
    }
};

template <class Epi, class Sched, bool ALIGN_EPI = false, bool SP2 = false>
__device__ __forceinline__ void gemm_phase(PG8_LAS unsigned char* lds, const Gemm g, const Sched& S, const Epi& E) {
    int tid_ = threadIdx.x; asm volatile("" : "+v"(tid_));
    const int tid = tid_, wid = __builtin_amdgcn_readfirstlane(tid >> 6), lane = tid & 63, wr = wid >> 2, wc = wid & 3, fr = lane & 15, fq = lane >> 4;
    const int K = g.K, nt = K / BK;
    unsigned voffA[2], voffB[2];
#pragma unroll
    for (int i = 0; i < 2; ++i) { int R, C; stage_rc(tid * 16 + i * 8192, R, C); const int Rb = Epi::PERM ? ((R & ~31) + perm32(R & 31)) : R;
        voffA[i] = (unsigned)(R * K + C) * 2u; voffB[i] = (unsigned)(Rb * K + C) * 2u; }
    const size_t kstep = (size_t)(BK * 2);
    const size_t hstep = (size_t)HALF * K * 2;
    const size_t tstep = 2 * hstep;
    const unsigned ldsw = (unsigned)wid * 1024u;
    const int aoff = lds_byte(wr * 64 + fr, fq * 8), boff = lds_byte(wc * 32 + fr, fq * 8);
#define PG8_SA(b, h) (((b) * 2 + (h)) * HTB)
#define PG8_SB(b, h) ((4 + (b) * 2 + (h)) * HTB)
#define PG8_STAGE(bufoff, gbase, voff) do { _Pragma("unroll") for (int _i = 0; _i < 2; ++_i) \
        __builtin_amdgcn_global_load_lds((const unsigned*)((const char*)(gbase) + (voff)[_i]), (PG8_LAS unsigned*)(lds + (bufoff) + ldsw + _i * 8192), 16, 0, 0); } while (0)
#define PG8_LDA(dst, b, h) do { _Pragma("unroll") for (int m = 0; m < 4; ++m) _Pragma("unroll") for (int k = 0; k < 2; ++k) dst[m][k] = *(const PG8_LAS bf16x8*)(lds + PG8_SA(b, h) + aoff + m * 2048 + k * 1024); } while (0)
#define PG8_LDB(dst, b, h) do { _Pragma("unroll") for (int n = 0; n < 2; ++n) _Pragma("unroll") for (int k = 0; k < 2; ++k) dst[n][k] = *(const PG8_LAS bf16x8*)(lds + PG8_SB(b, h) + boff + n * 2048 + k * 1024); } while (0)
#define PG8_MMA(ai, bj, At, Bt) do { __builtin_amdgcn_s_setprio(1); _Pragma("unroll") for (int n = 0; n < 2; ++n) _Pragma("unroll") for (int m = 0; m < 4; ++m) _Pragma("unroll") for (int k = 0; k < 2; ++k) { \
        acc[ai][bj][m][n] = __builtin_amdgcn_mfma_f32_16x16x32_bf16(Bt[n][k], At[m][k], acc[ai][bj][m][n], 0, 0, 0); __builtin_amdgcn_sched_barrier(0); } __builtin_amdgcn_s_setprio(0); } while (0)
#define PG8_MFMA1(ai, bj, Bt, m, n, k) do { acc[ai][bj][m][n] = __builtin_amdgcn_mfma_f32_16x16x32_bf16(Bt[n][k], At[m][k], acc[ai][bj][m][n], 0, 0, 0); __builtin_amdgcn_sched_barrier(0); } while (0)
#define PG8_MFMA1Z(ai, bj, Bt, m, n, k) do { asm volatile("v_mfma_f32_16x16x32_bf16 %0, %1, %2, 0" : "+v"(acc[ai][bj][m][n]) : "v"(Bt[n][k]), "v"(At[m][k])); __builtin_amdgcn_sched_barrier(0); } while (0)
#define PG8_MMA2Z(ai) do { __builtin_amdgcn_s_setprio(1); _Pragma("unroll") for (int m = 0; m < 4; ++m) { PG8_MFMA1Z(ai, 0, B0, m, 0, 0); PG8_MFMA1(ai, 0, B0, m, 0, 1); PG8_MFMA1Z(ai, 0, B0, m, 1, 1); PG8_MFMA1(ai, 0, B0, m, 1, 0); \
        PG8_MFMA1Z(ai, 1, B1, m, 0, 0); PG8_MFMA1(ai, 1, B1, m, 0, 1); PG8_MFMA1Z(ai, 1, B1, m, 1, 1); PG8_MFMA1(ai, 1, B1, m, 1, 0); } __builtin_amdgcn_s_setprio(0); } while (0)
#define PG8_MMA2(ai) do { __builtin_amdgcn_s_setprio(1); _Pragma("unroll") for (int m = 0; m < 4; ++m) { PG8_MFMA1(ai, 0, B0, m, 0, 0); PG8_MFMA1(ai, 0, B0, m, 0, 1); PG8_MFMA1(ai, 0, B0, m, 1, 1); PG8_MFMA1(ai, 0, B0, m, 1, 0); \
        PG8_MFMA1(ai, 1, B1, m, 0, 0); PG8_MFMA1(ai, 1, B1, m, 0, 1); PG8_MFMA1(ai, 1, B1, m, 1, 1); PG8_MFMA1(ai, 1, B1, m, 1, 0); } __builtin_amdgcn_s_setprio(0); } while (0)
#define PG8_WAIT_V(n) asm volatile("s_waitcnt vmcnt(" #n ")" ::: "memory")
#define PG8_WAIT_L(n) asm volatile("s_waitcnt lgkmcnt(" #n ")" ::: "memory")
#define PG8_BAR __builtin_amdgcn_s_barrier()
#define PG8_SCHED __builtin_amdgcn_sched_barrier(0)
#define PG8_KITER_SP2(MZ) do { \
            PG8_LDB(B0, 0, 0); PG8_LDB(B1, 0, 1); PG8_SCHED; PG8_LDA(At, 0, 0); PG8_STAGE(PG8_SA(1, 1), a1 + hstep, voffA); \
            PG8_WAIT_V(8); PG8_WAIT_L(0); PG8_BAR; PG8_MMA2##MZ(0); PG8_BAR; PG8_SCHED; \
            PG8_LDA(At, 0, 1); PG8_STAGE(PG8_SB(0, 0), b2, voffB); PG8_STAGE(PG8_SB(0, 1), b2 + hstep, voffB); PG8_STAGE(PG8_SA(0, 0), a2, voffA); \
            PG8_WAIT_V(8); PG8_WAIT_L(0); PG8_BAR; PG8_MMA2##MZ(1); PG8_BAR; PG8_SCHED; \
            PG8_LDB(B0, 1, 0); PG8_LDB(B1, 1, 1); PG8_SCHED; PG8_LDA(At, 1, 0); PG8_STAGE(PG8_SA(0, 1), a2 + hstep, voffA); \
            PG8_WAIT_V(8); PG8_WAIT_L(0); PG8_BAR; PG8_MMA2(0); PG8_BAR; PG8_SCHED; \
            PG8_LDA(At, 1, 1); PG8_STAGE(PG8_SB(1, 0), b3, voffB); PG8_STAGE(PG8_SB(1, 1), b3 + hstep, voffB); PG8_STAGE(PG8_SA(1, 0), a3, voffA); \
            PG8_WAIT_V(8); PG8_WAIT_L(0); PG8_BAR; PG8_MMA2(1); PG8_BAR; PG8_SCHED; \
            } while (0)
    Unit cur, nxt; int ui = 0;
    if (!S.next(0, cur)) return;
    f32x4 acc[2][2][4][2];
#pragma unroll
    for (int a = 0; a < 2; ++a)
#pragma unroll
        for (int b = 0; b < 2; ++b)
#pragma unroll
            for (int m = 0; m < 4; ++m)
#pragma unroll
                for (int n = 0; n < 2; ++n) acc[a][b][m][n] = (f32x4){0.f, 0.f, 0.f, 0.f};
    bf16x8 At[4][2], B0[2][2], B1[2][2];
    const char* cA = (const char*)g.A + (size_t)cur.pm * tstep; const char* cB = (const char*)g.Bt + (size_t)cur.pn * tstep;
    S.a_ready(cur);
    if constexpr (SP2) {
        PG8_STAGE(PG8_SB(0, 0), cB, voffB); PG8_STAGE(PG8_SB(0, 1), cB + hstep, voffB); PG8_STAGE(PG8_SA(0, 0), cA, voffA); PG8_STAGE(PG8_SA(0, 1), cA + hstep, voffA);
        if (wr == 1) PG8_BAR;
        PG8_WAIT_V(2); PG8_BAR;
        PG8_STAGE(PG8_SB(1, 0), cB + kstep, voffB); PG8_STAGE(PG8_SA(1, 0), cA + kstep, voffA); PG8_STAGE(PG8_SB(1, 1), cB + hstep + kstep, voffB);
        PG8_WAIT_V(6); PG8_BAR;
    } else {
        PG8_STAGE(PG8_SB(0, 0), cB, voffB); PG8_STAGE(PG8_SA(0, 0), cA, voffA); PG8_STAGE(PG8_SB(0, 1), cB + hstep, voffB); PG8_STAGE(PG8_SA(0, 1), cA + hstep, voffA);
        if (wr == 1) PG8_BAR;
        PG8_WAIT_V(4); PG8_BAR;
        PG8_STAGE(PG8_SB(1, 0), cB + kstep, voffB); PG8_STAGE(PG8_SA(1, 0), cA + kstep, voffA); PG8_STAGE(PG8_SB(1, 1), cB + hstep + kstep, voffB);
        PG8_WAIT_V(6); PG8_BAR;
    }
    for (;;) {
        const bool has_next = S.next(ui + 1, nxt);
        const char* nA = has_next ? (const char*)g.A + (size_t)nxt.pm * tstep : cA; const char* nB = has_next ? (const char*)g.Bt + (size_t)nxt.pn * tstep : cB;
        if constexpr (SP2) {
            { const int t = 0;
            const bool last = (t == nt - 2);
            const char* a1 = cA + (size_t)(t + 1) * kstep;
            const char* a2 = last ? nA : cA + (size_t)(t + 2) * kstep; const char* b2 = last ? nB : cB + (size_t)(t + 2) * kstep;
            const char* a3 = a2 + kstep; const char* b3 = b2 + kstep;
            if (last && has_next) S.a_ready(nxt);
            PG8_KITER_SP2(Z); }
            for (int t = 2; t < nt; t += 2) {
            const bool last = (t == nt - 2);
            const char* a1 = cA + (size_t)(t + 1) * kstep;
            const char* a2 = last ? nA : cA + (size_t)(t + 2) * kstep; const char* b2 = last ? nB : cB + (size_t)(t + 2) * kstep;
            const char* a3 = a2 + kstep; const char* b3 = b2 + kstep;
            if (last && has_next) S.a_ready(nxt);
            PG8_KITER_SP2(); }
        } else {
        for (int t = 0; t < nt; t += 2) {
            const bool last = (t == nt - 2);
            const char* a1 = cA + (size_t)(t + 1) * kstep;
            const char* a2 = last ? nA : cA + (size_t)(t + 2) * kstep; const char* b2 = last ? nB : cB + (size_t)(t + 2) * kstep;
            const char* a3 = a2 + kstep; const char* b3 = b2 + kstep;
            if (last && has_next) S.a_ready(nxt);
            PG8_LDB(B0, 0, 0); PG8_SCHED; PG8_LDA(At, 0, 0); PG8_STAGE(PG8_SA(1, 1), a1 + hstep, voffA);
            PG8_WAIT_L(8); PG8_BAR; PG8_WAIT_L(0); PG8_MMA(0, 0, At, B0); PG8_BAR; PG8_SCHED;
            PG8_LDB(B1, 0, 1); PG8_STAGE(PG8_SB(0, 0), b2, voffB);
            PG8_BAR; PG8_WAIT_L(0); PG8_MMA(0, 1, At, B1); PG8_BAR;
            PG8_LDA(At, 0, 1); PG8_STAGE(PG8_SA(0, 0), a2, voffA);
            PG8_BAR; PG8_WAIT_L(0); PG8_MMA(1, 0, At, B0); PG8_BAR; PG8_SCHED;
            PG8_STAGE(PG8_SB(0, 1), b2 + hstep, voffB);
            PG8_WAIT_V(6); PG8_BAR; PG8_MMA(1, 1, At, B1); PG8_BAR;
            PG8_LDB(B0, 1, 0); PG8_SCHED; PG8_LDA(At, 1, 0); PG8_STAGE(PG8_SA(0, 1), a2 + hstep, voffA);
            PG8_WAIT_L(8); PG8_BAR; PG8_WAIT_L(0); PG8_MMA(0, 0, At, B0); PG8_BAR; PG8_SCHED;
            PG8_LDB(B1, 1, 1); PG8_STAGE(PG8_SB(1, 0), b3, voffB);
            PG8_BAR; PG8_WAIT_L(0); PG8_MMA(0, 1, At, B1); PG8_BAR;
            PG8_LDA(At, 1, 1); PG8_STAGE(PG8_SA(1, 0), a3, voffA);
            PG8_BAR; PG8_WAIT_L(0); PG8_MMA(1, 0, At, B0); PG8_BAR; PG8_SCHED;
            PG8_STAGE(PG8_SB(1, 1), b3 + hstep, voffB);
            PG8_WAIT_V(6); PG8_BAR; PG8_MMA(1, 1, At, B1); PG8_BAR;
        }
        }
        if constexpr (ALIGN_EPI) { if (wr == 0) PG8_BAR; }
        if constexpr (!Epi::AFTER_DRAIN) { E(acc, cur, wr, wc, fr, fq); S.done(cur); }
        if (!has_next) break;
        if constexpr (!SP2) {
#pragma unroll
        for (int a = 0; a < 2; ++a)
#pragma unroll
            for (int b = 0; b < 2; ++b)
#pragma unroll
                for (int m = 0; m < 4; ++m)
#pragma unroll
                    for (int n = 0; n < 2; ++n) acc[a][b][m][n] = (f32x4){0.f, 0.f, 0.f, 0.f};
        }
        cur = nxt; cA = nA; cB = nB; ++ui;
        if constexpr (ALIGN_EPI) { if (wr == 1) PG8_BAR; }
    }
    PG8_WAIT_V(0);
    if constexpr (!ALIGN_EPI) { if (wr == 0) PG8_BAR; }
    PG8_BAR;
    if constexpr (Epi::AFTER_DRAIN) { E.fused(acc, cur, wr, wc, fr, fq, lds, wid, lane); S.done(cur); }
#undef PG8_SA
#undef PG8_SB
#undef PG8_STAGE
#undef PG8_LDA
#undef PG8_LDB
#undef PG8_MMA
#undef PG8_MMA2
#undef PG8_MMA2Z
#undef PG8_KITER_SP2
#undef PG8_MFMA1Z
#undef PG8_MFMA1
#undef PG8_WAIT_V
#undef PG8_WAIT_L
#undef PG8_BAR
#undef PG8_SCHED
}
}
#include <hip/hip_bf16.h>
#include <cmath>
namespace attn_body {
using bf16=__hip_bfloat16;
using bf16x8=__attribute__((ext_vector_type(8)))short;
using s16x4=__attribute__((ext_vector_type(4)))short;
using f32x16=__attribute__((ext_vector_type(16)))float;
using u32x4=__attribute__((ext_vector_type(4)))unsigned;
constexpr int SEQ=4096,D=64,DM=5632,DMO=2048;
constexpr int NW=8,QBLK=32,QB=QBLK*NW,KVBLK=64,NQB=SEQ/QB;
constexpr int ATTN_PITCH=DM, ATTN_UNIT_ROWS=QB;
constexpr float LOG2E=1.4426950408889634f;
__device__ __forceinline__ int crow(int r,int hi){return (r&3)+8*(r>>2)+4*hi;}
#define SBAR() __builtin_amdgcn_sched_barrier(0)
__device__ __forceinline__ void cmask(f32x16&p0,f32x16&p1,int jb,int qrel,int hi){
  const float NEG=-INFINITY; int kb=64*jb+4*hi;
  #pragma unroll
  for(int r=0;r<16;++r){int kv=kb+(r&3)+8*(r>>2); if(kv>qrel)p0[r]=NEG; if(kv+32>qrel)p1[r]=NEG;}
}

constexpr int NSLOT=3, SLOTB=8192, VSLOTB=16384;
constexpr int LDS_K=0, LDS_V=NSLOT*SLOTB, LDS_WS=LDS_V+NSLOT*VSLOTB, LDS_OST=LDS_WS+NW*64*4, LDS_BYTES=LDS_OST+NW*4096;
constexpr float C2=0.125f*1.4426950408889634f;
__device__ __forceinline__ void glds16(const void*gsrc,unsigned lds_dst){unsigned keep;
  asm volatile("s_mov_b32 %0, m0\n\ts_mov_b32 m0, %2\n\ts_nop 0\n\tglobal_load_lds_dwordx4 %1, off\n\ts_mov_b32 m0, %0":"=&s"(keep):"v"(gsrc),"s"(lds_dst):"memory");}
__device__ __forceinline__ float max3f(float a,float b,float c){float r;asm("v_max3_f32 %0, %1, %2, %3":"=v"(r):"v"(a),"v"(b),"v"(c));return r;}
__device__ __forceinline__ float max2f(float a,float b){float r;asm("v_max_f32_e32 %0, %1, %2":"=v"(r):"v"(a),"v"(b));return r;}
__device__ __forceinline__ float fadd_s(float a,float b){float r;asm("v_add_f32_e32 %0, %1, %2":"=v"(r):"v"(a),"v"(b));return r;}
__device__ __forceinline__ float fsub_s(float a,float b){float r;asm("v_sub_f32_e32 %0, %1, %2":"=v"(r):"v"(a),"v"(b));return r;}
typedef float f32x2_t __attribute__((ext_vector_type(2))); typedef __bf16 bf16x2_t __attribute__((ext_vector_type(2)));
__device__ __forceinline__ unsigned cvtpk_s(float lo,float hi){f32x2_t v={lo,hi};bf16x2_t b=__builtin_convertvector(v,bf16x2_t);return __builtin_bit_cast(unsigned,b);}
#define WAIT_BAR(N) asm volatile("s_waitcnt vmcnt(" #N ") lgkmcnt(0)\n\ts_barrier":::"memory")

__device__ __forceinline__ void qkt(f32x16&p0,f32x16&p1,const char*Kslot,const bf16x8*qr,bf16x8 ka0,bf16x8 ka1,bf16x8 qa,int r32,int hi){
  const char*kb=Kslot+hi*1024+r32*16;
  const f32x16 z=f32x16{};
  p0=__builtin_amdgcn_mfma_f32_32x32x16_bf16(ka0,qa,z,0,0,0);p1=__builtin_amdgcn_mfma_f32_32x32x16_bf16(ka1,qa,z,0,0,0);
  #pragma unroll
  for(int d0=0;d0<4;++d0){
    const bf16x8 b0=*reinterpret_cast<const bf16x8*>(kb+d0*2048);
    const bf16x8 b1=*reinterpret_cast<const bf16x8*>(kb+d0*2048+512);
    p0=__builtin_amdgcn_mfma_f32_32x32x16_bf16(b0,qr[d0],p0,0,0,0);p1=__builtin_amdgcn_mfma_f32_32x32x16_bf16(b1,qr[d0],p1,0,0,0);}
}
typedef __attribute__((address_space(3))) const char* lds_cptr;
typedef short v4i16_t __attribute__((ext_vector_type(4)));
__device__ __forceinline__ void kload8(bf16x8*kf,lds_cptr kp){
  kf[0]=*(const __attribute__((address_space(3))) bf16x8*)(kp);      kf[1]=*(const __attribute__((address_space(3))) bf16x8*)(kp+512);
  kf[2]=*(const __attribute__((address_space(3))) bf16x8*)(kp+2048); kf[3]=*(const __attribute__((address_space(3))) bf16x8*)(kp+2560);
  kf[4]=*(const __attribute__((address_space(3))) bf16x8*)(kp+4096); kf[5]=*(const __attribute__((address_space(3))) bf16x8*)(kp+4608);
  kf[6]=*(const __attribute__((address_space(3))) bf16x8*)(kp+6144); kf[7]=*(const __attribute__((address_space(3))) bf16x8*)(kp+6656);
}
__device__ __forceinline__ void kload2(bf16x8*kf,lds_cptr kp,int j){ kf[2*j]=*(const __attribute__((address_space(3))) bf16x8*)(kp+j*2048); kf[2*j+1]=*(const __attribute__((address_space(3))) bf16x8*)(kp+j*2048+512); }
__device__ __forceinline__ s16x4 vtr(lds_cptr p){ return __builtin_bit_cast(s16x4,__builtin_amdgcn_ds_read_tr16_b64_v4i16((__attribute__((address_space(3))) v4i16_t*)p)); }
__device__ __forceinline__ float rowmax(const f32x16&p0,const f32x16&p1){
  float a=max3f(p0[0],p0[1],p1[0]),b=max3f(p0[2],p0[3],p1[1]);a=max3f(a,p1[2],p1[3]);
  #pragma unroll
  for(int r=4;r<16;r+=4){a=max3f(a,p0[r],p0[r+1]);b=max3f(b,p0[r+2],p0[r+3]);a=max3f(a,p1[r],p1[r+1]);b=max3f(b,p1[r+2],p1[r+3]);}
  const float m=max2f(a,b);
  auto rr=__builtin_amdgcn_permlane32_swap(__float_as_uint(m),__float_as_uint(m),false,false);
  return max2f(__uint_as_float(rr[0]),__uint_as_float(rr[1]));
}
__device__ __forceinline__ void pv(f32x16*o,int vb,bf16x8 pa0,bf16x8 pa1,bf16x8 pa2,bf16x8 pa3){
  #pragma unroll
  for(int d0=0;d0<4;++d0){s16x4 lo[4],hi[4];
    #pragma unroll
    for(int ks=0;ks<4;++ks){
      asm volatile("ds_read_b64_tr_b16 %0,%1 offset:%c2":"=&v"(lo[ks]):"v"(vb),"i"(d0*4096+ks*1024):"memory");
      asm volatile("ds_read_b64_tr_b16 %0,%1 offset:%c2":"=&v"(hi[ks]):"v"(vb),"i"(d0*4096+ks*1024+512):"memory");}
    asm volatile("s_waitcnt lgkmcnt(0)":::"memory");SBAR();
    #define PK(k) (bf16x8){lo[k][0],lo[k][1],lo[k][2],lo[k][3],hi[k][0],hi[k][1],hi[k][2],hi[k][3]}
    o[d0]=__builtin_amdgcn_mfma_f32_32x32x16_bf16(pa0,PK(0),o[d0],0,0,0);
    o[d0]=__builtin_amdgcn_mfma_f32_32x32x16_bf16(pa1,PK(1),o[d0],0,0,0);
    o[d0]=__builtin_amdgcn_mfma_f32_32x32x16_bf16(pa2,PK(2),o[d0],0,0,0);
    o[d0]=__builtin_amdgcn_mfma_f32_32x32x16_bf16(pa3,PK(3),o[d0],0,0,0);
    #undef PK
  }
}

#ifndef ATTN_STORE16
#define ATTN_STORE16(p,v) (*(u32x4*)(p)=(v))
#endif
template<int THRL> __device__ __forceinline__ void attn_unit(int qb,const bf16*Qh,const bf16*__restrict__ Kh,const bf16*__restrict__ Vh,bf16*Oh,float sl2,char*shm,int nte,float bnd,float inv64c){
  int tid_=threadIdx.x; asm volatile("":"+v"(tid_)); const int tid=tid_,lane=tid&63,r32=lane&31,hi=lane>>5; const int wid=__builtin_amdgcn_readfirstlane(tid>>6);
  const int q0=qb*QB;
  const bf16*Qw=Qh+(long)(q0+wid*QBLK)*DM;
  const unsigned lds0=(unsigned)(uintptr_t)shm;
  float*wsf=(float*)(shm+LDS_WS)+wid*64;
  const bf16*ksrc=Kh+(long)lane*DM+wid*8;
  const bf16*vsrc=Vh+(long)(16*(wid&3)+(lane>>2))*DM+(wid>>2)*32+(lane&3)*8;
  const unsigned kdst=lds0+LDS_K+wid*1024, vdst=lds0+LDS_V+wid*1024;
  #define DMA_K(t,slot) glds16(ksrc+(long)(NTF-1-(t))*KVBLK*DM,(unsigned)__builtin_amdgcn_readfirstlane(kdst+(slot)))
  #define DMA_V(t,slot) do{ glds16(vsrc+(long)(NTF-1-(t))*KVBLK*DM,(unsigned)__builtin_amdgcn_readfirstlane(vdst+2*(slot))); glds16(vsrc+(long)(NTF-1-(t))*KVBLK*DM+64,(unsigned)__builtin_amdgcn_readfirstlane(vdst+2*(slot)+8192)); }while(0)
  const char*Kbase=shm+LDS_K; bf16x8 kf[8];
  const lds_cptr shm3=(lds_cptr)shm; const lds_cptr kp0=shm3+LDS_K+hi*1024+r32*16; const lds_cptr vp0=shm3+LDS_V+((lane>>4)&1)*32+(lane&3)*8+(4*hi+((lane&15)>>2))*64; const int vb0=(int)(unsigned)(uintptr_t)vp0;
  const int NTF=(q0+QB)/KVBLK;
  int NT=__builtin_amdgcn_readfirstlane(nte<NTF?nte:NTF);
  DMA_K(0,0);DMA_V(0,0);DMA_K(1,SLOTB);
  bf16x8 qr[4];
  #pragma unroll
  for(int d0=0;d0<4;++d0)qr[d0]=*reinterpret_cast<const bf16x8*>(&Qw[(long)r32*DM+d0*16+hi*8]);
  float mhat=0.f,l_reg=0.f;f32x16 o[4];o[0]=f32x16{};o[1]=f32x16{};o[2]=f32x16{};o[3]=f32x16{};
  const int qrel=wid*QBLK+r32;
  #define CMASK(P0,P1,t) do{int jb_=3-(t); if(jb_>=0)cmask(P0,P1,jb_,qrel,hi);}while(0)
  const unsigned hm=hi?0u:0xffffffffu;
  const unsigned c_pk=cvtpk_s(sl2,0.f)&0xffffu; const float c_hif=__uint_as_float(c_pk<<16); const unsigned c_pl=cvtpk_s(sl2-c_hif,0.f)&0xffffu;
  const unsigned qa_c=((c_pl^0x8000u)<<16)|(c_pk^0x8000u);
  u32x4 qaw=(u32x4){qa_c,qa_c,0x80008000u,0u};
  const unsigned ka_j0=hm&(cvtpk_s((float)(63-r32),0.f)&0xffffu)*0x10001u, ka_j1=hm&(cvtpk_s((float)(31-r32),0.f)&0xffffu)*0x10001u, ka_one=hm&0x3f803f80u;
  #define KA_D0(t) (hm&((__float_as_uint((float)(64*(t)))>>16)*0x10001u))
  #define KAF(d0,j) __builtin_bit_cast(bf16x8,(u32x4){(d0),(j),ka_one,0u})
  #define QAF() __builtin_bit_cast(bf16x8,qaw)
  #define SET_REF(m,out) do{ const unsigned h_=cvtpk_s((m),0.f)&0xffffu; const float hf_=__uint_as_float(h_<<16); const unsigned l_=cvtpk_s((m)-hf_,0.f)&0xffffu; \
      out=hf_+__uint_as_float(l_<<16); qaw[2]=((l_^0x8000u)<<16)|(h_^0x8000u); }while(0)
  bool started=false;
  bool resc=false;
  #define START(P0,P1) do{ const float rm=rowmax(P0,P1); resc=false; started=(rm>-INFINITY); \
    { float dl=0.f; if(started){ SET_REF(rm,dl); } mhat=dl; \
      _Pragma("unroll") for(int r=0;r<16;++r){P0[r]=fsub_s(P0[r],dl);P1[r]=fsub_s(P1[r],dl);} } \
    _Pragma("unroll") for(int r=0;r<16;++r)P0[r]=__builtin_amdgcn_exp2f(P0[r]); }while(0)
  #define RESC() do{ if(resc){ asm volatile("s_waitcnt lgkmcnt(0)":::"memory"); \
      _Pragma("unroll") for(int d_=0;d_<4;++d_) _Pragma("unroll") for(int r=0;r<16;++r)o[d_][r]*=wsf[crow(r,hi)]; } }while(0)
  f32x16 pA0,pA1,pB0,pB1;
  int sl_prev=0,sl_cur=0,sl_next=SLOTB;
  #define ROT() do{sl_prev=sl_cur;sl_cur=sl_next;sl_next=(sl_next==(NSLOT-1)*SLOTB)?0:sl_next+SLOTB;}while(0)
  DMA_K(2,2*SLOTB);
  WAIT_BAR(4);
  qkt(pA0,pA1,Kbase,qr,KAF(0u,ka_j0),KAF(0u,ka_j1),QAF(),r32,hi);asm volatile("s_nop 15\n\ts_nop 7":"+v"(pA0),"+v"(pA1));CMASK(pA0,pA1,0);
  START(pA0,pA1);
  _Pragma("unroll") for(int r=0;r<16;++r)pA1[r]=__builtin_amdgcn_exp2f(pA1[r]);
  WAIT_BAR(0);
  DMA_K(3,0);DMA_V(1,SLOTB);
  ROT();
  kload8(kf,kp0+sl_cur);
  WAIT_BAR(3);
  s16x4 vlo[8],vhi[8]; u32x4 pw0,pw1,pw2,pw3;
  #define PKW(P,B) cvtpk_s(P[B],P[B+1])
  #define PAF(k) __builtin_bit_cast(bf16x8,pw##k)
  #define VFR(i) (bf16x8){vlo[i][0],vlo[i][1],vlo[i][2],vlo[i][3],vhi[i][0],vhi[i][1],vhi[i][2],vhi[i][3]}
  #define PIN(x) asm volatile("":"+v"(x))
  #define MX3(a,b,c) __builtin_fmaxf(__builtin_fmaxf((a),(b)),(c))
  #define GAPA(MF,A0,A1,A2,A3,W0,W1,PW) do{ MF; sacc+=A0; sacc+=A1; sacc+=A2; sacc+=A3; PIN(sacc); W0; W1; PIN(PW); SBAR(); }while(0)
  #define EX(v) __builtin_amdgcn_exp2f(v)
  #define GAPB(MF,X,B) do{ MF; X[B]=EX(X[B]); X[B+1]=EX(X[B+1]); PIN(X); SBAR(); }while(0)
  #define VRDX(i,db,ks) do{ vlo[i]=vtr(vp_+((db)*4096+(ks)*1024)); vhi[i]=vtr(vp_+((db)*4096+(ks)*1024+512)); }while(0)
  #define VRD(i) VRDX(i,(i)>>2,(i)&3)
  #define VRD2(i) do{ VRDX(i,((i)>>2)+2,(i)&3); SBAR(); }while(0)
  #define KRD(G,j) do{ if(G){ kload2(kf,kp0+sl_next,j); SBAR(); } }while(0)
  #define ROWMAX(C0,C1,rm) do{ float a=MX3(C0[0],C0[1],C1[0]),b=MX3(C0[2],C0[3],C1[1]); a=MX3(a,C1[2],C1[3]); \
      _Pragma("unroll") for(int r=4;r<16;r+=4){a=MX3(a,C0[r],C0[r+1]);b=MX3(b,C0[r+2],C0[r+3]);a=MX3(a,C1[r],C1[r+1]);b=MX3(b,C1[r+2],C1[r+3]);} \
      rm=__builtin_fmaxf(a,b); { auto rr=__builtin_amdgcn_permlane32_swap(__float_as_uint(rm),__float_as_uint(rm),false,false); rm=__builtin_fmaxf(__uint_as_float(rr[0]),__uint_as_float(rr[1])); } }while(0)
  #define DECIDE(C0,C1,rm) do{ resc=false; const bool fin_=(rm>-INFINITY); \
      if(__builtin_expect(__any(started?(rm>(float)THRL):fin_),0)){ const float want=mhat+(started?__builtin_fmaxf(rm,0.f):(fin_?rm:0.f)); float nref; SET_REF(want,nref); \
        const float dl=nref-mhat; mhat=nref; \
        _Pragma("unroll") for(int r=0;r<16;++r){C0[r]-=dl;C1[r]-=dl;} \
        const float f=started?__builtin_amdgcn_exp2f(-dl):1.f; l_reg*=f; if(hi==0)wsf[r32]=f; resc=true; } \
      started=started||fin_; }while(0)
  bool dead=false;
  #define LSTEP(C0,C1,t) do{ SBAR(); \
    { const unsigned kd0_=KA_D0(t); const f32x16 z_=f32x16{}; \
      C0=__builtin_amdgcn_mfma_f32_32x32x16_bf16(KAF(kd0_,ka_j0),QAF(),z_,0,0,0); C1=__builtin_amdgcn_mfma_f32_32x32x16_bf16(KAF(kd0_,ka_j1),QAF(),z_,0,0,0); } \
    C0=__builtin_amdgcn_mfma_f32_32x32x16_bf16(kf[0],qr[0],C0,0,0,0); C1=__builtin_amdgcn_mfma_f32_32x32x16_bf16(kf[1],qr[0],C1,0,0,0); \
    C0=__builtin_amdgcn_mfma_f32_32x32x16_bf16(kf[2],qr[1],C0,0,0,0); C1=__builtin_amdgcn_mfma_f32_32x32x16_bf16(kf[3],qr[1],C1,0,0,0); \
    C0=__builtin_amdgcn_mfma_f32_32x32x16_bf16(kf[4],qr[2],C0,0,0,0); C1=__builtin_amdgcn_mfma_f32_32x32x16_bf16(kf[5],qr[2],C1,0,0,0); \
    C0=__builtin_amdgcn_mfma_f32_32x32x16_bf16(kf[6],qr[3],C0,0,0,0); C1=__builtin_amdgcn_mfma_f32_32x32x16_bf16(kf[7],qr[3],C1,0,0,0); \
    SBAR(); kload2(kf,kp0+sl_next,0); kload2(kf,kp0+sl_next,1); kload2(kf,kp0+sl_next,2); kload2(kf,kp0+sl_next,3); SBAR();     \
    DMA_K((t)+3,sl_cur); DMA_V((t)+1,sl_next); \
    resc=false; \
    { float rm; ROWMAX(C0,C1,rm); \
      if(__builtin_expect(!__all(rm<-160.f),0)){ DECIDE(C0,C1,rm); \
        _Pragma("unroll") for(int r=0;r<16;++r){C0[r]=EX(C0[r]);C1[r]=EX(C1[r]);} dead=false; } } \
    SBAR(); \
    }while(0)
  #define STEP(C0,C1,P0,P1,t,GK,GV,GL) do{ SBAR(); \
    const lds_cptr vp_=vp0+2*sl_prev; \
    { const unsigned kd0_=KA_D0(t); const f32x16 z_=f32x16{}; \
      C0=__builtin_amdgcn_mfma_f32_32x32x16_bf16(KAF(kd0_,ka_j0),QAF(),z_,0,0,0); C1=__builtin_amdgcn_mfma_f32_32x32x16_bf16(KAF(kd0_,ka_j1),QAF(),z_,0,0,0); } \
    VRD(0); SBAR(); float sacc=(P0[0]+P0[1]); \
    GAPA(C0=__builtin_amdgcn_mfma_f32_32x32x16_bf16(kf[0],qr[0],C0,0,0,0), P0[2],P0[3],P0[4],P0[5],     pw0[0]=PKW(P0,0), pw0[1]=PKW(P0,2), pw0); \
    VRD(4); SBAR(); GAPA(C1=__builtin_amdgcn_mfma_f32_32x32x16_bf16(kf[1],qr[0],C1,0,0,0), P0[6],P0[7],P0[8],P0[9],     pw0[2]=PKW(P0,4), pw0[3]=PKW(P0,6), pw0); \
    VRD(1); SBAR(); GAPA(C0=__builtin_amdgcn_mfma_f32_32x32x16_bf16(kf[2],qr[1],C0,0,0,0),   P0[10],P0[11],P0[12],P0[13], pw1[0]=PKW(P0,8), pw1[1]=PKW(P0,10), pw1); \
    VRD(5); SBAR(); GAPA(C1=__builtin_amdgcn_mfma_f32_32x32x16_bf16(kf[3],qr[1],C1,0,0,0),   P0[14],P0[15],P1[0],P1[1],   pw1[2]=PKW(P0,12),pw1[3]=PKW(P0,14), pw1); \
    VRD(2); SBAR(); GAPA(C0=__builtin_amdgcn_mfma_f32_32x32x16_bf16(kf[4],qr[2],C0,0,0,0),   P1[2],P1[3],P1[4],P1[5],     pw2[0]=PKW(P1,0), pw2[1]=PKW(P1,2), pw2); \
    VRD(6); SBAR(); GAPA(C1=__builtin_amdgcn_mfma_f32_32x32x16_bf16(kf[5],qr[2],C1,0,0,0),   P1[6],P1[7],P1[8],P1[9],     pw2[2]=PKW(P1,4), pw2[3]=PKW(P1,6), pw2); \
    VRD(3); SBAR(); GAPA(C0=__builtin_amdgcn_mfma_f32_32x32x16_bf16(kf[6],qr[3],C0,0,0,0),   P1[10],P1[11],P1[12],P1[13], pw3[0]=PKW(P1,8), pw3[1]=PKW(P1,10), pw3); \
    VRD(7); SBAR(); GAPA(C1=__builtin_amdgcn_mfma_f32_32x32x16_bf16(kf[7],qr[3],C1,0,0,0),   P1[14],P1[15],0.f,0.f,       pw3[2]=PKW(P1,12),pw3[3]=PKW(P1,14), pw3); \
    l_reg+=sacc; \
    if(GK){DMA_K((t)+3,sl_cur);} if(GV){DMA_V((t)+1,sl_next);} \
    CMASK(C0,C1,t); \
    { float rm; ROWMAX(C0,C1,rm); DECIDE(C0,C1,rm); dead=__all(rm<-160.f); } \
    SBAR(); \
    GAPB(o[0]=__builtin_amdgcn_mfma_f32_32x32x16_bf16(PAF(0),VFR(0),o[0],0,0,0), C0,0); \
    VRD2(0); GAPB(o[1]=__builtin_amdgcn_mfma_f32_32x32x16_bf16(PAF(0),VFR(4),o[1],0,0,0), C0,2); \
    VRD2(4); GAPB(o[0]=__builtin_amdgcn_mfma_f32_32x32x16_bf16(PAF(1),VFR(1),o[0],0,0,0), C0,4); \
    VRD2(1); GAPB(o[1]=__builtin_amdgcn_mfma_f32_32x32x16_bf16(PAF(1),VFR(5),o[1],0,0,0), C0,6); \
    VRD2(5); GAPB(o[0]=__builtin_amdgcn_mfma_f32_32x32x16_bf16(PAF(2),VFR(2),o[0],0,0,0), C0,8); \
    VRD2(2); GAPB(o[1]=__builtin_amdgcn_mfma_f32_32x32x16_bf16(PAF(2),VFR(6),o[1],0,0,0), C0,10); \
    VRD2(6); GAPB(o[0]=__builtin_amdgcn_mfma_f32_32x32x16_bf16(PAF(3),VFR(3),o[0],0,0,0), C0,12); \
    VRD2(3); GAPB(o[1]=__builtin_amdgcn_mfma_f32_32x32x16_bf16(PAF(3),VFR(7),o[1],0,0,0), C0,14); \
    VRD2(7); GAPB(o[2]=__builtin_amdgcn_mfma_f32_32x32x16_bf16(PAF(0),VFR(0),o[2],0,0,0), C1,0); \
    KRD(GL,0); GAPB(o[3]=__builtin_amdgcn_mfma_f32_32x32x16_bf16(PAF(0),VFR(4),o[3],0,0,0), C1,2); \
    KRD(GL,1); GAPB(o[2]=__builtin_amdgcn_mfma_f32_32x32x16_bf16(PAF(1),VFR(1),o[2],0,0,0), C1,4); \
    KRD(GL,2); GAPB(o[3]=__builtin_amdgcn_mfma_f32_32x32x16_bf16(PAF(1),VFR(5),o[3],0,0,0), C1,6); \
    KRD(GL,3); GAPB(o[2]=__builtin_amdgcn_mfma_f32_32x32x16_bf16(PAF(2),VFR(2),o[2],0,0,0), C1,8); \
    GAPB(o[3]=__builtin_amdgcn_mfma_f32_32x32x16_bf16(PAF(2),VFR(6),o[3],0,0,0), C1,10); \
    GAPB(o[2]=__builtin_amdgcn_mfma_f32_32x32x16_bf16(PAF(3),VFR(3),o[2],0,0,0), C1,12); \
    GAPB(o[3]=__builtin_amdgcn_mfma_f32_32x32x16_bf16(PAF(3),VFR(7),o[3],0,0,0), C1,14); \
    }while(0)
  int t=1;
  #define ENDW(tt) do{ if((tt)+3<NT){WAIT_BAR(3);} else if((tt)+2<NT){WAIT_BAR(2);} else {WAIT_BAR(0);} }while(0)
  for(;t<5&&t+1<NT;t+=2){
    STEP(pB0,pB1,pA0,pA1,t,(t+3<NT),(t+1<NT),(t+1<NT));       ENDW(t);   RESC(); ROT();
    STEP(pA0,pA1,pB0,pB1,t+1,(t+4<NT),(t+2<NT),(t+2<NT));     ENDW(t+1); RESC(); ROT();
  }
  if(NT>=10){
    float v_=-mhat;
    _Pragma("unroll") for(int o_=1;o_<32;o_<<=1)v_=__builtin_fmaxf(v_,__shfl_xor(v_,o_));
    if(lane==0)wsf[48]=v_;
    asm volatile("s_waitcnt lgkmcnt(0)\n\ts_barrier":::"memory");
    const float*wsx_=(const float*)(shm+LDS_WS); float mx_=wsx_[48];
    _Pragma("unroll") for(int w_=1;w_<NW;++w_)mx_=__builtin_fmaxf(mx_,wsx_[w_*64+48]);
    const float tb_=(bnd+mx_)*inv64c; int n2_=(tb_<1000.f)?2*((int)(tb_*0.5f))+2:4096; n2_=n2_<8?8:n2_;
    NT=__builtin_amdgcn_readfirstlane(n2_<NT?n2_:NT);
  }
  #undef CMASK
  #define CMASK(P0,P1,t) do{}while(0)
  while(t+5<NT){
    STEP(pB0,pB1,pA0,pA1,t,true,true,true);     WAIT_BAR(3); RESC(); ROT();
    STEP(pA0,pA1,pB0,pB1,t+1,true,true,true);   WAIT_BAR(3); RESC(); ROT();
    t+=2; if(dead) break;
  }
  if(dead){
    for(;t+5<NT;++t){
      dead=true; LSTEP(pA0,pA1,t); WAIT_BAR(3); RESC();
      if(!dead){ float sacc=pA0[0]+pA0[1]; _Pragma("unroll") for(int r=2;r<16;++r)sacc+=pA0[r]; _Pragma("unroll") for(int r=0;r<16;++r)sacc+=pA1[r]; l_reg+=sacc;
        pw0=(u32x4){PKW(pA0,0),PKW(pA0,2),PKW(pA0,4),PKW(pA0,6)};pw1=(u32x4){PKW(pA0,8),PKW(pA0,10),PKW(pA0,12),PKW(pA0,14)};pw2=(u32x4){PKW(pA1,0),PKW(pA1,2),PKW(pA1,4),PKW(pA1,6)};pw3=(u32x4){PKW(pA1,8),PKW(pA1,10),PKW(pA1,12),PKW(pA1,14)};
        SBAR(); pv(o,vb0+2*sl_cur,PAF(0),PAF(1),PAF(2),PAF(3)); }
      ROT();
    }
    dead=true; pA0=f32x16{}; pA1=f32x16{}; pB0=f32x16{}; pB1=f32x16{};
    if(!(t&1)){   }
  }
  #undef CMASK
  #define CMASK(P0,P1,t) do{int jb_=3-(t); if(jb_>=0)cmask(P0,P1,jb_,qrel,hi);}while(0)
  for(;t+1<NT;t+=2){
    STEP(pB0,pB1,pA0,pA1,t,(t+3<NT),(t+1<NT),(t+1<NT));       ENDW(t);   RESC(); ROT();
    STEP(pA0,pA1,pB0,pB1,t+1,(t+4<NT),(t+2<NT),(t+2<NT));     ENDW(t+1); RESC(); ROT();
  }
  STEP(pB0,pB1,pA0,pA1,NT-1,false,false,false); RESC();
  { float sacc=pB0[0]+pB0[1]; _Pragma("unroll") for(int r=2;r<16;++r)sacc+=pB0[r]; _Pragma("unroll") for(int r=0;r<16;++r)sacc+=pB1[r]; l_reg+=sacc;
    pw0=(u32x4){PKW(pB0,0),PKW(pB0,2),PKW(pB0,4),PKW(pB0,6)};pw1=(u32x4){PKW(pB0,8),PKW(pB0,10),PKW(pB0,12),PKW(pB0,14)};pw2=(u32x4){PKW(pB1,0),PKW(pB1,2),PKW(pB1,4),PKW(pB1,6)};pw3=(u32x4){PKW(pB1,8),PKW(pB1,10),PKW(pB1,12),PKW(pB1,14)};
    SBAR(); pv(o,vb0+2*sl_cur,PAF(0),PAF(1),PAF(2),PAF(3)); }
  #undef PKW
  #undef PAF
  #undef VFR
  #undef PIN
  #undef MX3
  #undef GAPA
  #undef GAPB
  #undef EX
  #undef VRD
  #undef VRD2
  #undef VRDX
  #undef KRD
  #undef STEP
  #undef LSTEP
  #undef ROWMAX
  #undef DECIDE
  #undef ENDW
  {auto rr=__builtin_amdgcn_permlane32_swap(__float_as_uint(l_reg),__float_as_uint(l_reg),false,false);l_reg=__uint_as_float(rr[0])+__uint_as_float(rr[1]);}
  if(hi==0)wsf[32+r32]=l_reg;asm volatile("s_waitcnt lgkmcnt(0)":::"memory");
  float rli[16];
  #pragma unroll
  for(int r=0;r<16;++r)rli[r]=__builtin_amdgcn_rcpf(wsf[32+crow(r,hi)]);
  bf16*Ow=Oh+(long)(q0+wid*QBLK)*DMO;
  { bf16*stg=(bf16*)(shm+LDS_OST)+wid*2048;
    #pragma unroll
    for(int pass=0;pass<2;++pass){
      #pragma unroll
      for(int r=0;r<16;++r){const int orow=crow(r,hi);
        #pragma unroll
        for(int d0=0;d0<2;++d0)stg[orow*64+d0*32+r32]=__float2bfloat16(o[2*pass+d0][r]*rli[r]);}
      asm volatile("s_waitcnt lgkmcnt(0)":::"memory");
      #pragma unroll
      for(int i=0;i<4;++i){const int row=i*8+(lane>>3),ch=lane&7; const u32x4 v=*(const u32x4*)(stg+row*64+ch*8); ATTN_STORE16(Ow+(long)row*DMO+pass*64+ch*8,v);}
      asm volatile("s_waitcnt lgkmcnt(0)":::"memory"); } }
  asm volatile("s_waitcnt lgkmcnt(0)\n\ts_barrier":::"memory");
  #undef DMA_K
  #undef DMA_V
  #undef CMASK
  #undef KA_D0
  #undef KAF
  #undef QAF
  #undef SET_REF
  #undef START
  #undef RESC
  #undef ROT
}
constexpr int ATTN_LDS_BYTES=LDS_BYTES;
struct AttnTensors { const bf16* P; bf16* O; const unsigned* nrm; };
struct AttnUnit { int combo; int qb; };
__device__ const unsigned char ATT_TAB[256] = {123, 45, 21, 112, 255, 255, 255, 255, 127, 55, 50, 65, 255, 255, 255, 255, 75, 44, 20, 64, 255, 255, 255, 255, 79, 118, 115, 49, 255, 255, 255, 255, 122, 68, 29, 15, 255, 255, 255, 255, 126, 119, 67, 14, 255, 255, 255, 255, 74, 52, 28, 13, 255, 255, 255, 255, 78, 71, 51, 12, 255, 255, 255, 255, 121, 69, 27, 11, 255, 255, 255, 255, 125, 59, 114, 113, 255, 255, 255, 255, 73, 53, 26, 10, 255, 255, 255, 255, 77, 58, 66, 97, 255, 255, 255, 255, 120, 70, 25, 9, 255, 255, 255, 255, 124, 63, 41, 8, 255, 255, 255, 255, 72, 54, 24, 7, 255, 255, 255, 255, 76, 62, 40, 6, 255, 255, 255, 255, 107, 47, 23, 96, 255, 255, 255, 255, 111, 102, 39, 80, 255, 255, 255, 255, 91, 46, 22, 48, 255, 255, 255, 255, 95, 86, 38, 32, 255, 255, 255, 255, 106, 100, 34, 81, 255, 255, 255, 255, 110, 103, 37, 16, 255, 255, 255, 255, 90, 84, 31, 33, 255, 255, 255, 255, 94, 87, 36, 0, 255, 255, 255, 255, 105, 85, 30, 17, 255, 255, 255, 255, 109, 57, 99, 5, 255, 255, 255, 255, 89, 116, 83, 4, 255, 255, 255, 255, 93, 56, 35, 3, 255, 255, 255, 255, 104, 117, 98, 19, 255, 255, 255, 255, 108, 61, 43, 2, 255, 255, 255, 255, 88, 101, 82, 18, 255, 255, 255, 255, 92, 60, 42, 1, 255, 255, 255, 255};
struct StaticOrder {
  int vcu, G;
  __device__ __forceinline__ explicit StaticOrder(int grid,int block):vcu((grid%8==0)?(block%8)*(grid/8)+block/8:block),G(grid){}
  __device__ __forceinline__ bool next(int i,AttnUnit&u)const{
    if(G==256){ if(i>=8)return false; const int g=vcu>>5, c=vcu&31; const int e=__builtin_amdgcn_readfirstlane((int)ATT_TAB[((g&1)*16+(c&15))*8+i]); if(e==255)return false;
      u.combo=(((g>>1)*8+(e>>4))<<1)|(c>>4); u.qb=e&15; return true; }
    const int L=i*G+vcu; if(L>=64*16)return false; u.combo=L>>4; u.qb=L&15; return true; }
};
template<class Sched,int THRL=8> __device__ __forceinline__ void attn_phase(char*lds,const AttnTensors&T,const Sched&S){
  AttnUnit u;
  for(int i=0;S.next(i,u);++i){
    const int m=u.combo&1, h=(u.combo>>1)&7, b=u.combo>>4;
    const bf16*rowp=T.P+(long)b*SEQ*DM;
    const float sl2=LOG2E*__builtin_amdgcn_exp2f(-(float)(h+1));
    int nte; float bnd, inv64c;
    { const int hm=2*h+m; const unsigned*qt=T.nrm+(b*16+u.qb)*32+2*hm, *kt=T.nrm+64*32+b*32+2*hm;
      const float q2=__uint_as_float(__hip_atomic_load(qt,__ATOMIC_RELAXED,__HIP_MEMORY_SCOPE_AGENT))+__uint_as_float(__hip_atomic_load(qt+1,__ATOMIC_RELAXED,__HIP_MEMORY_SCOPE_AGENT));
      const float k2=__uint_as_float(__hip_atomic_load(kt,__ATOMIC_RELAXED,__HIP_MEMORY_SCOPE_AGENT))+__uint_as_float(__hip_atomic_load(kt+1,__ATOMIC_RELAXED,__HIP_MEMORY_SCOPE_AGENT));
      const float B=__builtin_sqrtf(q2*k2);
      const float tb=((170.f+2.04f*B)/(0.999f*sl2)+255.f)*(1.f/64.f);
      nte=(tb<1000.f)?2*((int)(tb*0.5f))+2:4096;
      nte=__builtin_amdgcn_readfirstlane(nte);
      bnd=162.f+1.02f*B; inv64c=1.f/(64.f*0.999f*sl2); }
    attn_unit<THRL>(u.qb, rowp+1024+(2*h+m)*64, rowp+2048+(2*h+m)*64, rowp+3072+h*128, T.O+(long)b*SEQ*DMO+m*1024+h*128, sl2, lds, nte, bnd, inv64c); }
}
#undef SBAR
#undef WAIT_BAR
}
#define GAS __attribute__((address_space(1)))
#define LAS __attribute__((address_space(3)))
typedef unsigned short bf16;
typedef unsigned v4u __attribute__((ext_vector_type(4)));
typedef float f32x4 __attribute__((ext_vector_type(4)));
typedef short bf16x8 __attribute__((ext_vector_type(8)));
typedef GAS unsigned gu32;
typedef GAS unsigned long long gu64;
#define RLX_AGENT __ATOMIC_RELAXED, __HIP_MEMORY_SCOPE_AGENT
#define LDS_WAIT() asm volatile("s_waitcnt lgkmcnt(0)" ::: "memory")
#define VM_WAIT() asm volatile("s_waitcnt vmcnt(0)" ::: "memory")
__device__ __forceinline__ unsigned long long rt() { return __builtin_amdgcn_s_memrealtime(); }
__device__ __forceinline__ unsigned f2bf(float f) { unsigned u = __builtin_bit_cast(unsigned, f); return (u + 0x7fffu + ((u >> 16) & 1u)) >> 16; }
__device__ __forceinline__ unsigned pk2(float lo, float hi) { return f2bf(lo) | (f2bf(hi) << 16); }

#define XB_TMO      128
#define XB_XCNT(j)  (256  + 64 * (j))
#define XB_XSUB(j)  (1280 + 64 * (j))
#define XB_XGEN(j)  (2304 + 64 * (j))
#define XB_TOP      3328
#define XB_TOPGEN   3392
#define XCD_BAR_WORDS 3456
#define XB_SPIN_CAP (1u << 18)

__device__ __forceinline__ unsigned xb_ld(unsigned* p)              { return __hip_atomic_load(p, __ATOMIC_RELAXED, __HIP_MEMORY_SCOPE_AGENT); }
__device__ __forceinline__ unsigned xb_add(unsigned* p, unsigned v) { return __hip_atomic_fetch_add(p, v, __ATOMIC_RELAXED, __HIP_MEMORY_SCOPE_AGENT); }
__device__ __forceinline__ unsigned xb_xcc_id() { return (unsigned)__builtin_amdgcn_s_getreg((3 << 11) | 20) & 0xFu; }
#define XB_SPIN(cond, bar) do { unsigned _sp = 0; while (cond) { __builtin_amdgcn_s_sleep(1); \
    if ((++_sp & 255u) == 0u) { if (xb_ld(&(bar)[XB_TMO])) break; if (_sp > XB_SPIN_CAP) { atomicAdd(&(bar)[XB_TMO], 1u); break; } } } } while (0)

struct XcdBarrier {
    unsigned* bar; unsigned x;
    volatile LAS unsigned* st;
};

__device__ __forceinline__ XcdBarrier xcd_barrier_post(unsigned* bar, volatile LAS unsigned* st) {
    XcdBarrier b; b.bar = bar; b.x = xb_xcc_id(); b.st = st;
    if (threadIdx.x == 0) (void)xb_add(&bar[XB_XCNT(b.x)], 1u);
    return b;
}
__device__ __forceinline__ void xcd_barrier_complete(unsigned* bar, unsigned x, unsigned& nloc, unsigned& nx) {
    const unsigned G = gridDim.x * gridDim.y * gridDim.z;
    unsigned sum, cnt, mine, sp = 0u;
    for (;;) {
        sum = 0u; cnt = 0u; mine = 0u;
#pragma unroll
        for (unsigned j = 0; j < 16; ++j) { const unsigned c = xb_ld(&bar[XB_XCNT(j)]); sum += c; cnt += (c > 0u) ? 1u : 0u; mine = (j == x) ? c : mine; }
        if (sum == G) break;
        __builtin_amdgcn_s_sleep(1);
        if ((++sp & 255u) == 0u) { if (xb_ld(&bar[XB_TMO])) break; if (sp > XB_SPIN_CAP) { atomicAdd(&bar[XB_TMO], 1u); break; } }
    }
    nloc = mine > 0u ? mine : 1u; nx = cnt > 0u ? cnt : 1u;
}

__device__ __forceinline__ void xcd_barrier(const XcdBarrier& b) {
    asm volatile("s_waitcnt vmcnt(0)" ::: "memory");
    __syncthreads();
    if (threadIdx.x == 0) {
        unsigned* bar = b.bar; unsigned bx_ = b.x;
        asm volatile("" : "+s"(bar), "+s"(bx_));
        __builtin_amdgcn_s_waitcnt(0);
        unsigned nloc = b.st[0], nx = b.st[1];
        if (nloc == 0u) { xcd_barrier_complete(bar, bx_, nloc, nx); b.st[0] = nloc; b.st[1] = nx; }
        const unsigned old = xb_add(&bar[XB_XSUB(bx_)], 1u);
        const unsigned gen = old / nloc;
        if (old + 1u == (gen + 1u) * nloc) {
            __builtin_amdgcn_fence(__ATOMIC_RELEASE, "agent");
            asm volatile("s_waitcnt vmcnt(0)" ::: "memory");
            const unsigned og = xb_add(&bar[XB_TOP], 1u);
            const unsigned tg = og / nx;
            if (og + 1u == (tg + 1u) * nx) xb_add(&bar[XB_TOPGEN], 1u);
            else XB_SPIN(xb_ld(&bar[XB_TOPGEN]) == tg, bar);
            __builtin_amdgcn_fence(__ATOMIC_ACQUIRE, "agent");
            xb_add(&bar[XB_XGEN(bx_)], 1u);
            asm volatile("s_waitcnt vmcnt(0)" ::: "memory");
        } else {
            XB_SPIN(xb_ld(&bar[XB_XGEN(bx_)]) == gen, bar);
            __builtin_amdgcn_fence(__ATOMIC_ACQUIRE, "agent");
            asm volatile("s_waitcnt vmcnt(0)" ::: "memory");
        }
    }
    __syncthreads();
}

constexpr int NWAVES = 8;
struct Frame {
    LAS unsigned char* lds;
    volatile LAS unsigned* MISC;
    gu32* ctl;
    int tid, lane, wave;
    int vcu, G;
};
__device__ __forceinline__ float wave_sum(float v) {
#pragma unroll
    for (int o = 1; o < 64; o <<= 1) v += __shfl_xor(v, o);
    return v;
}
__device__ __forceinline__ float bf_lo(unsigned w) { return __uint_as_float(w << 16); }
__device__ __forceinline__ float bf_hi(unsigned w) { return __uint_as_float(w & 0xffff0000u); }

__device__ __forceinline__ void w_transpose_item(const float* W, int K, int N, const float* gain, bf16* WT, int k0, int n0, int dst_row0, LAS float* scr, int lane) {
    const GAS float* src = (const GAS float*)W + (size_t)(k0 + (lane >> 5)) * N + n0 + (lane & 31);
    float w[32];
#pragma unroll
    for (int i = 0; i < 32; ++i) w[i] = __builtin_nontemporal_load(src + (size_t)(2 * i) * N);
    const int c = lane & 7;
    f32x4 g0 = (f32x4){1.f, 1.f, 1.f, 1.f}, g1 = g0;
    if (gain) { g0 = *(const GAS f32x4*)(gain + k0 + 8 * c); g1 = *(const GAS f32x4*)(gain + k0 + 8 * c + 4); }
#pragma unroll
    for (int i = 0; i < 32; ++i) scr[(2 * i + (lane >> 5)) * 33 + (lane & 31)] = w[i];
    LDS_WAIT(); asm volatile("" ::: "memory");
#pragma unroll
    for (int j = 0; j < 4; ++j) { const int n = (lane >> 3) + 8 * j; const LAS float* s = scr + (8 * c) * 33 + n;
        v4u o; o.x = pg8::cvt_pk_bf16(s[0 * 33] * g0.x, s[1 * 33] * g0.y); o.y = pg8::cvt_pk_bf16(s[2 * 33] * g0.z, s[3 * 33] * g0.w);
        o.z = pg8::cvt_pk_bf16(s[4 * 33] * g1.x, s[5 * 33] * g1.y); o.w = pg8::cvt_pk_bf16(s[6 * 33] * g1.z, s[7 * 33] * g1.w);
        *(GAS v4u*)(WT + (size_t)(dst_row0 + n) * K + k0 + 8 * c) = o; }
    LDS_WAIT(); asm volatile("" ::: "memory");
}

constexpr int DM = 2048, NB = 4, SEQ = 4096, M = NB * SEQ, DEPTH = 4, FF = 5632, NIN = 5632, WA = 512, WBW = 1024, WC = 512;
constexpr float EPS = 1e-6f;
constexpr size_t MiB = 1u << 20;
constexpr size_t WS_CTL = 0, CTL_ZERO_BYTES = 4 * MiB;
constexpr int CW_BAR = 4096;
constexpr size_t NRM_OFF = 3 * MiB, NRM_LAYER_BYTES = 16384;
constexpr size_t SS_OFF = 64 * 1024;
static_assert(CW_BAR * 4 + XCD_BAR_WORDS * 4 <= SS_OFF && SS_OFF + 17 * (size_t)M * 8 <= NRM_OFF && NRM_OFF + 4 * NRM_LAYER_BYTES <= CTL_ZERO_BYTES && (pg8::NRM_K_WORD + 4 * 32) * 4 <= (int)NRM_LAYER_BYTES, "ctl map");
constexpr size_t WS_WGU1 = 4 * MiB, WS_WD1 = WS_WGU1 + 44 * MiB, WS_WIN = WS_WD1 + 22 * MiB, WS_WOUT = WS_WIN + 22 * MiB, WS_WGU2 = WS_WOUT + 8 * MiB, WS_WD2 = WS_WGU2 + 44 * MiB;
constexpr size_t WL_STRIDE = 162 * MiB;
constexpr size_t WS_XB = WS_WGU1 + 4 * WL_STRIDE;
constexpr size_t WS_ACT = WS_XB + 64 * MiB;
constexpr size_t WS_OB = WS_ACT + 176 * MiB;
constexpr size_t WS_YM = WS_OB + 64 * MiB;
constexpr size_t WS_END = WS_YM + 64 * MiB;
static_assert((size_t)FF * 2 * DM * 2 == 44 * MiB && (size_t)M * FF * 2 == 176 * MiB, "sizes");
constexpr int RING_OFF = 0, RING_BYTES = 131072;
constexpr int LDSCTL_OFF = RING_BYTES, MISC_OFF = LDSCTL_OFF + 320;
constexpr int LDS_BYTES = 147456;
constexpr int RSTAB_OFF = RING_BYTES + 1024;

struct Args { const float* in[19]; float* out; unsigned char* ws; };
typedef const __attribute__((address_space(4))) Args* ArgsP;
__device__ __forceinline__ ArgsP get_args() { ArgsP p = (ArgsP)__builtin_amdgcn_kernarg_segment_ptr(); asm volatile("" : "+s"(p)); return p; }

__device__ __forceinline__ const LAS float* fill_rstab(Frame& F, const pg8::ssq_t* ss, float inv_k, int* rowbase) {
    if (F.G != 256) { *rowbase = 0; return nullptr; }
    LAS float* tab = (LAS float*)(F.lds + RSTAB_OFF); const int base = 2048 * ((int)blockIdx.x & 7); *rowbase = base;
    int t_ = threadIdx.x; asm volatile("" : "+v"(t_));
#pragma unroll
    for (int i = 0; i < 4; ++i) tab[t_ + 512 * i] = __builtin_amdgcn_rsqf(pg8::ssq_dec(ss[base + t_ + 512 * i]) * inv_k + pg8::RMS_EPS);
    __syncthreads();
    return tab;
}

__device__ __forceinline__ void phase_weights(Frame& F0, int l_in, bool do_x = true, size_t dst_shift = 0) {
    int l = l_in; asm volatile("" : "+s"(l));
    Frame F = F0; asm volatile("" : "+v"(F.tid), "+v"(F.lane));
    const ArgsP ap = get_args();
    LAS float* scr = (LAS float*)(F.lds + RING_OFF + F.wave * 16384);
    const int gw = F.vcu * NWAVES + F.wave, NGW = F.G * NWAVES;
    unsigned char* ws = ap->ws + dst_shift;
    constexpr int I_BIG = (DM / 64) * (FF / 32);
    constexpr int I_OUT = (DM / 64) * (DM / 32);
    constexpr int NITEMS = 7 * I_BIG + I_OUT;
    const size_t wbig = (size_t)l * DM * FF;
    for (int it = gw; it < NITEMS; it += NGW) {
        const int which = it / I_BIG, r = it % I_BIG;
        if (which == 0 || which == 1 || which == 4 || which == 5) {
            const int f2 = which >= 4, up = which & 1;
            const float* W = ap->in[(f2 ? 15 : 2) + up] + wbig; const float* g = ap->in[f2 ? 14 : 1] + (size_t)l * DM;
            bf16* WT = (bf16*)(ws + (f2 ? WS_WGU2 : WS_WGU1));
            const int nblk = FF / 32, kb = r / nblk, nb = r % nblk, n0 = 32 * nb;
            w_transpose_item(W, DM, FF, g, WT, 64 * kb, n0, (n0 / 128) * 256 + (n0 % 128) + up * 128, scr, F.lane);
        } else if (which == 2 || which == 6) {
            const int f2 = which == 6;
            const float* W = ap->in[f2 ? 17 : 4] + wbig; bf16* WT = (bf16*)(ws + (f2 ? WS_WD2 : WS_WD1));
            const int nblk = DM / 32, kb = r / nblk, nb = r % nblk;
            w_transpose_item(W, FF, DM, nullptr, WT, 64 * kb, 32 * nb, 32 * nb, scr, F.lane);
        } else if (which == 3) {
            const float* W = ap->in[6] + wbig; const float* g = ap->in[5] + (size_t)l * DM; bf16* WT = (bf16*)(ws + WS_WIN);
            const int nblk = NIN / 32, kb = r / nblk, nb = r % nblk;
            w_transpose_item(W, DM, NIN, g, WT, 64 * kb, 32 * nb, 32 * nb, scr, F.lane);
        } else {
            const float* W = ap->in[13] + (size_t)l * DM * DM; bf16* WT = (bf16*)(ws + WS_WOUT);
            const int nblk = DM / 32, kb = r / nblk, nb = r % nblk;
            w_transpose_item(W, DM, DM, nullptr, WT, 64 * kb, 32 * nb, 32 * nb, scr, F.lane);
        }
    }
    if (l == 0 && do_x) {
        const float* x = ap->in[0]; bf16* xb = (bf16*)(ws + WS_XB); pg8::ssq_t* ss0 = (pg8::ssq_t*)(ws + SS_OFF);
        for (int m = gw; m < M; m += NGW) {
            const GAS f32x4* xr = (const GAS f32x4*)(x + (size_t)m * DM) + F.lane; GAS unsigned long long* o8 = (GAS unsigned long long*)(xb + (size_t)m * DM) + F.lane;
            float s = 0.f;
#pragma unroll
            for (int j = 0; j < 8; ++j) { const f32x4 v = xr[64 * j]; s += (v.x * v.x + v.y * v.y) + (v.z * v.z + v.w * v.w);
                o8[64 * j] = (unsigned long long)pk2(v.x, v.y) | ((unsigned long long)pk2(v.z, v.w) << 32); }
            s = wave_sum(s); if (F.lane == 0) ss0[m] = pg8::ssq_enc(s);
        }
    }
}

__device__ __forceinline__ void phase_mixer_post(Frame& F0, int l_in) {
    int l = l_in; asm volatile("" : "+s"(l));
    Frame F = F0; asm volatile("" : "+v"(F.tid), "+v"(F.lane));
    const ArgsP ap = get_args();
    unsigned char* ws = ap->ws;
    const bf16* P = (const bf16*)(ws + WS_ACT); const bf16* OB = (const bf16*)(ws + WS_OB); bf16* YM = (bf16*)(ws + WS_YM);
    const int gw = F.vcu * NWAVES + F.wave, NGW = F.G * NWAVES, lane = F.lane;
    const float* lq = ap->in[10] + (size_t)l * 4 * 64;
    const float s01 = wave_sum(lq[lane] * lq[64 + lane]), s23 = wave_sum(lq[128 + lane] * lq[192 + lane]);
    const float lam_init = 0.8f - 0.6f * __expf(-0.3f * (float)l);
    const float lam = __expf(s01) - __expf(s23) + lam_init, oml = 1.0f - lam_init;
    {
        const float* gsub = ap->in[11] + (size_t)l * 128; const float* wcv = ap->in[12] + (size_t)l * 3 * WC;
        float gs[16]; { const int c0 = (lane & 7) * 16;
#pragma unroll
            for (int i = 0; i < 16; ++i) gs[i] = gsub[c0 + i] * oml; }
        float w0[8], w1[8], w2[8]; { const int c = lane * 8;
#pragma unroll
            for (int i = 0; i < 8; ++i) { w0[i] = wcv[c + i]; w1[i] = wcv[WC + c + i]; w2[i] = wcv[2 * WC + c + i]; } }
        for (int row = gw; row < M; row += NGW) {
            { const v4u* p1 = (const v4u*)(OB + (size_t)row * 2048 + lane * 16); const v4u* p2 = (const v4u*)(OB + (size_t)row * 2048 + 1024 + lane * 16);
              const v4u a0 = p1[0], a1 = p1[1], b0 = p2[0], b1 = p2[1];
              const unsigned aw[8] = {a0.x, a0.y, a0.z, a0.w, a1.x, a1.y, a1.z, a1.w}, bw[8] = {b0.x, b0.y, b0.z, b0.w, b1.x, b1.y, b1.z, b1.w};
              float d[16]; float s = 0.f;
#pragma unroll
              for (int i = 0; i < 8; ++i) { d[2 * i] = bf_lo(aw[i]) - lam * bf_lo(bw[i]); d[2 * i + 1] = bf_hi(aw[i]) - lam * bf_hi(bw[i]); s += d[2 * i] * d[2 * i] + d[2 * i + 1] * d[2 * i + 1]; }
              s += __shfl_xor(s, 1); s += __shfl_xor(s, 2); s += __shfl_xor(s, 4);
              const float rs = __builtin_amdgcn_rsqf(s * (1.0f / 128.0f) + EPS);
              v4u o0, o1;
              o0.x = pk2(d[0] * rs * gs[0], d[1] * rs * gs[1]); o0.y = pk2(d[2] * rs * gs[2], d[3] * rs * gs[3]); o0.z = pk2(d[4] * rs * gs[4], d[5] * rs * gs[5]); o0.w = pk2(d[6] * rs * gs[6], d[7] * rs * gs[7]);
              o1.x = pk2(d[8] * rs * gs[8], d[9] * rs * gs[9]); o1.y = pk2(d[10] * rs * gs[10], d[11] * rs * gs[11]); o1.z = pk2(d[12] * rs * gs[12], d[13] * rs * gs[13]); o1.w = pk2(d[14] * rs * gs[14], d[15] * rs * gs[15]);
              v4u* yo = (v4u*)(YM + (size_t)row * 2048 + WA + lane * 16); yo[0] = o0; yo[1] = o1; }
            { const int t = row & (SEQ - 1); const bf16* pr = P + (size_t)row * NIN + lane * 8;
              const v4u bg = *(const v4u*)(pr + 4096), cg0 = *(const v4u*)(pr + 4608), xc0 = *(const v4u*)(pr + 5120);
              v4u cg1 = (v4u){0u, 0u, 0u, 0u}, xc1 = cg1, cg2 = cg1, xc2 = cg1;
              if (t >= 1) { cg1 = *(const v4u*)(pr - NIN + 4608); xc1 = *(const v4u*)(pr - NIN + 5120); }
              if (t >= 2) { cg2 = *(const v4u*)(pr - 2 * NIN + 4608); xc2 = *(const v4u*)(pr - 2 * NIN + 5120); }
              const unsigned bgw[4] = {bg.x, bg.y, bg.z, bg.w}, c0w[4] = {cg0.x, cg0.y, cg0.z, cg0.w}, x0w[4] = {xc0.x, xc0.y, xc0.z, xc0.w},
                             c1w[4] = {cg1.x, cg1.y, cg1.z, cg1.w}, x1w[4] = {xc1.x, xc1.y, xc1.z, xc1.w}, c2w[4] = {cg2.x, cg2.y, cg2.z, cg2.w}, x2w[4] = {xc2.x, xc2.y, xc2.z, xc2.w};
              unsigned ow[4];
#pragma unroll
              for (int i = 0; i < 4; ++i) {
                  const float ylo = bf_lo(bgw[i]) * (w0[2 * i] * (bf_lo(c2w[i]) * bf_lo(x2w[i])) + w1[2 * i] * (bf_lo(c1w[i]) * bf_lo(x1w[i])) + w2[2 * i] * (bf_lo(c0w[i]) * bf_lo(x0w[i])));
                  const float yhi = bf_hi(bgw[i]) * (w0[2 * i + 1] * (bf_hi(c2w[i]) * bf_hi(x2w[i])) + w1[2 * i + 1] * (bf_hi(c1w[i]) * bf_hi(x1w[i])) + w2[2 * i + 1] * (bf_hi(c0w[i]) * bf_hi(x0w[i])));
                  ow[i] = pk2(ylo, yhi); }
              *(v4u*)(YM + (size_t)row * 2048 + WA + WBW + lane * 8) = (v4u){ow[0], ow[1], ow[2], ow[3]}; }
        }
    }
    {
        constexpr int PITCH = 136;
        LAS bf16* WT = (LAS bf16*)(F.lds + RING_OFF);
        LAS bf16* VT = (LAS bf16*)(F.lds + RING_OFF + 128 * PITCH * 2);
        LAS float* RS = (LAS float*)(F.lds + RING_OFF + 2 * 128 * PITCH * 2);
        const pg8::ssq_t* ssv = (const pg8::ssq_t*)(ws + SS_OFF) + (size_t)(13 + l) * M;
        const float* wsg = ap->in[8] + (size_t)l * 4 * 128 * 128; const float* bsg = ap->in[9] + (size_t)l * 4 * 128; const float* gv = ap->in[7] + (size_t)l * WA;
        const int tid = F.tid, wave = F.wave, fr = lane & 15, fq = lane >> 4;
        for (int unit = blockIdx.x; unit < 512; unit += F.G) {
            const int ch = unit >> 2, g = unit & 3, r0 = ch * 128;
            __syncthreads();
            if (tid < 128) RS[tid] = __builtin_amdgcn_rsqf(pg8::ssq_dec(ssv[r0 + tid]) * (1.0f / WA) + EPS);
            __syncthreads();
            { const int t = tid >> 2, s0 = (tid & 3) * 32; const float* wrow = wsg + ((size_t)g * 128 + t) * 128 + s0;
#pragma unroll
              for (int j = 0; j < 4; ++j) { const f32x4 wa = *(const f32x4*)(wrow + 8 * j), wb = *(const f32x4*)(wrow + 8 * j + 4); const int s = s0 + 8 * j;
                  float e[8] = {wa.x, wa.y, wa.z, wa.w, wb.x, wb.y, wb.z, wb.w};
#pragma unroll
                  for (int i = 0; i < 8; ++i) e[i] = (s + i <= t) ? e[i] * RS[s + i] : 0.f;
                  *(LAS v4u*)(WT + t * PITCH + s) = (v4u){pk2(e[0], e[1]), pk2(e[2], e[3]), pk2(e[4], e[5]), pk2(e[6], e[7])}; } }
            { const int s = tid >> 2, c0 = (tid & 3) * 32; const bf16* vrow = P + (size_t)(r0 + s) * NIN + WA + g * 128 + c0;
#pragma unroll
              for (int j = 0; j < 4; ++j) { const v4u v = *(const v4u*)(vrow + 8 * j); const unsigned vw[4] = {v.x, v.y, v.z, v.w};
#pragma unroll
                  for (int i = 0; i < 4; ++i) { VT[(c0 + 8 * j + 2 * i) * PITCH + s] = (bf16)(vw[i] & 0xffffu); VT[(c0 + 8 * j + 2 * i + 1) * PITCH + s] = (bf16)(vw[i] >> 16); } } }
            __syncthreads();
            f32x4 acc[8];
#pragma unroll
            for (int j = 0; j < 8; ++j) acc[j] = (f32x4){0.f, 0.f, 0.f, 0.f};
#pragma unroll
            for (int kk = 0; kk < 4; ++kk) { const bf16x8 af = *(const LAS bf16x8*)(WT + (16 * wave + fr) * PITCH + kk * 32 + fq * 8);
#pragma unroll
                for (int j = 0; j < 8; ++j) { const bf16x8 bfv = *(const LAS bf16x8*)(VT + (16 * j + fr) * PITCH + kk * 32 + fq * 8);
                    acc[j] = __builtin_amdgcn_mfma_f32_16x16x32_bf16(bfv, af, acc[j], 0, 0, 0); } }
            const int t = 16 * wave + fr; const float bt = bsg[g * 128 + t];
#pragma unroll
            for (int j = 0; j < 8; ++j) { const int c = 16 * j + 4 * fq; const f32x4 gvv = *(const f32x4*)(gv + g * 128 + c);
                const unsigned long long uu = *(const unsigned long long*)(P + (size_t)(r0 + t) * NIN + g * 128 + c); const unsigned ulo = (unsigned)uu, uhi = (unsigned)(uu >> 32);
                const float y0 = bf_lo(ulo) * (acc[j][0] * gvv.x + bt), y1 = bf_hi(ulo) * (acc[j][1] * gvv.y + bt), y2 = bf_lo(uhi) * (acc[j][2] * gvv.z + bt), y3 = bf_hi(uhi) * (acc[j][3] * gvv.w + bt);
                *(unsigned long long*)(YM + (size_t)(r0 + t) * 2048 + g * 128 + c) = (unsigned long long)pk2(y0, y1) | ((unsigned long long)pk2(y2, y3) << 32); }
        }
        __syncthreads();
    }
}

__device__ __forceinline__ void phase_final(Frame& F0) {
    Frame F = F0; asm volatile("" : "+v"(F.tid), "+v"(F.lane));
    const ArgsP ap = get_args();
    const int gw = F.vcu * NWAVES + F.wave, NGW = F.G * NWAVES;
    const bf16* xb = (const bf16*)(ap->ws + WS_XB); const pg8::ssq_t* ss = (const pg8::ssq_t*)(ap->ws + SS_OFF) + (size_t)12 * M; const float* gf = ap->in[18];
    f32x4 g[8];
#pragma unroll
    for (int j = 0; j < 4; ++j) { g[2 * j] = *(const f32x4*)(gf + 8 * F.lane + 512 * j); g[2 * j + 1] = *(const f32x4*)(gf + 8 * F.lane + 512 * j + 4); }
    for (int m = gw; m < M; m += NGW) { const float rs = __builtin_amdgcn_rsqf(pg8::ssq_dec(ss[m]) * (1.0f / DM) + EPS);
        const GAS v4u* xi = (const GAS v4u*)(xb + (size_t)m * DM) + F.lane; GAS f32x4* xo = (GAS f32x4*)(ap->out + (size_t)m * DM) + 2 * F.lane;
#pragma unroll
        for (int j = 0; j < 4; ++j) { const v4u x = xi[64 * j];
            xo[128 * j] = (f32x4){bf_lo(x.x), bf_hi(x.x), bf_lo(x.y), bf_hi(x.y)} * rs * g[2 * j];
            xo[128 * j + 1] = (f32x4){bf_lo(x.z), bf_hi(x.z), bf_lo(x.w), bf_hi(x.w)} * rs * g[2 * j + 1]; } }
}

__global__ void __launch_bounds__(NWAVES * 64, 2) mega_fwd(Args args) {
    extern __shared__ __attribute__((aligned(16))) unsigned char lds[];
    Frame F;
    F.lds = (LAS unsigned char*)lds;
    F.MISC = (volatile LAS unsigned*)(F.lds + MISC_OFF);
    F.tid = threadIdx.x; F.lane = F.tid & 63; F.wave = __builtin_amdgcn_readfirstlane(F.tid >> 6);
    F.G = gridDim.x; { const int bx = blockIdx.x; F.vcu = (F.G % 8 == 0) ? (bx % 8) * (F.G / 8) + bx / 8 : bx; }
    F.ctl = (gu32*)(get_args()->ws + WS_CTL);
    for (int u = F.tid; u < (LDS_BYTES - LDSCTL_OFF) / 4; u += NWAVES * 64) ((LAS unsigned*)(F.lds + LDSCTL_OFF))[u] = 0u;
    __syncthreads();
    XcdBarrier bar = xcd_barrier_post((unsigned*)(F.ctl + CW_BAR), F.MISC + 8);
#define GRID_BAR() xcd_barrier(bar)
#define WSP(T, off) ((T*)(ws + (off)))

#if W_UPFRONT
    for (int l = 0; l < DEPTH; ++l) phase_weights(F, l, l == 0, (size_t)l * WL_STRIDE);
    GRID_BAR();
#endif
    for (int l = 0; l < DEPTH; ++l) {
        const size_t wl = W_UPFRONT ? (size_t)l * WL_STRIDE : 0;
#if !W_UPFRONT
        phase_weights(F, l);
        GRID_BAR();
#endif
        for (int rep_ = 0; rep_ < PROBE_W; ++rep_) { phase_weights(F, l, false, wl); GRID_BAR(); }
        for (int half = 0; half < 2; ++half) {
            for (int rep_ = 0; rep_ < PROBE_BAR; ++rep_) GRID_BAR();
            if (half == 1) {
#ifndef SKIP_GIN
                for (int part = 0; part < 2; ++part) {
                  unsigned char* ws = get_args()->ws; pg8::ssq_t* SS = WSP(pg8::ssq_t, SS_OFF); const bool split = (F.G == 256);
                  pg8::Gemm g{WSP(bf16, WS_XB), (const bf16*)(ws + wl + WS_WIN), M, NIN, DM}; pg8::StaticOrder S; S.init(M, split ? NIN - 512 : NIN, F.G, (int)blockIdx.x);
                  if (part == 1) { S.tail = split ? 1 : 2; S.tail_vcu = F.vcu; S.pn_off = (NIN - 512) / 256; }
                  int rb_ = 0; const LAS float* rt_ = (part == 0) ? fill_rstab(F, SS + (size_t)(3 * l + 1) * M, 1.0f / DM, &rb_) : ((F.G == 256) ? (const LAS float*)(F.lds + RSTAB_OFF) : nullptr); if (part == 1) rb_ = (F.G == 256) ? 2048 * ((int)blockIdx.x & 7) : 0;
                  pg8::EpiProj E{WSP(bf16, WS_ACT), NIN, SS + (size_t)(3 * l + 1) * M, 1.0f / DM, SS + (size_t)(13 + l) * M, attn_body::C2, 4, 8, 2, 4, rt_, rb_, WSP(unsigned, NRM_OFF + (size_t)l * NRM_LAYER_BYTES)};
                  for (int rep_ = 0; rep_ < PROBE_GIN; ++rep_) { pg8::EpiProj E0 = E; E0.v_lo = 0; E0.v_hi = 0; pg8::gemm_phase<pg8::EpiProj, pg8::StaticOrder, true, true>(F.lds + RING_OFF, g, S, E0); GRID_BAR(); }
                  pg8::gemm_phase<pg8::EpiProj, pg8::StaticOrder, true, true>(F.lds + RING_OFF, g, S, E);
                  if (part == 0) GRID_BAR();
                }
#else
                GRID_BAR();
#endif
#ifndef SKIP_ATT
                { unsigned char* ws = get_args()->ws;
                  const attn_body::AttnTensors AT{WSP(const attn_body::bf16, WS_ACT), WSP(attn_body::bf16, WS_OB), WSP(const unsigned, NRM_OFF + (size_t)l * NRM_LAYER_BYTES)};
                  const attn_body::StaticOrder S((int)F.G, (int)blockIdx.x);
                  attn_body::attn_phase<attn_body::StaticOrder>((char*)lds + RING_OFF, AT, S);
                  for (int rep_ = 0; rep_ < PROBE_ATT; ++rep_) { GRID_BAR(); attn_body::attn_phase<attn_body::StaticOrder>((char*)lds + RING_OFF, AT, S); } }
#endif
                GRID_BAR();
#ifndef SKIP_MIX
                phase_mixer_post(F, l);
#endif
                GRID_BAR();
                for (int rep_ = 0; rep_ < PROBE_MIX; ++rep_) { phase_mixer_post(F, l); GRID_BAR(); }
#ifndef SKIP_GOUT
                { unsigned char* ws = get_args()->ws; pg8::ssq_t* SS = WSP(pg8::ssq_t, SS_OFF);
                  pg8::Gemm g{WSP(bf16, WS_YM), (const bf16*)(ws + wl + WS_WOUT), M, DM, DM}; pg8::StaticOrder S; S.init(M, DM, F.G, (int)blockIdx.x);
                  pg8::EpiResid E{nullptr, WSP(bf16, WS_XB), SS + (size_t)(3 * l + 2) * M, 1.0f, DM, 1};
                  for (int rep_ = 0; rep_ < PROBE_GOUT; ++rep_) { pg8::EpiResid E0 = E; E0.alpha = 0.f; E0.do_ss = 0; pg8::gemm_phase<pg8::EpiResid, pg8::StaticOrder, true, true>(F.lds + RING_OFF, g, S, E0); GRID_BAR(); }
                  pg8::gemm_phase<pg8::EpiResid, pg8::StaticOrder, true, true>(F.lds + RING_OFF, g, S, E); }
#endif
                GRID_BAR();
            }
#ifndef SKIP_GGU
            { unsigned char* ws = get_args()->ws; pg8::ssq_t* SS = WSP(pg8::ssq_t, SS_OFF);
              pg8::Gemm g{WSP(bf16, WS_XB), (const bf16*)(ws + wl + (half ? WS_WGU2 : WS_WGU1)), M, 2 * FF, DM}; pg8::StaticOrder S; S.init(M, 2 * FF, F.G, (int)blockIdx.x);
              int rb_ = 0; const LAS float* rt_ = fill_rstab(F, SS + (size_t)(3 * l + 2 * half) * M, 1.0f / DM, &rb_);
              pg8::EpiSwiGLU E{WSP(bf16, WS_ACT), FF, SS + (size_t)(3 * l + 2 * half) * M, 1.0f / DM, rt_, rb_};
#if PROBE_SPLIT
              S.i_hi = 6; pg8::gemm_phase<pg8::EpiSwiGLU, pg8::StaticOrder, true, true>(F.lds + RING_OFF, g, S, E); GRID_BAR(); S.i_lo = 6; S.i_hi = 1 << 30;
#endif
              pg8::gemm_phase<pg8::EpiSwiGLU, pg8::StaticOrder, true, true>(F.lds + RING_OFF, g, S, E);
              for (int rep_ = 0; rep_ < PROBE_GGU; ++rep_) { GRID_BAR(); pg8::gemm_phase<pg8::EpiSwiGLU, pg8::StaticOrder, true, true>(F.lds + RING_OFF, g, S, E); } }
#endif
            GRID_BAR();
#ifndef SKIP_GDN
            { const ArgsP ap = get_args(); unsigned char* ws = ap->ws; pg8::ssq_t* SS = WSP(pg8::ssq_t, SS_OFF);
              pg8::Gemm g{WSP(bf16, WS_ACT), (const bf16*)(ws + wl + (half ? WS_WD2 : WS_WD1)), M, DM, FF}; pg8::StaticOrder S; S.init(M, DM, F.G, (int)blockIdx.x);
              pg8::EpiResid E{(l == 0 && half == 0) ? ap->in[0] : (const float*)nullptr, WSP(bf16, WS_XB), SS + (size_t)(3 * l + 2 * half + 1) * M, 0.5f, DM, 1};
              for (int rep_ = 0; rep_ < PROBE_GDN; ++rep_) { pg8::EpiResid E0 = E; E0.alpha = 0.f; E0.do_ss = 0; pg8::gemm_phase<pg8::EpiResid, pg8::StaticOrder, true, true>(F.lds + RING_OFF, g, S, E0); GRID_BAR(); }
              pg8::gemm_phase<pg8::EpiResid, pg8::StaticOrder, true, true>(F.lds + RING_OFF, g, S, E); }
#endif
            GRID_BAR();
        }
    }
#ifndef SKIP_FIN
    phase_final(F);
#endif
}

extern "C" void kernel_launch(void* const* d_in, const int* in_sizes, int n_in, void* d_out, int out_size, void* d_ws, size_t ws_size, hipStream_t stream) {
    static int grid = 0;
    if (grid == 0) {
        if (n_in != 19 || in_sizes[0] != M * DM || out_size != M * DM || ws_size < WS_END) { fprintf(stderr, "kernel_launch: unexpected shapes / workspace (%zu < %zu)\n", ws_size, (size_t)WS_END); grid = -1; return; }
        int dev = 0, cus = 0, per_cu = 0;
        if (hipGetDevice(&dev) != hipSuccess || hipDeviceGetAttribute(&cus, hipDeviceAttributeMultiprocessorCount, dev) != hipSuccess) { grid = -1; return; }
        if (hipFuncSetAttribute((const void*)mega_fwd, hipFuncAttributeMaxDynamicSharedMemorySize, LDS_BYTES) != hipSuccess) { grid = -1; return; }
        if (hipOccupancyMaxActiveBlocksPerMultiprocessor(&per_cu, (const void*)mega_fwd, NWAVES * 64, LDS_BYTES) != hipSuccess || per_cu < 1) { fprintf(stderr, "kernel_launch: occupancy query says %d\n", per_cu); }
        (void)hipGetLastError();
        grid = cus;
    }
    if (grid < 0) return;
    if (hipMemsetAsync((char*)d_ws + WS_CTL, 0, CTL_ZERO_BYTES, stream) != hipSuccess) return;
    Args a{};
    for (int i = 0; i < 19; ++i) a.in[i] = (const float*)d_in[i];
    a.out = (float*)d_out; a.ws = (unsigned char*)d_ws;
    hipLaunchKernelGGL(mega_fwd, dim3(grid), dim3(NWAVES * 64), LDS_BYTES, stream, a);
}
```

```cpp
#include <hip/hip_runtime.h>
#include <cstdio>
#include <cstdint>
#ifndef PROBE_W
#define PROBE_W 0
#endif
#ifndef PROBE_ATT
#define PROBE_ATT 0
#endif
#ifndef PROBE_MIX
#define PROBE_MIX 0
#endif
#ifndef PROBE_GGU
#define PROBE_GGU 0
#endif
#ifndef PROBE_GDN
#define PROBE_GDN 0
#endif
#ifndef PROBE_GOUT
#define PROBE_GOUT 0
#endif
#ifndef PROBE_GIN
#define PROBE_GIN 0
#endif
#ifndef PROBE_BAR
#define PROBE_BAR 0
#endif
#ifndef PROBE_SPLIT
#define PROBE_SPLIT 0
#endif
#ifndef W_UPFRONT
#define W_UPFRONT 1
#endif
namespace pg8 {
#define PG8_LAS __attribute__((address_space(3)))
typedef unsigned short bf16_t;
typedef short bf16x8 __attribute__((ext_vector_type(8)));
typedef float f32x4 __attribute__((ext_vector_type(4)));
typedef unsigned u32x4 __attribute__((ext_vector_type(4)));
constexpr int BM = 256, BK = 64, HALF = 128, HTB = HALF * BK * 2  , STAGE_BYTES = 8 * HTB, NXCD = 8, WGM = 8;

__host__ __device__ __forceinline__ int lds_byte(int r, int c) { const int st = (r >> 4) * 2 + (c >> 5), rr = r & 15, cc = c & 31, ob = rr * 64 + cc * 2; return st * 1024 + (ob ^ (((ob >> 9) & 1) << 5)); }
__host__ __device__ __forceinline__ void stage_rc(int b, int& R, int& C) { const int st = b / 1024, sb = b % 1024, swz = sb ^ (((sb >> 9) & 1) << 5); R = (st >> 1) * 16 + swz / 64; C = (st & 1) * 32 + (swz % 64) / 2; }
__host__ __device__ __forceinline__ int perm32(int rho) { const int n = rho >> 4, i = rho & 15; return 8 * (i >> 2) + 4 * n + (i & 3); }

struct Unit { int pm, pn; };
struct Gemm { const bf16_t* A; const bf16_t* Bt; int M, N, K; };

struct StaticOrder {
    int nM, nN, nwg, G, c, i_lo = 0, i_hi = 1 << 30;
    int tail = 0, tail_vcu = 0, pn_off = 0;
    __host__ __device__ void init(int M, int N, int G_, int c_) { nM = M / BM; nN = N / BM; nwg = nM * nN; G = G_; c = c_; }
    __host__ __device__ bool next(int i, Unit& u) const {
        if (tail) { if (tail != 1 || i > 0 || (tail_vcu & 1)) return false; u.pm = tail_vcu >> 2; u.pn = pn_off + ((tail_vcu >> 1) & 1); return true; }
        if (i + i_lo >= i_hi) return false;
        const long L = (long)(i + i_lo) * G + c; if (L >= nwg) return false;
        int wgid = (int)L; { const int q = nwg / NXCD, r = nwg % NXCD, xcd = wgid % NXCD, off = wgid / NXCD; wgid = (xcd < r ? xcd * (q + 1) : r * (q + 1) + (xcd - r) * q) + off; }
        const int nig = WGM * nN, gid = wgid / nig, fm = gid * WGM, gsz = (nM - fm) < WGM ? (nM - fm) : WGM;
        u.pm = fm + ((wgid % nig) % gsz); u.pn = (wgid % nig) / gsz; return true;
    }
    __device__ __forceinline__ void a_ready(const Unit&) const {}
    __device__ __forceinline__ void done(const Unit&) const {}
};

__device__ __forceinline__ unsigned cvt_pk_bf16(float lo, float hi) { unsigned r; asm volatile("v_cvt_pk_bf16_f32 %0, %1, %2" : "=v"(r) : "v"(lo), "v"(hi)); return r; }
typedef float f32x2 __attribute__((ext_vector_type(2)));
constexpr float RMS_EPS = 1e-6f;
typedef unsigned long long ssq_t;
constexpr float SSQ_SCALE = 1073741824.0f, SSQ_INV = 1.0f / 1073741824.0f;
__device__ __forceinline__ ssq_t ssq_enc(float v) { return (ssq_t)(long long)(v * SSQ_SCALE); }
__device__ __forceinline__ float ssq_dec(ssq_t v) { return (float)(long long)v * SSQ_INV; }
__device__ __forceinline__ void ssq_add(ssq_t* p, float v) { (void)__hip_atomic_fetch_add(p, ssq_enc(v), __ATOMIC_RELAXED, __HIP_MEMORY_SCOPE_AGENT); }
struct EpiSwiGLU {
    static constexpr bool PERM = true, AFTER_DRAIN = false;
    bf16_t* O; int ldc; const ssq_t* ss; float inv_k;
    const PG8_LAS float* rstab; int rowbase;
    __device__ __forceinline__ void operator()(const f32x4 (&acc)[2][2][4][2], const Unit& u, int wr, int wc, int fr, int fq) const {
        const int row0 = u.pm * BM + wr * 64 + fr, col0 = u.pn * HALF + wc * 32 + 8 * fq;
        float rsv[8];
        if (rstab) {
#pragma unroll
            for (int i = 0; i < 8; ++i) rsv[i] = rstab[row0 - rowbase + (i >> 2) * HALF + (i & 3) * 16];
        } else { ssq_t sv[8];
#pragma unroll
            for (int i = 0; i < 8; ++i) sv[i] = ss[row0 + (i >> 2) * HALF + (i & 3) * 16];
#pragma unroll
            for (int i = 0; i < 8; ++i) rsv[i] = __builtin_amdgcn_rsqf(ssq_dec(sv[i]) * inv_k + RMS_EPS); }
#pragma unroll
        for (int ai = 0; ai < 2; ++ai)
#pragma unroll
            for (int m = 0; m < 4; ++m) { const int row = row0 + ai * HALF + m * 16; const float rs = rsv[ai * 4 + m];
                const float k1 = rs * -1.4426950408889634f, k2 = rs * rs; f32x2 o[4];
#pragma unroll
                for (int n = 0; n < 2; ++n)
#pragma unroll
                    for (int h = 0; h < 2; ++h) { const f32x2 g = (f32x2){acc[ai][0][m][n][2 * h], acc[ai][0][m][n][2 * h + 1]}, up = (f32x2){acc[ai][1][m][n][2 * h], acc[ai][1][m][n][2 * h + 1]};
                        const f32x2 t = g * k1; f32x2 e; e.x = __builtin_amdgcn_exp2f(t.x); e.y = __builtin_amdgcn_exp2f(t.y);
                        const f32x2 d = e + 1.0f; f32x2 r; r.x = __builtin_amdgcn_rcpf(d.x); r.y = __builtin_amdgcn_rcpf(d.y);
                        o[2 * n + h] = ((g * up) * k2) * r; }
                u32x4 w; w.x = cvt_pk_bf16(o[0].x, o[0].y); w.y = cvt_pk_bf16(o[1].x, o[1].y); w.z = cvt_pk_bf16(o[2].x, o[2].y); w.w = cvt_pk_bf16(o[3].x, o[3].y);
                *(u32x4*)(O + (size_t)row * ldc + col0) = w; }
    }
};
constexpr int NRM_K_WORD = 64 * 32;
struct EpiProj {
    static constexpr bool PERM = true, AFTER_DRAIN = false;
    bf16_t* O; int ldc; const ssq_t* ss; float inv_k; ssq_t* ssv; float qscale; int q_lo, q_hi, v_lo, v_hi;
    const PG8_LAS float* rstab; int rowbase;
    unsigned* nrm = nullptr;
    __device__ __forceinline__ void operator()(const f32x4 (&acc)[2][2][4][2], const Unit& u, int wr, int wc, int fr, int fq) const {
        const int row0 = u.pm * BM + wr * 64 + fr, col0 = u.pn * BM + wc * 32 + 8 * fq;
        const float cs = (u.pn >= q_lo && u.pn < q_hi) ? qscale : 1.0f; const bool isv = (u.pn >= v_lo && u.pn < v_hi);
        const bool isn = nrm && (u.pn >= q_lo && u.pn < 2 * q_hi - q_lo); float nmx0 = 0.f, nmx1 = 0.f;
        float rsv[8];
        if (rstab) {
#pragma unroll
            for (int i = 0; i < 8; ++i) rsv[i] = rstab[row0 - rowbase + (i >> 2) * HALF + (i & 3) * 16];
        } else { ssq_t sv[8];
#pragma unroll
            for (int i = 0; i < 8; ++i) sv[i] = ss[row0 + (i >> 2) * HALF + (i & 3) * 16];
#pragma unroll
            for (int i = 0; i < 8; ++i) rsv[i] = __builtin_amdgcn_rsqf(ssq_dec(sv[i]) * inv_k + RMS_EPS); }
#pragma unroll
        for (int ai = 0; ai < 2; ++ai)
#pragma unroll
            for (int m = 0; m < 4; ++m) { const int row = row0 + ai * HALF + m * 16; const float rs = rsv[ai * 4 + m] * cs; float sqb[2];
#pragma unroll
                for (int bj = 0; bj < 2; ++bj) { const f32x4 v0 = acc[ai][bj][m][0] * rs, v1 = acc[ai][bj][m][1] * rs;
                    sqb[bj] = (v0[0] * v0[0] + v0[1] * v0[1]) + (v0[2] * v0[2] + v0[3] * v0[3]) + (v1[0] * v1[0] + v1[1] * v1[1]) + (v1[2] * v1[2] + v1[3] * v1[3]);
                    u32x4 w; w.x = cvt_pk_bf16(v0[0], v0[1]); w.y = cvt_pk_bf16(v0[2], v0[3]); w.z = cvt_pk_bf16(v1[0], v1[1]); w.w = cvt_pk_bf16(v1[2], v1[3]);
                    *(u32x4*)(O + (size_t)row * ldc + col0 + bj * HALF) = w; }
                if (isv) { float sq = sqb[0] + sqb[1]; sq += __shfl_xor(sq, 16); sq += __shfl_xor(sq, 32); if (fq == 0) ssq_add(ssv + row, sq); }
                if (isn) { float a = sqb[0], b = sqb[1]; a += __shfl_xor(a, 16); b += __shfl_xor(b, 16); a += __shfl_xor(a, 32); b += __shfl_xor(b, 32);
                    nmx0 = fmaxf(nmx0, a); nmx1 = fmaxf(nmx1, b); } }
        if (isn) {
#pragma unroll
            for (int d = 1; d < 16; d <<= 1) { nmx0 = fmaxf(nmx0, __shfl_xor(nmx0, d)); nmx1 = fmaxf(nmx1, __shfl_xor(nmx1, d)); }
            const bool isq = u.pn < q_hi; const int g8 = (u.pn - (isq ? q_lo : q_hi)) * 8 + wc;
            unsigned* t = nrm + (isq ? (u.pm * 32) : (NRM_K_WORD + (u.pm >> 4) * 32)) + g8;
            if (fr == 0 && fq == 0) { (void)__hip_atomic_fetch_max(t, __float_as_uint(nmx0), __ATOMIC_RELAXED, __HIP_MEMORY_SCOPE_AGENT); (void)__hip_atomic_fetch_max(t + 4, __float_as_uint(nmx1), __ATOMIC_RELAXED, __HIP_MEMORY_SCOPE_AGENT); } }
    }
};
struct EpiResid {
    static constexpr bool PERM = true, AFTER_DRAIN = false;
    const float* xin_f32; bf16_t* xb; ssq_t* ss_out; float alpha; int ldc; int do_ss;
    __device__ __forceinline__ void operator()(const f32x4 (&acc)[2][2][4][2], const Unit& u, int wr, int wc, int fr, int fq) const {
        const int row0 = u.pm * BM + wr * 64 + fr, col0 = u.pn * BM + wc * 32 + 8 * fq;
#pragma unroll
        for (int ai = 0; ai < 2; ++ai)
#pragma unroll
            for (int m = 0; m < 4; ++m) { const int row = row0 + ai * HALF + m * 16; const size_t off = (size_t)row * ldc + col0; float sq = 0.f;
#pragma unroll
                for (int bj = 0; bj < 2; ++bj) { f32x4 b0, b1;
                    if (xin_f32) { b0 = *(const f32x4*)(xin_f32 + off + bj * HALF); b1 = *(const f32x4*)(xin_f32 + off + bj * HALF + 4); }
                    else { const u32x4 x = *(const u32x4*)(xb + off + bj * HALF);
                        b0 = (f32x4){__uint_as_float(x.x << 16), __uint_as_float(x.x & 0xffff0000u), __uint_as_float(x.y << 16), __uint_as_float(x.y & 0xffff0000u)};
                        b1 = (f32x4){__uint_as_float(x.z << 16), __uint_as_float(x.z & 0xffff0000u), __uint_as_float(x.w << 16), __uint_as_float(x.w & 0xffff0000u)}; }
                    const f32x4 v0 = b0 + acc[ai][bj][m][0] * alpha, v1 = b1 + acc[ai][bj][m][1] * alpha;
                    u32x4 w; w.x = cvt_pk_bf16(v0[0], v0[1]); w.y = cvt_pk_bf16(v0[2], v0[3]); w.z = cvt_pk_bf16(v1[0], v1[1]); w.w = cvt_pk_bf16(v1[2], v1[3]);
                    *(u32x4*)(xb + off + bj * HALF) = w;
                    const float r0 = __uint_as_float(w.x << 16), r1 = __uint_as_float(w.x & 0xffff0000u), r2 = __uint_as_float(w.y << 16), r3 = __uint_as_float(w.y & 0xffff0000u),
                                r4 = __uint_as_float(w.z << 16), r5 = __uint_as_float(w.z & 0xffff0000u), r6 = __uint_as_float(w.w << 16), r7 = __uint_as_float(w.w & 0xffff0000u);
                    sq += (r0 * r0 + r1 * r1) + (r2 * r2 + r3 * r3) + (r4 * r4 + r5 * r5) + (r6 * r6 + r7 * r7); }
                sq += __shfl_xor(sq, 16); sq += __shfl_xor(sq, 32); if (fq == 0 && do_ss) ssq_add(ss_out + row, sq);
                if (m & 1) asm volatile("" ::: "memory"); }
    }
};

template <class Epi, class Sched, bool ALIGN_EPI = false, bool SP2 = false>
__device__ __forceinline__ void gemm_phase(PG8_LAS unsigned char* lds, const Gemm g, const Sched& S, const Epi& E) {
    int tid_ = threadIdx.x; asm volatile("" : "+v"(tid_));
    const int tid = tid_, wid = __builtin_amdgcn_readfirstlane(tid >> 6), lane = tid & 63, wr = wid >> 2, wc = wid & 3, fr = lane & 15, fq = lane >> 4;
    const int K = g.K, nt = K / BK;
    unsigned voffA[2], voffB[2];
#pragma unroll
    for (int i = 0; i < 2; ++i) { int R, C; stage_rc(tid * 16 + i * 8192, R, C); const int Rb = Epi::PERM ? ((R & ~31) + perm32(R & 31)) : R;
        voffA[i] = (unsigned)(R * K + C) * 2u; voffB[i] = (unsigned)(Rb * K + C) * 2u; }
    const size_t kstep = (size_t)(BK * 2);
    const size_t hstep = (size_t)HALF * K * 2;
    const size_t tstep = 2 * hstep;
    const unsigned ldsw = (unsigned)wid * 1024u;
    const int aoff = lds_byte(wr * 64 + fr, fq * 8), boff = lds_byte(wc * 32 + fr, fq * 8);
#define PG8_SA(b, h) (((b) * 2 + (h)) * HTB)
#define PG8_SB(b, h) ((4 + (b) * 2 + (h)) * HTB)
#define PG8_STAGE(bufoff, gbase, voff) do { _Pragma("unroll") for (int _i = 0; _i < 2; ++_i) \
        __builtin_amdgcn_global_load_lds((const unsigned*)((const char*)(gbase) + (voff)[_i]), (PG8_LAS unsigned*)(lds + (bufoff) + ldsw + _i * 8192), 16, 0, 0); } while (0)
#define PG8_LDA(dst, b, h) do { _Pragma("unroll") for (int m = 0; m < 4; ++m) _Pragma("unroll") for (int k = 0; k < 2; ++k) dst[m][k] = *(const PG8_LAS bf16x8*)(lds + PG8_SA(b, h) + aoff + m * 2048 + k * 1024); } while (0)
#define PG8_LDB(dst, b, h) do { _Pragma("unroll") for (int n = 0; n < 2; ++n) _Pragma("unroll") for (int k = 0; k < 2; ++k) dst[n][k] = *(const PG8_LAS bf16x8*)(lds + PG8_SB(b, h) + boff + n * 2048 + k * 1024); } while (0)
#define PG8_MMA(ai, bj, At, Bt) do { __builtin_amdgcn_s_setprio(1); _Pragma("unroll") for (int n = 0; n < 2; ++n) _Pragma("unroll") for (int m = 0; m < 4; ++m) _Pragma("unroll") for (int k = 0; k < 2; ++k) { \
        acc[ai][bj][m][n] = __builtin_amdgcn_mfma_f32_16x16x32_bf16(Bt[n][k], At[m][k], acc[ai][bj][m][n], 0, 0, 0); __builtin_amdgcn_sched_barrier(0); } __builtin_amdgcn_s_setprio(0); } while (0)
#define PG8_MFMA1(ai, bj, Bt, m, n, k) do { acc[ai][bj][m][n] = __builtin_amdgcn_mfma_f32_16x16x32_bf16(Bt[n][k], At[m][k], acc[ai][bj][m][n], 0, 0, 0); __builtin_amdgcn_sched_barrier(0); } while (0)
#define PG8_MFMA1Z(ai, bj, Bt, m, n, k) do { asm volatile("v_mfma_f32_16x16x32_bf16 %0, %1, %2, 0" : "+v"(acc[ai][bj][m][n]) : "v"(Bt[n][k]), "v"(At[m][k])); __builtin_amdgcn_sched_barrier(0); } while (0)
#define PG8_MMA2Z(ai) do { _Pragma("unroll") for (int m = 0; m < 4; ++m) { PG8_MFMA1Z(ai, 0, B0, m, 0, 0); PG8_MFMA1(ai, 0, B0, m, 0, 1); PG8_MFMA1Z(ai, 0, B0, m, 1, 1); PG8_MFMA1(ai, 0, B0, m, 1, 0); \
        PG8_MFMA1Z(ai, 1, B1, m, 0, 0); PG8_MFMA1(ai, 1, B1, m, 0, 1); PG8_MFMA1Z(ai, 1, B1, m, 1, 1); PG8_MFMA1(ai, 1, B1, m, 1, 0); } } while (0)
#define PG8_MMA2(ai) do { _Pragma("unroll") for (int m = 0; m < 4; ++m) { PG8_MFMA1(ai, 0, B0, m, 0, 0); PG8_MFMA1(ai, 0, B0, m, 0, 1); PG8_MFMA1(ai, 0, B0, m, 1, 1); PG8_MFMA1(ai, 0, B0, m, 1, 0); \
        PG8_MFMA1(ai, 1, B1, m, 0, 0); PG8_MFMA1(ai, 1, B1, m, 0, 1); PG8_MFMA1(ai, 1, B1, m, 1, 1); PG8_MFMA1(ai, 1, B1, m, 1, 0); } } while (0)
#define PG8_WAIT_V(n) asm volatile("s_waitcnt vmcnt(" #n ")" ::: "memory")
#define PG8_WAIT_L(n) asm volatile("s_waitcnt lgkmcnt(" #n ")" ::: "memory")
#define PG8_BAR __builtin_amdgcn_s_barrier()
#define PG8_SCHED __builtin_amdgcn_sched_barrier(0)
#define PG8_KITER_SP2(MZ) do { \
            PG8_LDB(B0, 0, 0); PG8_LDB(B1, 0, 1); PG8_SCHED; PG8_LDA(At, 0, 0); PG8_STAGE(PG8_SA(1, 1), a1 + hstep, voffA); \
            PG8_WAIT_V(8); PG8_WAIT_L(0); __builtin_amdgcn_s_setprio(1); PG8_BAR; PG8_MMA2##MZ(0); PG8_BAR; __builtin_amdgcn_s_setprio(0); PG8_SCHED; \
            PG8_LDA(At, 0, 1); PG8_STAGE(PG8_SB(0, 0), b2, voffB); PG8_STAGE(PG8_SB(0, 1), b2 + hstep, voffB); PG8_STAGE(PG8_SA(0, 0), a2, voffA); \
            PG8_WAIT_V(8); PG8_WAIT_L(0); __builtin_amdgcn_s_setprio(1); PG8_BAR; PG8_MMA2##MZ(1); PG8_BAR; __builtin_amdgcn_s_setprio(0); PG8_SCHED; \
            PG8_LDB(B0, 1, 0); PG8_LDB(B1, 1, 1); PG8_SCHED; PG8_LDA(At, 1, 0); PG8_STAGE(PG8_SA(0, 1), a2 + hstep, voffA); \
            PG8_WAIT_V(8); PG8_WAIT_L(0); __builtin_amdgcn_s_setprio(1); PG8_BAR; PG8_MMA2(0); PG8_BAR; __builtin_amdgcn_s_setprio(0); PG8_SCHED; \
            PG8_LDA(At, 1, 1); PG8_STAGE(PG8_SB(1, 0), b3, voffB); PG8_STAGE(PG8_SB(1, 1), b3 + hstep, voffB); PG8_STAGE(PG8_SA(1, 0), a3, voffA); \
            PG8_WAIT_V(8); PG8_WAIT_L(0); __builtin_amdgcn_s_setprio(1); PG8_BAR; PG8_MMA2(1); PG8_BAR; __builtin_amdgcn_s_setprio(0); PG8_SCHED; \
            } while (0)
    Unit cur, nxt; int ui = 0;
    if (!S.next(0, cur)) return;
    f32x4 acc[2][2][4][2];
#pragma unroll
    for (int a = 0; a < 2; ++a)
#pragma unroll
        for (int b = 0; b < 2; ++b)
#pragma unroll
            for (int m = 0; m < 4; ++m)
#pragma unroll
                for (int n = 0; n < 2; ++n) acc[a][b][m][n] = (f32x4){0.f, 0.f, 0.f, 0.f};
    bf16x8 At[4][2], B0[2][2], B1[2][2];
    const char* cA = (const char*)g.A + (size_t)cur.pm * tstep; const char* cB = (const char*)g.Bt + (size_t)cur.pn * tstep;
    S.a_ready(cur);
    if constexpr (SP2) {
        PG8_STAGE(PG8_SB(0, 0), cB, voffB); PG8_STAGE(PG8_SB(0, 1), cB + hstep, voffB); PG8_STAGE(PG8_SA(0, 0), cA, voffA); PG8_STAGE(PG8_SA(0, 1), cA + hstep, voffA);
        if (wr == 1) PG8_BAR;
        PG8_WAIT_V(2); PG8_BAR;
        PG8_STAGE(PG8_SB(1, 0), cB + kstep, voffB); PG8_STAGE(PG8_SA(1, 0), cA + kstep, voffA); PG8_STAGE(PG8_SB(1, 1), cB + hstep + kstep, voffB);
        PG8_WAIT_V(6); PG8_BAR;
    } else {
        PG8_STAGE(PG8_SB(0, 0), cB, voffB); PG8_STAGE(PG8_SA(0, 0), cA, voffA); PG8_STAGE(PG8_SB(0, 1), cB + hstep, voffB); PG8_STAGE(PG8_SA(0, 1), cA + hstep, voffA);
        if (wr == 1) PG8_BAR;
        PG8_WAIT_V(4); PG8_BAR;
        PG8_STAGE(PG8_SB(1, 0), cB + kstep, voffB); PG8_STAGE(PG8_SA(1, 0), cA + kstep, voffA); PG8_STAGE(PG8_SB(1, 1), cB + hstep + kstep, voffB);
        PG8_WAIT_V(6); PG8_BAR;
    }
    for (;;) {
        const bool has_next = S.next(ui + 1, nxt);
        const char* nA = has_next ? (const char*)g.A + (size_t)nxt.pm * tstep : cA; const char* nB = has_next ? (const char*)g.Bt + (size_t)nxt.pn * tstep : cB;
        if constexpr (SP2) {
            { const int t = 0;
            const bool last = (t == nt - 2);
            const char* a1 = cA + (size_t)(t + 1) * kstep;
            const char* a2 = last ? nA : cA + (size_t)(t + 2) * kstep; const char* b2 = last ? nB : cB + (size_t)(t + 2) * kstep;
            const char* a3 = a2 + kstep; const char* b3 = b2 + kstep;
            if (last && has_next) S.a_ready(nxt);
            PG8_KITER_SP2(Z); }
            for (int t = 2; t < nt; t += 2) {
            const bool last = (t == nt - 2);
            const char* a1 = cA + (size_t)(t + 1) * kstep;
            const char* a2 = last ? nA : cA + (size_t)(t + 2) * kstep; const char* b2 = last ? nB : cB + (size_t)(t + 2) * kstep;
            const char* a3 = a2 + kstep; const char* b3 = b2 + kstep;
            if (last && has_next) S.a_ready(nxt);
            PG8_KITER_SP2(); }
        } else {
        for (int t = 0; t < nt; t += 2) {
            const bool last = (t == nt - 2);
            const char* a1 = cA + (size_t)(t + 1) * kstep;
            const char* a2 = last ? nA : cA + (size_t)(t + 2) * kstep; const char* b2 = last ? nB : cB + (size_t)(t + 2) * kstep;
            const char* a3 = a2 + kstep; const char* b3 = b2 + kstep;
            if (last && has_next) S.a_ready(nxt);
            PG8_LDB(B0, 0, 0); PG8_SCHED; PG8_LDA(At, 0, 0); PG8_STAGE(PG8_SA(1, 1), a1 + hstep, voffA);
            PG8_WAIT_L(8); PG8_BAR; PG8_WAIT_L(0); PG8_MMA(0, 0, At, B0); PG8_BAR; PG8_SCHED;
            PG8_LDB(B1, 0, 1); PG8_STAGE(PG8_SB(0, 0), b2, voffB);
            PG8_BAR; PG8_WAIT_L(0); PG8_MMA(0, 1, At, B1); PG8_BAR;
            PG8_LDA(At, 0, 1); PG8_STAGE(PG8_SA(0, 0), a2, voffA);
            PG8_BAR; PG8_WAIT_L(0); PG8_MMA(1, 0, At, B0); PG8_BAR; PG8_SCHED;
            PG8_STAGE(PG8_SB(0, 1), b2 + hstep, voffB);
            PG8_WAIT_V(6); PG8_BAR; PG8_MMA(1, 1, At, B1); PG8_BAR;
            PG8_LDB(B0, 1, 0); PG8_SCHED; PG8_LDA(At, 1, 0); PG8_STAGE(PG8_SA(0, 1), a2 + hstep, voffA);
            PG8_WAIT_L(8); PG8_BAR; PG8_WAIT_L(0); PG8_MMA(0, 0, At, B0); PG8_BAR; PG8_SCHED;
            PG8_LDB(B1, 1, 1); PG8_STAGE(PG8_SB(1, 0), b3, voffB);
            PG8_BAR; PG8_WAIT_L(0); PG8_MMA(0, 1, At, B1); PG8_BAR;
            PG8_LDA(At, 1, 1); PG8_STAGE(PG8_SA(1, 0), a3, voffA);
            PG8_BAR; PG8_WAIT_L(0); PG8_MMA(1, 0, At, B0); PG8_BAR; PG8_SCHED;
            PG8_STAGE(PG8_SB(1, 1), b3 + hstep, voffB);
            PG8_WAIT_V(6); PG8_BAR; PG8_MMA(1, 1, At, B1); PG8_BAR;
        }
        }
        if constexpr (ALIGN_EPI) { if (wr == 0) PG8_BAR; }
        if constexpr (!Epi::AFTER_DRAIN) { E(acc, cur, wr, wc, fr, fq); S.done(cur); }
        if (!has_next) break;
        if constexpr (!SP2) {
#pragma unroll
        for (int a = 0; a < 2; ++a)
#pragma unroll
            for (int b = 0; b < 2; ++b)
#pragma unroll
                for (int m = 0; m < 4; ++m)
#pragma unroll
                    for (int n = 0; n < 2; ++n) acc[a][b][m][n] = (f32x4){0.f, 0.f, 0.f, 0.f};
        }
        cur = nxt; cA = nA; cB = nB; ++ui;
        if constexpr (ALIGN_EPI) { if (wr == 1) PG8_BAR; }
    }
    PG8_WAIT_V(0);
    if constexpr (!ALIGN_EPI) { if (wr == 0) PG8_BAR; }
    PG8_BAR;
    if constexpr (Epi::AFTER_DRAIN) { E.fused(acc, cur, wr, wc, fr, fq, lds, wid, lane); S.done(cur); }
#undef PG8_SA
#undef PG8_SB
#undef PG8_STAGE
#undef PG8_LDA
#undef PG8_LDB
#undef PG8_MMA
#undef PG8_MMA2
#undef PG8_MMA2Z
#undef PG8_KITER_SP2
#undef PG8_MFMA1Z
#undef PG8_MFMA1
#undef PG8_WAIT_V
#undef PG8_WAIT_L
#undef PG8_BAR
#undef PG8_SCHED
}
}
#include <hip/hip_bf16.h>
#include <cmath>
namespace attn_body {
using bf16=__hip_bfloat16;
using bf16x8=__attribute__((ext_vector_type(8)))short;
using s16x4=__attribute__((ext_vector_type(4)))short;
using f32x16=__attribute__((ext_vector_type(16)))float;
using u32x4=__attribute__((ext_vector_type(4)))unsigned;
constexpr int SEQ=4096,D=64,DM=5632,DMO=2048;
constexpr int NW=8,QBLK=32,QB=QBLK*NW,KVBLK=64,NQB=SEQ/QB;
constexpr int ATTN_PITCH=DM, ATTN_UNIT_ROWS=QB;
constexpr float LOG2E=1.4426950408889634f;
__device__ __forceinline__ int crow(int r,int hi){return (r&3)+8*(r>>2)+4*hi;}
#define SBAR() __builtin_amdgcn_sched_barrier(0)
__device__ __forceinline__ void cmask(f32x16&p0,f32x16&p1,int jb,int qrel,int hi){
  const float NEG=-INFINITY; int kb=64*jb+4*hi;
  #pragma unroll
  for(int r=0;r<16;++r){int kv=kb+(r&3)+8*(r>>2); if(kv>qrel)p0[r]=NEG; if(kv+32>qrel)p1[r]=NEG;}
}

constexpr int NSLOT=3, SLOTB=8192, VSLOTB=16384;
constexpr int LDS_K=0, LDS_V=NSLOT*SLOTB, LDS_WS=LDS_V+NSLOT*VSLOTB, LDS_OST=LDS_WS+NW*64*4, LDS_BYTES=LDS_OST+NW*4096;
constexpr float C2=0.125f*1.4426950408889634f;
__device__ __forceinline__ void glds16(const void*gsrc,unsigned lds_dst){unsigned keep;
  asm volatile("s_mov_b32 %0, m0\n\ts_mov_b32 m0, %2\n\ts_nop 0\n\tglobal_load_lds_dwordx4 %1, off\n\ts_mov_b32 m0, %0":"=&s"(keep):"v"(gsrc),"s"(lds_dst):"memory");}
__device__ __forceinline__ float max3f(float a,float b,float c){float r;asm("v_max3_f32 %0, %1, %2, %3":"=v"(r):"v"(a),"v"(b),"v"(c));return r;}
__device__ __forceinline__ float max2f(float a,float b){float r;asm("v_max_f32_e32 %0, %1, %2":"=v"(r):"v"(a),"v"(b));return r;}
__device__ __forceinline__ float fadd_s(float a,float b){float r;asm("v_add_f32_e32 %0, %1, %2":"=v"(r):"v"(a),"v"(b));return r;}
__device__ __forceinline__ float fsub_s(float a,float b){float r;asm("v_sub_f32_e32 %0, %1, %2":"=v"(r):"v"(a),"v"(b));return r;}
typedef float f32x2_t __attribute__((ext_vector_type(2))); typedef __bf16 bf16x2_t __attribute__((ext_vector_type(2)));
__device__ __forceinline__ unsigned cvtpk_s(float lo,float hi){f32x2_t v={lo,hi};bf16x2_t b=__builtin_convertvector(v,bf16x2_t);return __builtin_bit_cast(unsigned,b);}
#define WAIT_BAR(N) asm volatile("s_waitcnt vmcnt(" #N ") lgkmcnt(0)\n\ts_barrier":::"memory")

__device__ __forceinline__ void qkt(f32x16&p0,f32x16&p1,const char*Kslot,const bf16x8*qr,bf16x8 ka0,bf16x8 ka1,bf16x8 qa,int r32,int hi){
  const char*kb=Kslot+hi*1024+r32*16;
  const f32x16 z=f32x16{};
  p0=__builtin_amdgcn_mfma_f32_32x32x16_bf16(ka0,qa,z,0,0,0);p1=__builtin_amdgcn_mfma_f32_32x32x16_bf16(ka1,qa,z,0,0,0);
  #pragma unroll
  for(int d0=0;d0<4;++d0){
    const bf16x8 b0=*reinterpret_cast<const bf16x8*>(kb+d0*2048);
    const bf16x8 b1=*reinterpret_cast<const bf16x8*>(kb+d0*2048+512);
    p0=__builtin_amdgcn_mfma_f32_32x32x16_bf16(b0,qr[d0],p0,0,0,0);p1=__builtin_amdgcn_mfma_f32_32x32x16_bf16(b1,qr[d0],p1,0,0,0);}
}
typedef __attribute__((address_space(3))) const char* lds_cptr;
typedef short v4i16_t __attribute__((ext_vector_type(4)));
__device__ __forceinline__ void kload8(bf16x8*kf,lds_cptr kp){
  kf[0]=*(const __attribute__((address_space(3))) bf16x8*)(kp);      kf[1]=*(const __attribute__((address_space(3))) bf16x8*)(kp+512);
  kf[2]=*(const __attribute__((address_space(3))) bf16x8*)(kp+2048); kf[3]=*(const __attribute__((address_space(3))) bf16x8*)(kp+2560);
  kf[4]=*(const __attribute__((address_space(3))) bf16x8*)(kp+4096); kf[5]=*(const __attribute__((address_space(3))) bf16x8*)(kp+4608);
  kf[6]=*(const __attribute__((address_space(3))) bf16x8*)(kp+6144); kf[7]=*(const __attribute__((address_space(3))) bf16x8*)(kp+6656);
}
__device__ __forceinline__ void kload2(bf16x8*kf,lds_cptr kp,int j){ kf[2*j]=*(const __attribute__((address_space(3))) bf16x8*)(kp+j*2048); kf[2*j+1]=*(const __attribute__((address_space(3))) bf16x8*)(kp+j*2048+512); }
__device__ __forceinline__ s16x4 vtr(lds_cptr p){ return __builtin_bit_cast(s16x4,__builtin_amdgcn_ds_read_tr16_b64_v4i16((__attribute__((address_space(3))) v4i16_t*)p)); }
__device__ __forceinline__ float rowmax(const f32x16&p0,const f32x16&p1){
  float a=max3f(p0[0],p0[1],p1[0]),b=max3f(p0[2],p0[3],p1[1]);a=max3f(a,p1[2],p1[3]);
  #pragma unroll
  for(int r=4;r<16;r+=4){a=max3f(a,p0[r],p0[r+1]);b=max3f(b,p0[r+2],p0[r+3]);a=max3f(a,p1[r],p1[r+1]);b=max3f(b,p1[r+2],p1[r+3]);}
  const float m=max2f(a,b);
  auto rr=__builtin_amdgcn_permlane32_swap(__float_as_uint(m),__float_as_uint(m),false,false);
  return max2f(__uint_as_float(rr[0]),__uint_as_float(rr[1]));
}
__device__ __forceinline__ void pv(f32x16*o,int vb,bf16x8 pa0,bf16x8 pa1,bf16x8 pa2,bf16x8 pa3){
  #pragma unroll
  for(int d0=0;d0<4;++d0){s16x4 lo[4],hi[4];
    #pragma unroll
    for(int ks=0;ks<4;++ks){
      asm volatile("ds_read_b64_tr_b16 %0,%1 offset:%c2":"=&v"(lo[ks]):"v"(vb),"i"(d0*4096+ks*1024):"memory");
      asm volatile("ds_read_b64_tr_b16 %0,%1 offset:%c2":"=&v"(hi[ks]):"v"(vb),"i"(d0*4096+ks*1024+512):"memory");}
    asm volatile("s_waitcnt lgkmcnt(0)":::"memory");SBAR();
    #define PK(k) (bf16x8){lo[k][0],lo[k][1],lo[k][2],lo[k][3],hi[k][0],hi[k][1],hi[k][2],hi[k][3]}
    o[d0]=__builtin_amdgcn_mfma_f32_32x32x16_bf16(pa0,PK(0),o[d0],0,0,0);
    o[d0]=__builtin_amdgcn_mfma_f32_32x32x16_bf16(pa1,PK(1),o[d0],0,0,0);
    o[d0]=__builtin_amdgcn_mfma_f32_32x32x16_bf16(pa2,PK(2),o[d0],0,0,0);
    o[d0]=__builtin_amdgcn_mfma_f32_32x32x16_bf16(pa3,PK(3),o[d0],0,0,0);
    #undef PK
  }
}

#ifndef ATTN_STORE16
#define ATTN_STORE16(p,v) (*(u32x4*)(p)=(v))
#endif
template<int THRL> __device__ __forceinline__ void attn_unit(int qb,const bf16*Qh,const bf16*__restrict__ Kh,const bf16*__restrict__ Vh,bf16*Oh,float sl2,char*shm,int nte,float bnd,float inv64c){
  int tid_=threadIdx.x; asm volatile("":"+v"(tid_)); const int tid=tid_,lane=tid&63,r32=lane&31,hi=lane>>5; const int wid=__builtin_amdgcn_readfirstlane(tid>>6);
  const int q0=qb*QB;
  const bf16*Qw=Qh+(long)(q0+wid*QBLK)*DM;
  const unsigned lds0=(unsigned)(uintptr_t)shm;
  float*wsf=(float*)(shm+LDS_WS)+wid*64;
  const bf16*ksrc=Kh+(long)lane*DM+wid*8;
  const bf16*vsrc=Vh+(long)(16*(wid&3)+(lane>>2))*DM+(wid>>2)*32+(lane&3)*8;
  const unsigned kdst=lds0+LDS_K+wid*1024, vdst=lds0+LDS_V+wid*1024;
  #define DMA_K(t,slot) glds16(ksrc+(long)(NTF-1-(t))*KVBLK*DM,(unsigned)__builtin_amdgcn_readfirstlane(kdst+(slot)))
  #define DMA_V(t,slot) do{ glds16(vsrc+(long)(NTF-1-(t))*KVBLK*DM,(unsigned)__builtin_amdgcn_readfirstlane(vdst+2*(slot))); glds16(vsrc+(long)(NTF-1-(t))*KVBLK*DM+64,(unsigned)__builtin_amdgcn_readfirstlane(vdst+2*(slot)+8192)); }while(0)
  const char*Kbase=shm+LDS_K; bf16x8 kf[8];
  const lds_cptr shm3=(lds_cptr)shm; const lds_cptr kp0=shm3+LDS_K+hi*1024+r32*16; const lds_cptr vp0=shm3+LDS_V+((lane>>4)&1)*32+(lane&3)*8+(4*hi+((lane&15)>>2))*64; const int vb0=(int)(unsigned)(uintptr_t)vp0;
  const int NTF=(q0+QB)/KVBLK;
  int NT=__builtin_amdgcn_readfirstlane(nte<NTF?nte:NTF);
  DMA_K(0,0);DMA_V(0,0);DMA_K(1,SLOTB);
  bf16x8 qr[4];
  #pragma unroll
  for(int d0=0;d0<4;++d0)qr[d0]=*reinterpret_cast<const bf16x8*>(&Qw[(long)r32*DM+d0*16+hi*8]);
  float mhat=0.f,l_reg=0.f;f32x16 o[4];o[0]=f32x16{};o[1]=f32x16{};o[2]=f32x16{};o[3]=f32x16{};
  const int qrel=wid*QBLK+r32;
  #define CMASK(P0,P1,t) do{int jb_=3-(t); if(jb_>=0)cmask(P0,P1,jb_,qrel,hi);}while(0)
  const unsigned hm=hi?0u:0xffffffffu;
  const unsigned c_pk=cvtpk_s(sl2,0.f)&0xffffu; const float c_hif=__uint_as_float(c_pk<<16); const unsigned c_pl=cvtpk_s(sl2-c_hif,0.f)&0xffffu;
  const unsigned qa_c=((c_pl^0x8000u)<<16)|(c_pk^0x8000u);
  u32x4 qaw=(u32x4){qa_c,qa_c,0x80008000u,0u};
  const unsigned ka_j0=hm&(cvtpk_s((float)(63-r32),0.f)&0xffffu)*0x10001u, ka_j1=hm&(cvtpk_s((float)(31-r32),0.f)&0xffffu)*0x10001u, ka_one=hm&0x3f803f80u;
  #define KA_D0(t) (hm&((__float_as_uint((float)(64*(t)))>>16)*0x10001u))
  #define KAF(d0,j) __builtin_bit_cast(bf16x8,(u32x4){(d0),(j),ka_one,0u})
  #define QAF() __builtin_bit_cast(bf16x8,qaw)
  #define SET_REF(m,out) do{ const unsigned h_=cvtpk_s((m),0.f)&0xffffu; const float hf_=__uint_as_float(h_<<16); const unsigned l_=cvtpk_s((m)-hf_,0.f)&0xffffu; \
      out=hf_+__uint_as_float(l_<<16); qaw[2]=((l_^0x8000u)<<16)|(h_^0x8000u); }while(0)
  bool started=false;
  bool resc=false;
  #define START(P0,P1) do{ const float rm=rowmax(P0,P1); resc=false; started=(rm>-INFINITY); \
    { float dl=0.f; if(started){ SET_REF(rm,dl); } mhat=dl; \
      _Pragma("unroll") for(int r=0;r<16;++r){P0[r]=fsub_s(P0[r],dl);P1[r]=fsub_s(P1[r],dl);} } \
    _Pragma("unroll") for(int r=0;r<16;++r)P0[r]=__builtin_amdgcn_exp2f(P0[r]); }while(0)
  #define RESC() do{ if(resc){ asm volatile("s_waitcnt lgkmcnt(0)":::"memory"); \
      _Pragma("unroll") for(int d_=0;d_<4;++d_) _Pragma("unroll") for(int r=0;r<16;++r)o[d_][r]*=wsf[crow(r,hi)]; } }while(0)
  f32x16 pA0,pA1,pB0,pB1;
  int sl_prev=0,sl_cur=0,sl_next=SLOTB;
  #define ROT() do{sl_prev=sl_cur;sl_cur=sl_next;sl_next=(sl_next==(NSLOT-1)*SLOTB)?0:sl_next+SLOTB;}while(0)
  DMA_K(2,2*SLOTB);
  WAIT_BAR(4);
  qkt(pA0,pA1,Kbase,qr,KAF(0u,ka_j0),KAF(0u,ka_j1),QAF(),r32,hi);asm volatile("s_nop 15\n\ts_nop 7":"+v"(pA0),"+v"(pA1));CMASK(pA0,pA1,0);
  START(pA0,pA1);
  _Pragma("unroll") for(int r=0;r<16;++r)pA1[r]=__builtin_amdgcn_exp2f(pA1[r]);
  WAIT_BAR(0);
  DMA_K(3,0);DMA_V(1,SLOTB);
  ROT();
  kload8(kf,kp0+sl_cur);
  WAIT_BAR(3);
  s16x4 vlo[8],vhi[8]; u32x4 pw0,pw1,pw2,pw3;
  #define PKW(P,B) cvtpk_s(P[B],P[B+1])
  #define PAF(k) __builtin_bit_cast(bf16x8,pw##k)
  #define VFR(i) (bf16x8){vlo[i][0],vlo[i][1],vlo[i][2],vlo[i][3],vhi[i][0],vhi[i][1],vhi[i][2],vhi[i][3]}
  #define PIN(x) asm volatile("":"+v"(x))
  #define MX3(a,b,c) __builtin_fmaxf(__builtin_fmaxf((a),(b)),(c))
  #define GAPA(MF,A0,A1,A2,A3,W0,W1,PW) do{ MF; sacc+=A0; sacc+=A1; sacc+=A2; sacc+=A3; PIN(sacc); W0; W1; PIN(PW); SBAR(); }while(0)
  #define EX(v) __builtin_amdgcn_exp2f(v)
  #define GAPB(MF,X,B) do{ MF; X[B]=EX(X[B]); X[B+1]=EX(X[B+1]); PIN(X); SBAR(); }while(0)
  #define VRDX(i,db,ks) do{ vlo[i]=vtr(vp_+((db)*4096+(ks)*1024)); vhi[i]=vtr(vp_+((db)*4096+(ks)*1024+512)); }while(0)
  #define VRD(i) VRDX(i,(i)>>2,(i)&3)
  #define VRD2(i) do{ VRDX(i,((i)>>2)+2,(i)&3); SBAR(); }while(0)
  #define KRD(G,j) do{ if(G){ kload2(kf,kp0+sl_next,j); SBAR(); } }while(0)
  #define ROWMAX(C0,C1,rm) do{ float a=MX3(C0[0],C0[1],C1[0]),b=MX3(C0[2],C0[3],C1[1]); a=MX3(a,C1[2],C1[3]); \
      _Pragma("unroll") for(int r=4;r<16;r+=4){a=MX3(a,C0[r],C0[r+1]);b=MX3(b,C0[r+2],C0[r+3]);a=MX3(a,C1[r],C1[r+1]);b=MX3(b,C1[r+2],C1[r+3]);} \
      rm=__builtin_fmaxf(a,b); { auto rr=__builtin_amdgcn_permlane32_swap(__float_as_uint(rm),__float_as_uint(rm),false,false); rm=__builtin_fmaxf(__uint_as_float(rr[0]),__uint_as_float(rr[1])); } }while(0)
  #define DECIDE(C0,C1,rm) do{ resc=false; const bool fin_=(rm>-INFINITY); \
      if(__builtin_expect(__any(started?(rm>(float)THRL):fin_),0)){ const float want=mhat+(started?__builtin_fmaxf(rm,0.f):(fin_?rm:0.f)); float nref; SET_REF(want,nref); \
        const float dl=nref-mhat; mhat=nref; \
        _Pragma("unroll") for(int r=0;r<16;++r){C0[r]-=dl;C1[r]-=dl;} \
        const float f=started?__builtin_amdgcn_exp2f(-dl):1.f; l_reg*=f; if(hi==0)wsf[r32]=f; resc=true; } \
      started=started||fin_; }while(0)
  bool dead=false;
  #define LSTEP(C0,C1,t) do{ SBAR(); \
    { const unsigned kd0_=KA_D0(t); const f32x16 z_=f32x16{}; \
      C0=__builtin_amdgcn_mfma_f32_32x32x16_bf16(KAF(kd0_,ka_j0),QAF(),z_,0,0,0); C1=__builtin_amdgcn_mfma_f32_32x32x16_bf16(KAF(kd0_,ka_j1),QAF(),z_,0,0,0); } \
    C0=__builtin_amdgcn_mfma_f32_32x32x16_bf16(kf[0],qr[0],C0,0,0,0); C1=__builtin_amdgcn_mfma_f32_32x32x16_bf16(kf[1],qr[0],C1,0,0,0); \
    C0=__builtin_amdgcn_mfma_f32_32x32x16_bf16(kf[2],qr[1],C0,0,0,0); C1=__builtin_amdgcn_mfma_f32_32x32x16_bf16(kf[3],qr[1],C1,0,0,0); \
    C0=__builtin_amdgcn_mfma_f32_32x32x16_bf16(kf[4],qr[2],C0,0,0,0); C1=__builtin_amdgcn_mfma_f32_32x32x16_bf16(kf[5],qr[2],C1,0,0,0); \
    C0=__builtin_amdgcn_mfma_f32_32x32x16_bf16(kf[6],qr[3],C0,0,0,0); C1=__builtin_amdgcn_mfma_f32_32x32x16_bf16(kf[7],qr[3],C1,0,0,0); \
    SBAR(); kload2(kf,kp0+sl_next,0); kload2(kf,kp0+sl_next,1); kload2(kf,kp0+sl_next,2); kload2(kf,kp0+sl_next,3); SBAR();     \
    DMA_K((t)+3,sl_cur); DMA_V((t)+1,sl_next); \
    resc=false; \
    { float rm; ROWMAX(C0,C1,rm); \
      if(__builtin_expect(!__all(rm<-160.f),0)){ DECIDE(C0,C1,rm); \
        _Pragma("unroll") for(int r=0;r<16;++r){C0[r]=EX(C0[r]);C1[r]=EX(C1[r]);} dead=false; } } \
    SBAR(); \
    }while(0)
  #define STEP(C0,C1,P0,P1,t,GK,GV,GL) do{ SBAR(); \
    const lds_cptr vp_=vp0+2*sl_prev; \
    { const unsigned kd0_=KA_D0(t); const f32x16 z_=f32x16{}; \
      C0=__builtin_amdgcn_mfma_f32_32x32x16_bf16(KAF(kd0_,ka_j0),QAF(),z_,0,0,0); C1=__builtin_amdgcn_mfma_f32_32x32x16_bf16(KAF(kd0_,ka_j1),QAF(),z_,0,0,0); } \
    VRD(0); SBAR(); float sacc=(P0[0]+P0[1]); \
    GAPA(C0=__builtin_amdgcn_mfma_f32_32x32x16_bf16(kf[0],qr[0],C0,0,0,0), P0[2],P0[3],P0[4],P0[5],     pw0[0]=PKW(P0,0), pw0[1]=PKW(P0,2), pw0); \
    VRD(4); SBAR(); GAPA(C1=__builtin_amdgcn_mfma_f32_32x32x16_bf16(kf[1],qr[0],C1,0,0,0), P0[6],P0[7],P0[8],P0[9],     pw0[2]=PKW(P0,4), pw0[3]=PKW(P0,6), pw0); \
    VRD(1); SBAR(); GAPA(C0=__builtin_amdgcn_mfma_f32_32x32x16_bf16(kf[2],qr[1],C0,0,0,0),   P0[10],P0[11],P0[12],P0[13], pw1[0]=PKW(P0,8), pw1[1]=PKW(P0,10), pw1); \
    VRD(5); SBAR(); GAPA(C1=__builtin_amdgcn_mfma_f32_32x32x16_bf16(kf[3],qr[1],C1,0,0,0),   P0[14],P0[15],P1[0],P1[1],   pw1[2]=PKW(P0,12),pw1[3]=PKW(P0,14), pw1); \
    VRD(2); SBAR(); GAPA(C0=__builtin_amdgcn_mfma_f32_32x32x16_bf16(kf[4],qr[2],C0,0,0,0),   P1[2],P1[3],P1[4],P1[5],     pw2[0]=PKW(P1,0), pw2[1]=PKW(P1,2), pw2); \
    VRD(6); SBAR(); GAPA(C1=__builtin_amdgcn_mfma_f32_32x32x16_bf16(kf[5],qr[2],C1,0,0,0),   P1[6],P1[7],P1[8],P1[9],     pw2[2]=PKW(P1,4), pw2[3]=PKW(P1,6), pw2); \
    VRD(3); SBAR(); GAPA(C0=__builtin_amdgcn_mfma_f32_32x32x16_bf16(kf[6],qr[3],C0,0,0,0),   P1[10],P1[11],P1[12],P1[13], pw3[0]=PKW(P1,8), pw3[1]=PKW(P1,10), pw3); \
    VRD(7); SBAR(); GAPA(C1=__builtin_amdgcn_mfma_f32_32x32x16_bf16(kf[7],qr[3],C1,0,0,0),   P1[14],P1[15],0.f,0.f,       pw3[2]=PKW(P1,12),pw3[3]=PKW(P1,14), pw3); \
    l_reg+=sacc; \
    if(GK){DMA_K((t)+3,sl_cur);} if(GV){DMA_V((t)+1,sl_next);} \
    CMASK(C0,C1,t); \
    { float rm; ROWMAX(C0,C1,rm); DECIDE(C0,C1,rm); dead=__all(rm<-160.f); } \
    SBAR(); \
    GAPB(o[0]=__builtin_amdgcn_mfma_f32_32x32x16_bf16(PAF(0),VFR(0),o[0],0,0,0), C0,0); \
    VRD2(0); GAPB(o[1]=__builtin_amdgcn_mfma_f32_32x32x16_bf16(PAF(0),VFR(4),o[1],0,0,0), C0,2); \
    VRD2(4); GAPB(o[0]=__builtin_amdgcn_mfma_f32_32x32x16_bf16(PAF(1),VFR(1),o[0],0,0,0), C0,4); \
    VRD2(1); GAPB(o[1]=__builtin_amdgcn_mfma_f32_32x32x16_bf16(PAF(1),VFR(5),o[1],0,0,0), C0,6); \
    VRD2(5); GAPB(o[0]=__builtin_amdgcn_mfma_f32_32x32x16_bf16(PAF(2),VFR(2),o[0],0,0,0), C0,8); \
    VRD2(2); GAPB(o[1]=__builtin_amdgcn_mfma_f32_32x32x16_bf16(PAF(2),VFR(6),o[1],0,0,0), C0,10); \
    VRD2(6); GAPB(o[0]=__builtin_amdgcn_mfma_f32_32x32x16_bf16(PAF(3),VFR(3),o[0],0,0,0), C0,12); \
    VRD2(3); GAPB(o[1]=__builtin_amdgcn_mfma_f32_32x32x16_bf16(PAF(3),VFR(7),o[1],0,0,0), C0,14); \
    VRD2(7); GAPB(o[2]=__builtin_amdgcn_mfma_f32_32x32x16_bf16(PAF(0),VFR(0),o[2],0,0,0), C1,0); \
    KRD(GL,0); GAPB(o[3]=__builtin_amdgcn_mfma_f32_32x32x16_bf16(PAF(0),VFR(4),o[3],0,0,0), C1,2); \
    KRD(GL,1); GAPB(o[2]=__builtin_amdgcn_mfma_f32_32x32x16_bf16(PAF(1),VFR(1),o[2],0,0,0), C1,4); \
    KRD(GL,2); GAPB(o[3]=__builtin_amdgcn_mfma_f32_32x32x16_bf16(PAF(1),VFR(5),o[3],0,0,0), C1,6); \
    KRD(GL,3); GAPB(o[2]=__builtin_amdgcn_mfma_f32_32x32x16_bf16(PAF(2),VFR(2),o[2],0,0,0), C1,8); \
    GAPB(o[3]=__builtin_amdgcn_mfma_f32_32x32x16_bf16(PAF(2),VFR(6),o[3],0,0,0), C1,10); \
    GAPB(o[2]=__builtin_amdgcn_mfma_f32_32x32x16_bf16(PAF(3),VFR(3),o[2],0,0,0), C1,12); \
    GAPB(o[3]=__builtin_amdgcn_mfma_f32_32x32x16_bf16(PAF(3),VFR(7),o[3],0,0,0), C1,14); \
    }while(0)
  int t=1;
  #define ENDW(tt) do{ if((tt)+3<NT){WAIT_BAR(3);} else if((tt)+2<NT){WAIT_BAR(2);} else {WAIT_BAR(0);} }while(0)
  for(;t<5&&t+1<NT;t+=2){
    STEP(pB0,pB1,pA0,pA1,t,(t+3<NT),(t+1<NT),(t+1<NT));       ENDW(t);   RESC(); ROT();
    STEP(pA0,pA1,pB0,pB1,t+1,(t+4<NT),(t+2<NT),(t+2<NT));     ENDW(t+1); RESC(); ROT();
  }
  if(NT>=10){
    float v_=-mhat;
    _Pragma("unroll") for(int o_=1;o_<32;o_<<=1)v_=__builtin_fmaxf(v_,__shfl_xor(v_,o_));
    if(lane==0)wsf[48]=v_;
    asm volatile("s_waitcnt lgkmcnt(0)\n\ts_barrier":::"memory");
    const float*wsx_=(const float*)(shm+LDS_WS); float mx_=wsx_[48];
    _Pragma("unroll") for(int w_=1;w_<NW;++w_)mx_=__builtin_fmaxf(mx_,wsx_[w_*64+48]);
    const float tb_=(bnd+mx_)*inv64c; int n2_=(tb_<1000.f)?2*((int)(tb_*0.5f))+2:4096; n2_=n2_<8?8:n2_;
    NT=__builtin_amdgcn_readfirstlane(n2_<NT?n2_:NT);
  }
  #undef CMASK
  #define CMASK(P0,P1,t) do{}while(0)
  while(t+5<NT){
    STEP(pB0,pB1,pA0,pA1,t,true,true,true);     WAIT_BAR(3); RESC(); ROT();
    STEP(pA0,pA1,pB0,pB1,t+1,true,true,true);   WAIT_BAR(3); RESC(); ROT();
    t+=2; if(dead) break;
  }
  if(dead){
    for(;t+5<NT;++t){
      dead=true; LSTEP(pA0,pA1,t); WAIT_BAR(3); RESC();
      if(!dead){ float sacc=pA0[0]+pA0[1]; _Pragma("unroll") for(int r=2;r<16;++r)sacc+=pA0[r]; _Pragma("unroll") for(int r=0;r<16;++r)sacc+=pA1[r]; l_reg+=sacc;
        pw0=(u32x4){PKW(pA0,0),PKW(pA0,2),PKW(pA0,4),PKW(pA0,6)};pw1=(u32x4){PKW(pA0,8),PKW(pA0,10),PKW(pA0,12),PKW(pA0,14)};pw2=(u32x4){PKW(pA1,0),PKW(pA1,2),PKW(pA1,4),PKW(pA1,6)};pw3=(u32x4){PKW(pA1,8),PKW(pA1,10),PKW(pA1,12),PKW(pA1,14)};
        SBAR(); pv(o,vb0+2*sl_cur,PAF(0),PAF(1),PAF(2),PAF(3)); }
      ROT();
    }
    dead=true; pA0=f32x16{}; pA1=f32x16{}; pB0=f32x16{}; pB1=f32x16{};
    if(!(t&1)){   }
  }
  #undef CMASK
  #define CMASK(P0,P1,t) do{int jb_=3-(t); if(jb_>=0)cmask(P0,P1,jb_,qrel,hi);}while(0)
  for(;t+1<NT;t+=2){
    STEP(pB0,pB1,pA0,pA1,t,(t+3<NT),(t+1<NT),(t+1<NT));       ENDW(t);   RESC(); ROT();
    STEP(pA0,pA1,pB0,pB1,t+1,(t+4<NT),(t+2<NT),(t+2<NT));     ENDW(t+1); RESC(); ROT();
  }
  STEP(pB0,pB1,pA0,pA1,NT-1,false,false,false); RESC();
  { float sacc=pB0[0]+pB0[1]; _Pragma("unroll") for(int r=2;r<16;++r)sacc+=pB0[r]; _Pragma("unroll") for(int r=0;r<16;++r)sacc+=pB1[r]; l_reg+=sacc;
    pw0=(u32x4){PKW(pB0,0),PKW(pB0,2),PKW(pB0,4),PKW(pB0,6)};pw1=(u32x4){PKW(pB0,8),PKW(pB0,10),PKW(pB0,12),PKW(pB0,14)};pw2=(u32x4){PKW(pB1,0),PKW(pB1,2),PKW(pB1,4),PKW(pB1,6)};pw3=(u32x4){PKW(pB1,8),PKW(pB1,10),PKW(pB1,12),PKW(pB1,14)};
    SBAR(); pv(o,vb0+2*sl_cur,PAF(0),PAF(1),PAF(2),PAF(3)); }
  #undef PKW
  #undef PAF
  #undef VFR
  #undef PIN
  #undef MX3
  #undef GAPA
  #undef GAPB
  #undef EX
  #undef VRD
  #undef VRD2
  #undef VRDX
  #undef KRD
  #undef STEP
  #undef LSTEP
  #undef ROWMAX
  #undef DECIDE
  #undef ENDW
  {auto rr=__builtin_amdgcn_permlane32_swap(__float_as_uint(l_reg),__float_as_uint(l_reg),false,false);l_reg=__uint_as_float(rr[0])+__uint_as_float(rr[1]);}
  if(hi==0)wsf[32+r32]=l_reg;asm volatile("s_waitcnt lgkmcnt(0)":::"memory");
  float rli[16];
  #pragma unroll
  for(int r=0;r<16;++r)rli[r]=__builtin_amdgcn_rcpf(wsf[32+crow(r,hi)]);
  bf16*Ow=Oh+(long)(q0+wid*QBLK)*DMO;
  { bf16*stg=(bf16*)(shm+LDS_OST)+wid*2048;
    #pragma unroll
    for(int pass=0;pass<2;++pass){
      #pragma unroll
      for(int r=0;r<16;++r){const int orow=crow(r,hi);
        #pragma unroll
        for(int d0=0;d0<2;++d0)stg[orow*64+d0*32+r32]=__float2bfloat16(o[2*pass+d0][r]*rli[r]);}
      asm volatile("s_waitcnt lgkmcnt(0)":::"memory");
      #pragma unroll
      for(int i=0;i<4;++i){const int row=i*8+(lane>>3),ch=lane&7; const u32x4 v=*(const u32x4*)(stg+row*64+ch*8); ATTN_STORE16(Ow+(long)row*DMO+pass*64+ch*8,v);}
      asm volatile("s_waitcnt lgkmcnt(0)":::"memory"); } }
  asm volatile("s_waitcnt lgkmcnt(0)\n\ts_barrier":::"memory");
  #undef DMA_K
  #undef DMA_V
  #undef CMASK
  #undef KA_D0
  #undef KAF
  #undef QAF
  #undef SET_REF
  #undef START
  #undef RESC
  #undef ROT
}
constexpr int ATTN_LDS_BYTES=LDS_BYTES;
struct AttnTensors { const bf16* P; bf16* O; const unsigned* nrm; };
struct AttnUnit { int combo; int qb; };
__device__ const unsigned char ATT_TAB[256] = {123, 45, 21, 112, 255, 255, 255, 255, 127, 55, 50, 65, 255, 255, 255, 255, 75, 44, 20, 64, 255, 255, 255, 255, 79, 118, 115, 49, 255, 255, 255, 255, 122, 68, 29, 15, 255, 255, 255, 255, 126, 119, 67, 14, 255, 255, 255, 255, 74, 52, 28, 13, 255, 255, 255, 255, 78, 71, 51, 12, 255, 255, 255, 255, 121, 69, 27, 11, 255, 255, 255, 255, 125, 59, 114, 113, 255, 255, 255, 255, 73, 53, 26, 10, 255, 255, 255, 255, 77, 58, 66, 97, 255, 255, 255, 255, 120, 70, 25, 9, 255, 255, 255, 255, 124, 63, 41, 8, 255, 255, 255, 255, 72, 54, 24, 7, 255, 255, 255, 255, 76, 62, 40, 6, 255, 255, 255, 255, 107, 47, 23, 96, 255, 255, 255, 255, 111, 102, 39, 80, 255, 255, 255, 255, 91, 46, 22, 48, 255, 255, 255, 255, 95, 86, 38, 32, 255, 255, 255, 255, 106, 100, 34, 81, 255, 255, 255, 255, 110, 103, 37, 16, 255, 255, 255, 255, 90, 84, 31, 33, 255, 255, 255, 255, 94, 87, 36, 0, 255, 255, 255, 255, 105, 85, 30, 17, 255, 255, 255, 255, 109, 57, 99, 5, 255, 255, 255, 255, 89, 116, 83, 4, 255, 255, 255, 255, 93, 56, 35, 3, 255, 255, 255, 255, 104, 117, 98, 19, 255, 255, 255, 255, 108, 61, 43, 2, 255, 255, 255, 255, 88, 101, 82, 18, 255, 255, 255, 255, 92, 60, 42, 1, 255, 255, 255, 255};
struct StaticOrder {
  int vcu, G;
  __device__ __forceinline__ explicit StaticOrder(int grid,int block):vcu((grid%8==0)?(block%8)*(grid/8)+block/8:block),G(grid){}
  __device__ __forceinline__ bool next(int i,AttnUnit&u)const{
    if(G==256){ if(i>=8)return false; const int g=vcu>>5, c=vcu&31; const int e=__builtin_amdgcn_readfirstlane((int)ATT_TAB[((g&1)*16+(c&15))*8+i]); if(e==255)return false;
      u.combo=(((g>>1)*8+(e>>4))<<1)|(c>>4); u.qb=e&15; return true; }
    const int L=i*G+vcu; if(L>=64*16)return false; u.combo=L>>4; u.qb=L&15; return true; }
};
template<class Sched,int THRL=8> __device__ __forceinline__ void attn_phase(char*lds,const AttnTensors&T,const Sched&S){
  AttnUnit u;
  for(int i=0;S.next(i,u);++i){
    const int m=u.combo&1, h=(u.combo>>1)&7, b=u.combo>>4;
    const bf16*rowp=T.P+(long)b*SEQ*DM;
    const float sl2=LOG2E*__builtin_amdgcn_exp2f(-(float)(h+1));
    int nte; float bnd, inv64c;
    { const int hm=2*h+m; const unsigned*qt=T.nrm+(b*16+u.qb)*32+2*hm, *kt=T.nrm+64*32+b*32+2*hm;
      const float q2=__uint_as_float(__hip_atomic_load(qt,__ATOMIC_RELAXED,__HIP_MEMORY_SCOPE_AGENT))+__uint_as_float(__hip_atomic_load(qt+1,__ATOMIC_RELAXED,__HIP_MEMORY_SCOPE_AGENT));
      const float k2=__uint_as_float(__hip_atomic_load(kt,__ATOMIC_RELAXED,__HIP_MEMORY_SCOPE_AGENT))+__uint_as_float(__hip_atomic_load(kt+1,__ATOMIC_RELAXED,__HIP_MEMORY_SCOPE_AGENT));
      const float B=__builtin_sqrtf(q2*k2);
      const float tb=((170.f+2.04f*B)/(0.999f*sl2)+255.f)*(1.f/64.f);
      nte=(tb<1000.f)?2*((int)(tb*0.5f))+2:4096;
      nte=__builtin_amdgcn_readfirstlane(nte);
      bnd=162.f+1.02f*B; inv64c=1.f/(64.f*0.999f*sl2); }
    attn_unit<THRL>(u.qb, rowp+1024+(2*h+m)*64, rowp+2048+(2*h+m)*64, rowp+3072+h*128, T.O+(long)b*SEQ*DMO+m*1024+h*128, sl2, lds, nte, bnd, inv64c); }
}
#undef SBAR
#undef WAIT_BAR
}
#define GAS __attribute__((address_space(1)))
#define LAS __attribute__((address_space(3)))
typedef unsigned short bf16;
typedef unsigned v4u __attribute__((ext_vector_type(4)));
typedef float f32x4 __attribute__((ext_vector_type(4)));
typedef short bf16x8 __attribute__((ext_vector_type(8)));
typedef GAS unsigned gu32;
typedef GAS unsigned long long gu64;
#define RLX_AGENT __ATOMIC_RELAXED, __HIP_MEMORY_SCOPE_AGENT
#define LDS_WAIT() asm volatile("s_waitcnt lgkmcnt(0)" ::: "memory")
#define VM_WAIT() asm volatile("s_waitcnt vmcnt(0)" ::: "memory")
__device__ __forceinline__ unsigned long long rt() { return __builtin_amdgcn_s_memrealtime(); }
__device__ __forceinline__ unsigned f2bf(float f) { unsigned u = __builtin_bit_cast(unsigned, f); return (u + 0x7fffu + ((u >> 16) & 1u)) >> 16; }
__device__ __forceinline__ unsigned pk2(float lo, float hi) { return f2bf(lo) | (f2bf(hi) << 16); }

#define XB_TMO      128
#define XB_XCNT(j)  (256  + 64 * (j))
#define XB_XSUB(j)  (1280 + 64 * (j))
#define XB_XGEN(j)  (2304 + 64 * (j))
#define XB_TOP      3328
#define XB_TOPGEN   3392
#define XCD_BAR_WORDS 3456
#define XB_SPIN_CAP (1u << 18)

__device__ __forceinline__ unsigned xb_ld(unsigned* p)              { return __hip_atomic_load(p, __ATOMIC_RELAXED, __HIP_MEMORY_SCOPE_AGENT); }
__device__ __forceinline__ unsigned xb_add(unsigned* p, unsigned v) { return __hip_atomic_fetch_add(p, v, __ATOMIC_RELAXED, __HIP_MEMORY_SCOPE_AGENT); }
__device__ __forceinline__ unsigned xb_xcc_id() { return (unsigned)__builtin_amdgcn_s_getreg((3 << 11) | 20) & 0xFu; }
#define XB_SPIN(cond, bar) do { unsigned _sp = 0; while (cond) { __builtin_amdgcn_s_sleep(1); \
    if ((++_sp & 255u) == 0u) { if (xb_ld(&(bar)[XB_TMO])) break; if (_sp > XB_SPIN_CAP) { atomicAdd(&(bar)[XB_TMO], 1u); break; } } } } while (0)

struct XcdBarrier {
    unsigned* bar; unsigned x;
    volatile LAS unsigned* st;
};

__device__ __forceinline__ XcdBarrier xcd_barrier_post(unsigned* bar, volatile LAS unsigned* st) {
    XcdBarrier b; b.bar = bar; b.x = xb_xcc_id(); b.st = st;
    if (threadIdx.x == 0) (void)xb_add(&bar[XB_XCNT(b.x)], 1u);
    return b;
}
__device__ __forceinline__ void xcd_barrier_complete(unsigned* bar, unsigned x, unsigned& nloc, unsigned& nx) {
    const unsigned G = gridDim.x * gridDim.y * gridDim.z;
    unsigned sum, cnt, mine, sp = 0u;
    for (;;) {
        sum = 0u; cnt = 0u; mine = 0u;
#pragma unroll
        for (unsigned j = 0; j < 16; ++j) { const unsigned c = xb_ld(&bar[XB_XCNT(j)]); sum += c; cnt += (c > 0u) ? 1u : 0u; mine = (j == x) ? c : mine; }
        if (sum == G) break;
        __builtin_amdgcn_s_sleep(1);
        if ((++sp & 255u) == 0u) { if (xb_ld(&bar[XB_TMO])) break; if (sp > XB_SPIN_CAP) { atomicAdd(&bar[XB_TMO], 1u); break; } }
    }
    nloc = mine > 0u ? mine : 1u; nx = cnt > 0u ? cnt : 1u;
}

__device__ __forceinline__ void xcd_barrier(const XcdBarrier& b) {
    asm volatile("s_waitcnt vmcnt(0)" ::: "memory");
    __syncthreads();
    if (threadIdx.x == 0) {
        unsigned* bar = b.bar; unsigned bx_ = b.x;
        asm volatile("" : "+s"(bar), "+s"(bx_));
        __builtin_amdgcn_s_waitcnt(0);
        unsigned nloc = b.st[0], nx = b.st[1];
        if (nloc == 0u) { xcd_barrier_complete(bar, bx_, nloc, nx); b.st[0] = nloc; b.st[1] = nx; }
        const unsigned old = xb_add(&bar[XB_XSUB(bx_)], 1u);
        const unsigned gen = old / nloc;
        if (old + 1u == (gen + 1u) * nloc) {
            __builtin_amdgcn_fence(__ATOMIC_RELEASE, "agent");
            asm volatile("s_waitcnt vmcnt(0)" ::: "memory");
            const unsigned og = xb_add(&bar[XB_TOP], 1u);
            const unsigned tg = og / nx;
            if (og + 1u == (tg + 1u) * nx) xb_add(&bar[XB_TOPGEN], 1u);
            else XB_SPIN(xb_ld(&bar[XB_TOPGEN]) == tg, bar);
            __builtin_amdgcn_fence(__ATOMIC_ACQUIRE, "agent");
            xb_add(&bar[XB_XGEN(bx_)], 1u);
            asm volatile("s_waitcnt vmcnt(0)" ::: "memory");
        } else {
            XB_SPIN(xb_ld(&bar[XB_XGEN(bx_)]) == gen, bar);
            __builtin_amdgcn_fence(__ATOMIC_ACQUIRE, "agent");
            asm volatile("s_waitcnt vmcnt(0)" ::: "memory");
        }
    }
    __syncthreads();
}

constexpr int NWAVES = 8;
struct Frame {
    LAS unsigned char* lds;
    volatile LAS unsigned* MISC;
    gu32* ctl;
    int tid, lane, wave;
    int vcu, G;
};
__device__ __forceinline__ float wave_sum(float v) {
#pragma unroll
    for (int o = 1; o < 64; o <<= 1) v += __shfl_xor(v, o);
    return v;
}
__device__ __forceinline__ float bf_lo(unsigned w) { return __uint_as_float(w << 16); }
__device__ __forceinline__ float bf_hi(unsigned w) { return __uint_as_float(w & 0xffff0000u); }

__device__ __forceinline__ void w_transpose_item(const float* W, int K, int N, const float* gain, bf16* WT, int k0, int n0, int dst_row0, LAS float* scr, int lane) {
    const GAS float* src = (const GAS float*)W + (size_t)(k0 + (lane >> 5)) * N + n0 + (lane & 31);
    float w[32];
#pragma unroll
    for (int i = 0; i < 32; ++i) w[i] = __builtin_nontemporal_load(src + (size_t)(2 * i) * N);
    const int c = lane & 7;
    f32x4 g0 = (f32x4){1.f, 1.f, 1.f, 1.f}, g1 = g0;
    if (gain) { g0 = *(const GAS f32x4*)(gain + k0 + 8 * c); g1 = *(const GAS f32x4*)(gain + k0 + 8 * c + 4); }
#pragma unroll
    for (int i = 0; i < 32; ++i) scr[(2 * i + (lane >> 5)) * 33 + (lane & 31)] = w[i];
    LDS_WAIT(); asm volatile("" ::: "memory");
#pragma unroll
    for (int j = 0; j < 4; ++j) { const int n = (lane >> 3) + 8 * j; const LAS float* s = scr + (8 * c) * 33 + n;
        v4u o; o.x = pg8::cvt_pk_bf16(s[0 * 33] * g0.x, s[1 * 33] * g0.y); o.y = pg8::cvt_pk_bf16(s[2 * 33] * g0.z, s[3 * 33] * g0.w);
        o.z = pg8::cvt_pk_bf16(s[4 * 33] * g1.x, s[5 * 33] * g1.y); o.w = pg8::cvt_pk_bf16(s[6 * 33] * g1.z, s[7 * 33] * g1.w);
        *(GAS v4u*)(WT + (size_t)(dst_row0 + n) * K + k0 + 8 * c) = o; }
    LDS_WAIT(); asm volatile("" ::: "memory");
}

constexpr int DM = 2048, NB = 4, SEQ = 4096, M = NB * SEQ, DEPTH = 4, FF = 5632, NIN = 5632, WA = 512, WBW = 1024, WC = 512;
constexpr float EPS = 1e-6f;
constexpr size_t MiB = 1u << 20;
constexpr size_t WS_CTL = 0, CTL_ZERO_BYTES = 4 * MiB;
constexpr int CW_BAR = 4096;
constexpr size_t NRM_OFF = 3 * MiB, NRM_LAYER_BYTES = 16384;
constexpr size_t SS_OFF = 64 * 1024;
static_assert(CW_BAR * 4 + XCD_BAR_WORDS * 4 <= SS_OFF && SS_OFF + 17 * (size_t)M * 8 <= NRM_OFF && NRM_OFF + 4 * NRM_LAYER_BYTES <= CTL_ZERO_BYTES && (pg8::NRM_K_WORD + 4 * 32) * 4 <= (int)NRM_LAYER_BYTES, "ctl map");
constexpr size_t WS_WGU1 = 4 * MiB, WS_WD1 = WS_WGU1 + 44 * MiB, WS_WIN = WS_WD1 + 22 * MiB, WS_WOUT = WS_WIN + 22 * MiB, WS_WGU2 = WS_WOUT + 8 * MiB, WS_WD2 = WS_WGU2 + 44 * MiB;
constexpr size_t WL_STRIDE = 162 * MiB;
constexpr size_t WS_XB = WS_WGU1 + 4 * WL_STRIDE;
constexpr size_t WS_ACT = WS_XB + 64 * MiB;
constexpr size_t WS_OB = WS_ACT + 176 * MiB;
constexpr size_t WS_YM = WS_OB + 64 * MiB;
constexpr size_t WS_END = WS_YM + 64 * MiB;
static_assert((size_t)FF * 2 * DM * 2 == 44 * MiB && (size_t)M * FF * 2 == 176 * MiB, "sizes");
constexpr int RING_OFF = 0, RING_BYTES = 131072;
constexpr int LDSCTL_OFF = RING_BYTES, MISC_OFF = LDSCTL_OFF + 320;
constexpr int LDS_BYTES = 147456;
constexpr int RSTAB_OFF = RING_BYTES + 1024;

struct Args { const float* in[19]; float* out; unsigned char* ws; };
typedef const __attribute__((address_space(4))) Args* ArgsP;
__device__ __forceinline__ ArgsP get_args() { ArgsP p = (ArgsP)__builtin_amdgcn_kernarg_segment_ptr(); asm volatile("" : "+s"(p)); return p; }

__device__ __forceinline__ const LAS float* fill_rstab(Frame& F, const pg8::ssq_t* ss, float inv_k, int* rowbase) {
    if (F.G != 256) { *rowbase = 0; return nullptr; }
    LAS float* tab = (LAS float*)(F.lds + RSTAB_OFF); const int base = 2048 * ((int)blockIdx.x & 7); *rowbase = base;
    int t_ = threadIdx.x; asm volatile("" : "+v"(t_));
#pragma unroll
    for (int i = 0; i < 4; ++i) tab[t_ + 512 * i] = __builtin_amdgcn_rsqf(pg8::ssq_dec(ss[base + t_ + 512 * i]) * inv_k + pg8::RMS_EPS);
    __syncthreads();
    return tab;
}

__device__ __forceinline__ void phase_weights(Frame& F0, int l_in, bool do_x = true, size_t dst_shift = 0) {
    int l = l_in; asm volatile("" : "+s"(l));
    Frame F = F0; asm volatile("" : "+v"(F.tid), "+v"(F.lane));
    const ArgsP ap = get_args();
    LAS float* scr = (LAS float*)(F.lds + RING_OFF + F.wave * 16384);
    const int gw = F.vcu * NWAVES + F.wave, NGW = F.G * NWAVES;
    unsigned char* ws = ap->ws + dst_shift;
    constexpr int I_BIG = (DM / 64) * (FF / 32);
    constexpr int I_OUT = (DM / 64) * (DM / 32);
    constexpr int NITEMS = 7 * I_BIG + I_OUT;
    const size_t wbig = (size_t)l * DM * FF;
    for (int it = gw; it < NITEMS; it += NGW) {
        const int which = it / I_BIG, r = it % I_BIG;
        if (which == 0 || which == 1 || which == 4 || which == 5) {
            const int f2 = which >= 4, up = which & 1;
            const float* W = ap->in[(f2 ? 15 : 2) + up] + wbig; const float* g = ap->in[f2 ? 14 : 1] + (size_t)l * DM;
            bf16* WT = (bf16*)(ws + (f2 ? WS_WGU2 : WS_WGU1));
            const int nblk = FF / 32, kb = r / nblk, nb = r % nblk, n0 = 32 * nb;
            w_transpose_item(W, DM, FF, g, WT, 64 * kb, n0, (n0 / 128) * 256 + (n0 % 128) + up * 128, scr, F.lane);
        } else if (which == 2 || which == 6) {
            const int f2 = which == 6;
            const float* W = ap->in[f2 ? 17 : 4] + wbig; bf16* WT = (bf16*)(ws + (f2 ? WS_WD2 : WS_WD1));
            const int nblk = DM / 32, kb = r / nblk, nb = r % nblk;
            w_transpose_item(W, FF, DM, nullptr, WT, 64 * kb, 32 * nb, 32 * nb, scr, F.lane);
        } else if (which == 3) {
            const float* W = ap->in[6] + wbig; const float* g = ap->in[5] + (size_t)l * DM; bf16* WT = (bf16*)(ws + WS_WIN);
            const int nblk = NIN / 32, kb = r / nblk, nb = r % nblk;
            w_transpose_item(W, DM, NIN, g, WT, 64 * kb, 32 * nb, 32 * nb, scr, F.lane);
        } else {
            const float* W = ap->in[13] + (size_t)l * DM * DM; bf16* WT = (bf16*)(ws + WS_WOUT);
            const int nblk = DM / 32, kb = r / nblk, nb = r % nblk;
            w_transpose_item(W, DM, DM, nullptr, WT, 64 * kb, 32 * nb, 32 * nb, scr, F.lane);
        }
    }
    if (l == 0 && do_x) {
        const float* x = ap->in[0]; bf16* xb = (bf16*)(ws + WS_XB); pg8::ssq_t* ss0 = (pg8::ssq_t*)(ws + SS_OFF);
        for (int m = gw; m < M; m += NGW) {
            const GAS f32x4* xr = (const GAS f32x4*)(x + (size_t)m * DM) + F.lane; GAS unsigned long long* o8 = (GAS unsigned long long*)(xb + (size_t)m * DM) + F.lane;
            float s = 0.f;
#pragma unroll
            for (int j = 0; j < 8; ++j) { const f32x4 v = xr[64 * j]; s += (v.x * v.x + v.y * v.y) + (v.z * v.z + v.w * v.w);
                o8[64 * j] = (unsigned long long)pk2(v.x, v.y) | ((unsigned long long)pk2(v.z, v.w) << 32); }
            s = wave_sum(s); if (F.lane == 0) ss0[m] = pg8::ssq_enc(s);
        }
    }
}

__device__ __forceinline__ void phase_mixer_post(Frame& F0, int l_in) {
    int l = l_in; asm volatile("" : "+s"(l));
    Frame F = F0; asm volatile("" : "+v"(F.tid), "+v"(F.lane));
    const ArgsP ap = get_args();
    unsigned char* ws = ap->ws;
    const bf16* P = (const bf16*)(ws + WS_ACT); const bf16* OB = (const bf16*)(ws + WS_OB); bf16* YM = (bf16*)(ws + WS_YM);
    const int gw = F.vcu * NWAVES + F.wave, NGW = F.G * NWAVES, lane = F.lane;
    const float* lq = ap->in[10] + (size_t)l * 4 * 64;
    const float s01 = wave_sum(lq[lane] * lq[64 + lane]), s23 = wave_sum(lq[128 + lane] * lq[192 + lane]);
    const float lam_init = 0.8f - 0.6f * __expf(-0.3f * (float)l);
    const float lam = __expf(s01) - __expf(s23) + lam_init, oml = 1.0f - lam_init;
    {
        const float* gsub = ap->in[11] + (size_t)l * 128; const float* wcv = ap->in[12] + (size_t)l * 3 * WC;
        float gs[16]; { const int c0 = (lane & 7) * 16;
#pragma unroll
            for (int i = 0; i < 16; ++i) gs[i] = gsub[c0 + i] * oml; }
        float w0[8], w1[8], w2[8]; { const int c = lane * 8;
#pragma unroll
            for (int i = 0; i < 8; ++i) { w0[i] = wcv[c + i]; w1[i] = wcv[WC + c + i]; w2[i] = wcv[2 * WC + c + i]; } }
        for (int row = gw; row < M; row += NGW) {
            { const v4u* p1 = (const v4u*)(OB + (size_t)row * 2048 + lane * 16); const v4u* p2 = (const v4u*)(OB + (size_t)row * 2048 + 1024 + lane * 16);
              const v4u a0 = p1[0], a1 = p1[1], b0 = p2[0], b1 = p2[1];
              const unsigned aw[8] = {a0.x, a0.y, a0.z, a0.w, a1.x, a1.y, a1.z, a1.w}, bw[8] = {b0.x, b0.y, b0.z, b0.w, b1.x, b1.y, b1.z, b1.w};
              float d[16]; float s = 0.f;
#pragma unroll
              for (int i = 0; i < 8; ++i) { d[2 * i] = bf_lo(aw[i]) - lam * bf_lo(bw[i]); d[2 * i + 1] = bf_hi(aw[i]) - lam * bf_hi(bw[i]); s += d[2 * i] * d[2 * i] + d[2 * i + 1] * d[2 * i + 1]; }
              s += __shfl_xor(s, 1); s += __shfl_xor(s, 2); s += __shfl_xor(s, 4);
              const float rs = __builtin_amdgcn_rsqf(s * (1.0f / 128.0f) + EPS);
              v4u o0, o1;
              o0.x = pk2(d[0] * rs * gs[0], d[1] * rs * gs[1]); o0.y = pk2(d[2] * rs * gs[2], d[3] * rs * gs[3]); o0.z = pk2(d[4] * rs * gs[4], d[5] * rs * gs[5]); o0.w = pk2(d[6] * rs * gs[6], d[7] * rs * gs[7]);
              o1.x = pk2(d[8] * rs * gs[8], d[9] * rs * gs[9]); o1.y = pk2(d[10] * rs * gs[10], d[11] * rs * gs[11]); o1.z = pk2(d[12] * rs * gs[12], d[13] * rs * gs[13]); o1.w = pk2(d[14] * rs * gs[14], d[15] * rs * gs[15]);
              v4u* yo = (v4u*)(YM + (size_t)row * 2048 + WA + lane * 16); yo[0] = o0; yo[1] = o1; }
            { const int t = row & (SEQ - 1); const bf16* pr = P + (size_t)row * NIN + lane * 8;
              const v4u bg = *(const v4u*)(pr + 4096), cg0 = *(const v4u*)(pr + 4608), xc0 = *(const v4u*)(pr + 5120);
              v4u cg1 = (v4u){0u, 0u, 0u, 0u}, xc1 = cg1, cg2 = cg1, xc2 = cg1;
              if (t >= 1) { cg1 = *(const v4u*)(pr - NIN + 4608); xc1 = *(const v4u*)(pr - NIN + 5120); }
              if (t >= 2) { cg2 = *(const v4u*)(pr - 2 * NIN + 4608); xc2 = *(const v4u*)(pr - 2 * NIN + 5120); }
              const unsigned bgw[4] = {bg.x, bg.y, bg.z, bg.w}, c0w[4] = {cg0.x, cg0.y, cg0.z, cg0.w}, x0w[4] = {xc0.x, xc0.y, xc0.z, xc0.w},
                             c1w[4] = {cg1.x, cg1.y, cg1.z, cg1.w}, x1w[4] = {xc1.x, xc1.y, xc1.z, xc1.w}, c2w[4] = {cg2.x, cg2.y, cg2.z, cg2.w}, x2w[4] = {xc2.x, xc2.y, xc2.z, xc2.w};
              unsigned ow[4];
#pragma unroll
              for (int i = 0; i < 4; ++i) {
                  const float ylo = bf_lo(bgw[i]) * (w0[2 * i] * (bf_lo(c2w[i]) * bf_lo(x2w[i])) + w1[2 * i] * (bf_lo(c1w[i]) * bf_lo(x1w[i])) + w2[2 * i] * (bf_lo(c0w[i]) * bf_lo(x0w[i])));
                  const float yhi = bf_hi(bgw[i]) * (w0[2 * i + 1] * (bf_hi(c2w[i]) * bf_hi(x2w[i])) + w1[2 * i + 1] * (bf_hi(c1w[i]) * bf_hi(x1w[i])) + w2[2 * i + 1] * (bf_hi(c0w[i]) * bf_hi(x0w[i])));
                  ow[i] = pk2(ylo, yhi); }
              *(v4u*)(YM + (size_t)row * 2048 + WA + WBW + lane * 8) = (v4u){ow[0], ow[1], ow[2], ow[3]}; }
        }
    }
    {
        constexpr int PITCH = 136;
        LAS bf16* WT = (LAS bf16*)(F.lds + RING_OFF);
        LAS bf16* VT = (LAS bf16*)(F.lds + RING_OFF + 128 * PITCH * 2);
        LAS float* RS = (LAS float*)(F.lds + RING_OFF + 2 * 128 * PITCH * 2);
        const pg8::ssq_t* ssv = (const pg8::ssq_t*)(ws + SS_OFF) + (size_t)(13 + l) * M;
        const float* wsg = ap->in[8] + (size_t)l * 4 * 128 * 128; const float* bsg = ap->in[9] + (size_t)l * 4 * 128; const float* gv = ap->in[7] + (size_t)l * WA;
        const int tid = F.tid, wave = F.wave, fr = lane & 15, fq = lane >> 4;
        for (int unit = blockIdx.x; unit < 512; unit += F.G) {
            const int ch = unit >> 2, g = unit & 3, r0 = ch * 128;
            __syncthreads();
            if (tid < 128) RS[tid] = __builtin_amdgcn_rsqf(pg8::ssq_dec(ssv[r0 + tid]) * (1.0f / WA) + EPS);
            __syncthreads();
            { const int t = tid >> 2, s0 = (tid & 3) * 32; const float* wrow = wsg + ((size_t)g * 128 + t) * 128 + s0;
#pragma unroll
              for (int j = 0; j < 4; ++j) { const f32x4 wa = *(const f32x4*)(wrow + 8 * j), wb = *(const f32x4*)(wrow + 8 * j + 4); const int s = s0 + 8 * j;
                  float e[8] = {wa.x, wa.y, wa.z, wa.w, wb.x, wb.y, wb.z, wb.w};
#pragma unroll
                  for (int i = 0; i < 8; ++i) e[i] = (s + i <= t) ? e[i] * RS[s + i] : 0.f;
                  *(LAS v4u*)(WT + t * PITCH + s) = (v4u){pk2(e[0], e[1]), pk2(e[2], e[3]), pk2(e[4], e[5]), pk2(e[6], e[7])}; } }
            { const int s = tid >> 2, c0 = (tid & 3) * 32; const bf16* vrow = P + (size_t)(r0 + s) * NIN + WA + g * 128 + c0;
#pragma unroll
              for (int j = 0; j < 4; ++j) { const v4u v = *(const v4u*)(vrow + 8 * j); const unsigned vw[4] = {v.x, v.y, v.z, v.w};
#pragma unroll
                  for (int i = 0; i < 4; ++i) { VT[(c0 + 8 * j + 2 * i) * PITCH + s] = (bf16)(vw[i] & 0xffffu); VT[(c0 + 8 * j + 2 * i + 1) * PITCH + s] = (bf16)(vw[i] >> 16); } } }
            __syncthreads();
            f32x4 acc[8];
#pragma unroll
            for (int j = 0; j < 8; ++j) acc[j] = (f32x4){0.f, 0.f, 0.f, 0.f};
#pragma unroll
            for (int kk = 0; kk < 4; ++kk) { const bf16x8 af = *(const LAS bf16x8*)(WT + (16 * wave + fr) * PITCH + kk * 32 + fq * 8);
#pragma unroll
                for (int j = 0; j < 8; ++j) { const bf16x8 bfv = *(const LAS bf16x8*)(VT + (16 * j + fr) * PITCH + kk * 32 + fq * 8);
                    acc[j] = __builtin_amdgcn_mfma_f32_16x16x32_bf16(bfv, af, acc[j], 0, 0, 0); } }
            const int t = 16 * wave + fr; const float bt = bsg[g * 128 + t];
#pragma unroll
            for (int j = 0; j < 8; ++j) { const int c = 16 * j + 4 * fq; const f32x4 gvv = *(const f32x4*)(gv + g * 128 + c);
                const unsigned long long uu = *(const unsigned long long*)(P + (size_t)(r0 + t) * NIN + g * 128 + c); const unsigned ulo = (unsigned)uu, uhi = (unsigned)(uu >> 32);
                const float y0 = bf_lo(ulo) * (acc[j][0] * gvv.x + bt), y1 = bf_hi(ulo) * (acc[j][1] * gvv.y + bt), y2 = bf_lo(uhi) * (acc[j][2] * gvv.z + bt), y3 = bf_hi(uhi) * (acc[j][3] * gvv.w + bt);
                *(unsigned long long*)(YM + (size_t)(r0 + t) * 2048 + g * 128 + c) = (unsigned long long)pk2(y0, y1) | ((unsigned long long)pk2(y2, y3) << 32); }
        }
        __syncthreads();
    }
}

__device__ __forceinline__ void phase_final(Frame& F0) {
    Frame F = F0; asm volatile("" : "+v"(F.tid), "+v"(F.lane));
    const ArgsP ap = get_args();
    const int gw = F.vcu * NWAVES + F.wave, NGW = F.G * NWAVES;
    const bf16* xb = (const bf16*)(ap->ws + WS_XB); const pg8::ssq_t* ss = (const pg8::ssq_t*)(ap->ws + SS_OFF) + (size_t)12 * M; const float* gf = ap->in[18];
    f32x4 g[8];
#pragma unroll
    for (int j = 0; j < 4; ++j) { g[2 * j] = *(const f32x4*)(gf + 8 * F.lane + 512 * j); g[2 * j + 1] = *(const f32x4*)(gf + 8 * F.lane + 512 * j + 4); }
    for (int m = gw; m < M; m += NGW) { const float rs = __builtin_amdgcn_rsqf(pg8::ssq_dec(ss[m]) * (1.0f / DM) + EPS);
        const GAS v4u* xi = (const GAS v4u*)(xb + (size_t)m * DM) + F.lane; GAS f32x4* xo = (GAS f32x4*)(ap->out + (size_t)m * DM) + 2 * F.lane;
#pragma unroll
        for (int j = 0; j < 4; ++j) { const v4u x = xi[64 * j];
            xo[128 * j] = (f32x4){bf_lo(x.x), bf_hi(x.x), bf_lo(x.y), bf_hi(x.y)} * rs * g[2 * j];
            xo[128 * j + 1] = (f32x4){bf_lo(x.z), bf_hi(x.z), bf_lo(x.w), bf_hi(x.w)} * rs * g[2 * j + 1]; } }
}

__global__ void __launch_bounds__(NWAVES * 64, 2) mega_fwd(Args args) {
    extern __shared__ __attribute__((aligned(16))) unsigned char lds[];
    Frame F;
    F.lds = (LAS unsigned char*)lds;
    F.MISC = (volatile LAS unsigned*)(F.lds + MISC_OFF);
    F.tid = threadIdx.x; F.lane = F.tid & 63; F.wave = __builtin_amdgcn_readfirstlane(F.tid >> 6);
    F.G = gridDim.x; { const int bx = blockIdx.x; F.vcu = (F.G % 8 == 0) ? (bx % 8) * (F.G / 8) + bx / 8 : bx; }
    F.ctl = (gu32*)(get_args()->ws + WS_CTL);
    for (int u = F.tid; u < (LDS_BYTES - LDSCTL_OFF) / 4; u += NWAVES * 64) ((LAS unsigned*)(F.lds + LDSCTL_OFF))[u] = 0u;
    __syncthreads();
    XcdBarrier bar = xcd_barrier_post((unsigned*)(F.ctl + CW_BAR), F.MISC + 8);
#define GRID_BAR() xcd_barrier(bar)
#define WSP(T, off) ((T*)(ws + (off)))

#if W_UPFRONT
    for (int l = 0; l < DEPTH; ++l) phase_weights(F, l, l == 0, (size_t)l * WL_STRIDE);
    GRID_BAR();
#endif
    for (int l = 0; l < DEPTH; ++l) {
        const size_t wl = W_UPFRONT ? (size_t)l * WL_STRIDE : 0;
#if !W_UPFRONT
        phase_weights(F, l);
        GRID_BAR();
#endif
        for (int rep_ = 0; rep_ < PROBE_W; ++rep_) { phase_weights(F, l, false, wl); GRID_BAR(); }
        for (int half = 0; half < 2; ++half) {
            for (int rep_ = 0; rep_ < PROBE_BAR; ++rep_) GRID_BAR();
            if (half == 1) {
#ifndef SKIP_GIN
                for (int part = 0; part < 2; ++part) {
                  unsigned char* ws = get_args()->ws; pg8::ssq_t* SS = WSP(pg8::ssq_t, SS_OFF); const bool split = (F.G == 256);
                  pg8::Gemm g{WSP(bf16, WS_XB), (const bf16*)(ws + wl + WS_WIN), M, NIN, DM}; pg8::StaticOrder S; S.init(M, split ? NIN - 512 : NIN, F.G, (int)blockIdx.x);
                  if (part == 1) { S.tail = split ? 1 : 2; S.tail_vcu = F.vcu; S.pn_off = (NIN - 512) / 256; }
                  int rb_ = 0; const LAS float* rt_ = (part == 0) ? fill_rstab(F, SS + (size_t)(3 * l + 1) * M, 1.0f / DM, &rb_) : ((F.G == 256) ? (const LAS float*)(F.lds + RSTAB_OFF) : nullptr); if (part == 1) rb_ = (F.G == 256) ? 2048 * ((int)blockIdx.x & 7) : 0;
                  pg8::EpiProj E{WSP(bf16, WS_ACT), NIN, SS + (size_t)(3 * l + 1) * M, 1.0f / DM, SS + (size_t)(13 + l) * M, attn_body::C2, 4, 8, 2, 4, rt_, rb_, WSP(unsigned, NRM_OFF + (size_t)l * NRM_LAYER_BYTES)};
                  for (int rep_ = 0; rep_ < PROBE_GIN; ++rep_) { pg8::EpiProj E0 = E; E0.v_lo = 0; E0.v_hi = 0; pg8::gemm_phase<pg8::EpiProj, pg8::StaticOrder, true, true>(F.lds + RING_OFF, g, S, E0); GRID_BAR(); }
                  pg8::gemm_phase<pg8::EpiProj, pg8::StaticOrder, true, true>(F.lds + RING_OFF, g, S, E);
                  if (part == 0) GRID_BAR();
                }
#else
                GRID_BAR();
#endif
#ifndef SKIP_ATT
                { unsigned char* ws = get_args()->ws;
                  const attn_body::AttnTensors AT{WSP(const attn_body::bf16, WS_ACT), WSP(attn_body::bf16, WS_OB), WSP(const unsigned, NRM_OFF + (size_t)l * NRM_LAYER_BYTES)};
                  const attn_body::StaticOrder S((int)F.G, (int)blockIdx.x);
                  attn_body::attn_phase<attn_body::StaticOrder>((char*)lds + RING_OFF, AT, S);
                  for (int rep_ = 0; rep_ < PROBE_ATT; ++rep_) { GRID_BAR(); attn_body::attn_phase<attn_body::StaticOrder>((char*)lds + RING_OFF, AT, S); } }
#endif
                GRID_BAR();
#ifndef SKIP_MIX
                phase_mixer_post(F, l);
#endif
                GRID_BAR();
                for (int rep_ = 0; rep_ < PROBE_MIX; ++rep_) { phase_mixer_post(F, l); GRID_BAR(); }
#ifndef SKIP_GOUT
                { unsigned char* ws = get_args()->ws; pg8::ssq_t* SS = WSP(pg8::ssq_t, SS_OFF);
                  pg8::Gemm g{WSP(bf16, WS_YM), (const bf16*)(ws + wl + WS_WOUT), M, DM, DM}; pg8::StaticOrder S; S.init(M, DM, F.G, (int)blockIdx.x);
                  pg8::EpiResid E{nullptr, WSP(bf16, WS_XB), SS + (size_t)(3 * l + 2) * M, 1.0f, DM, 1};
                  for (int rep_ = 0; rep_ < PROBE_GOUT; ++rep_) { pg8::EpiResid E0 = E; E0.alpha = 0.f; E0.do_ss = 0; pg8::gemm_phase<pg8::EpiResid, pg8::StaticOrder, true, true>(F.lds + RING_OFF, g, S, E0); GRID_BAR(); }
                  pg8::gemm_phase<pg8::EpiResid, pg8::StaticOrder, true, true>(F.lds + RING_OFF, g, S, E); }
#endif
                GRID_BAR();
            }
#ifndef SKIP_GGU
            { unsigned char* ws = get_args()->ws; pg8::ssq_t* SS = WSP(pg8::ssq_t, SS_OFF);
              pg8::Gemm g{WSP(bf16, WS_XB), (const bf16*)(ws + wl + (half ? WS_WGU2 : WS_WGU1)), M, 2 * FF, DM}; pg8::StaticOrder S; S.init(M, 2 * FF, F.G, (int)blockIdx.x);
              int rb_ = 0; const LAS float* rt_ = fill_rstab(F, SS + (size_t)(3 * l + 2 * half) * M, 1.0f / DM, &rb_);
              pg8::EpiSwiGLU E{WSP(bf16, WS_ACT), FF, SS + (size_t)(3 * l + 2 * half) * M, 1.0f / DM, rt_, rb_};
#if PROBE_SPLIT
              S.i_hi = 6; pg8::gemm_phase<pg8::EpiSwiGLU, pg8::StaticOrder, true, true>(F.lds + RING_OFF, g, S, E); GRID_BAR(); S.i_lo = 6; S.i_hi = 1 << 30;
#endif
              pg8::gemm_phase<pg8::EpiSwiGLU, pg8::StaticOrder, true, true>(F.lds + RING_OFF, g, S, E);
              for (int rep_ = 0; rep_ < PROBE_GGU; ++rep_) { GRID_BAR(); pg8::gemm_phase<pg8::EpiSwiGLU, pg8::StaticOrder, true, true>(F.lds + RING_OFF, g, S, E); } }
#endif
            GRID_BAR();
#ifndef SKIP_GDN
            { const ArgsP ap = get_args(); unsigned char* ws = ap->ws; pg8::ssq_t* SS = WSP(pg8::ssq_t, SS_OFF);
              pg8::Gemm g{WSP(bf16, WS_ACT), (const bf16*)(ws + wl + (half ? WS_WD2 : WS_WD1)), M, DM, FF}; pg8::StaticOrder S; S.init(M, DM, F.G, (int)blockIdx.x);
              pg8::EpiResid E{(l == 0 && half == 0) ? ap->in[0] : (const float*)nullptr, WSP(bf16, WS_XB), SS + (size_t)(3 * l + 2 * half + 1) * M, 0.5f, DM, 1};
              for (int rep_ = 0; rep_ < PROBE_GDN; ++rep_) { pg8::EpiResid E0 = E; E0.alpha = 0.f; E0.do_ss = 0; pg8::gemm_phase<pg8::EpiResid, pg8::StaticOrder, true, true>(F.lds + RING_OFF, g, S, E0); GRID_BAR(); }
              pg8::gemm_phase<pg8::EpiResid, pg8::StaticOrder, true, true>(F.lds + RING_OFF, g, S, E); }
#endif
            GRID_BAR();
        }
    }
#ifndef SKIP_FIN
    phase_final(F);
#endif
}

extern "C" void kernel_launch(void* const* d_in, const int* in_sizes, int n_in, void* d_out, int out_size, void* d_ws, size_t ws_size, hipStream_t stream) {
    static int grid = 0;
    if (grid == 0) {
        if (n_in != 19 || in_sizes[0] != M * DM || out_size != M * DM || ws_size < WS_END) { fprintf(stderr, "kernel_launch: unexpected shapes / workspace (%zu < %zu)\n", ws_size, (size_t)WS_END); grid = -1; return; }
        int dev = 0, cus = 0, per_cu = 0;
        if (hipGetDevice(&dev) != hipSuccess || hipDeviceGetAttribute(&cus, hipDeviceAttributeMultiprocessorCount, dev) != hipSuccess) { grid = -1; return; }
        if (hipFuncSetAttribute((const void*)mega_fwd, hipFuncAttributeMaxDynamicSharedMemorySize, LDS_BYTES) != hipSuccess) { grid = -1; return; }
        if (hipOccupancyMaxActiveBlocksPerMultiprocessor(&per_cu, (const void*)mega_fwd, NWAVES * 64, LDS_BYTES) != hipSuccess || per_cu < 1) { fprintf(stderr, "kernel_launch: occupancy query says %d\n", per_cu); }
        (void)hipGetLastError();
        grid = cus;
    }
    if (grid < 0) return;
    if (hipMemsetAsync((char*)d_ws + WS_CTL, 0, CTL_ZERO_BYTES, stream) != hipSuccess) return;
    Args a{};
    for (int i = 0; i < 19; ++i) a.in[i] = (const float*)d_in[i];
    a.out = (float*)d_out; a.ws = (unsigned char*)d_ws;
    hipLaunchKernelGGL(mega_fwd, dim3(grid), dim3(NWAVES * 64), LDS_BYTES, stream, a);
}
```

```cpp
#include <hip/hip_runtime.h>
#include <cstdio>
#include <cstdint>
#ifndef PROBE_W
#define PROBE_W 0
#endif
#ifndef PROBE_ATT
#define PROBE_ATT 0
#endif
#ifndef PROBE_MIX
#define PROBE_MIX 0
#endif
#ifndef PROBE_GGU
#define PROBE_GGU 0
#endif
#ifndef PROBE_GDN
#define PROBE_GDN 0
#endif
#ifndef PROBE_GOUT
#define PROBE_GOUT 0
#endif
#ifndef PROBE_GIN
#define PROBE_GIN 0
#endif
#ifndef PROBE_BAR
#define PROBE_BAR 0
#endif
#ifndef PROBE_SPLIT
#define PROBE_SPLIT 0
#endif
#ifndef W_UPFRONT
#define W_UPFRONT 1
#endif
namespace pg8 {
#define PG8_LAS __attribute__((address_space(3)))
typedef unsigned short bf16_t;
typedef short bf16x8 __attribute__((ext_vector_type(8)));
typedef float f32x4 __attribute__((ext_vector_type(4)));
typedef unsigned u32x4 __attribute__((ext_vector_type(4)));
constexpr int BM = 256, BK = 64, HALF = 128, HTB = HALF * BK * 2  , STAGE_BYTES = 8 * HTB, NXCD = 8, WGM = 8;

__host__ __device__ __forceinline__ int lds_byte(int r, int c) { const int st = (r >> 4) * 2 + (c >> 5), rr = r & 15, cc = c & 31, ob = rr * 64 + cc * 2; return st * 1024 + (ob ^ (((ob >> 9) & 1) << 5)); }
__host__ __device__ __forceinline__ void stage_rc(int b, int& R, int& C) { const int st = b / 1024, sb = b % 1024, swz = sb ^ (((sb >> 9) & 1) << 5); R = (st >> 1) * 16 + swz / 64; C = (st & 1) * 32 + (swz % 64) / 2; }
__host__ __device__ __forceinline__ int perm32(int rho) { const int n = rho >> 4, i = rho & 15; return 8 * (i >> 2) + 4 * n + (i & 3); }

struct Unit { int pm, pn; };
struct Gemm { const bf16_t* A; const bf16_t* Bt; int M, N, K; };

struct StaticOrder {
    int nM, nN, nwg, G, c, i_lo = 0, i_hi = 1 << 30;
    int tail = 0, tail_vcu = 0, pn_off = 0;
    __host__ __device__ void init(int M, int N, int G_, int c_) { nM = M / BM; nN = N / BM; nwg = nM * nN; G = G_; c = c_; }
    __host__ __device__ bool next(int i, Unit& u) const {
        if (tail) { if (tail != 1 || i > 0 || (tail_vcu & 1)) return false; u.pm = tail_vcu >> 2; u.pn = pn_off + ((tail_vcu >> 1) & 1); return true; }
        if (i + i_lo >= i_hi) return false;
        const long L = (long)(i + i_lo) * G + c; if (L >= nwg) return false;
        int wgid = (int)L; { const int q = nwg / NXCD, r = nwg % NXCD, xcd = wgid % NXCD, off = wgid / NXCD; wgid = (xcd < r ? xcd * (q + 1) : r * (q + 1) + (xcd - r) * q) + off; }
        const int nig = WGM * nN, gid = wgid / nig, fm = gid * WGM, gsz = (nM - fm) < WGM ? (nM - fm) : WGM;
        u.pm = fm + ((wgid % nig) % gsz); u.pn = (wgid % nig) / gsz; return true;
    }
    __device__ __forceinline__ void a_ready(const Unit&) const {}
    __device__ __forceinline__ void done(const Unit&) const {}
};

__device__ __forceinline__ unsigned cvt_pk_bf16(float lo, float hi) { unsigned r; asm volatile("v_cvt_pk_bf16_f32 %0, %1, %2" : "=v"(r) : "v"(lo), "v"(hi)); return r; }
typedef float f32x2 __attribute__((ext_vector_type(2)));
constexpr float RMS_EPS = 1e-6f;
typedef unsigned long long ssq_t;
constexpr float SSQ_SCALE = 1073741824.0f, SSQ_INV = 1.0f / 1073741824.0f;
__device__ __forceinline__ ssq_t ssq_enc(float v) { return (ssq_t)(long long)(v * SSQ_SCALE); }
__device__ __forceinline__ float ssq_dec(ssq_t v) { return (float)(long long)v * SSQ_INV; }
__device__ __forceinline__ void ssq_add(ssq_t* p, float v) { (void)__hip_atomic_fetch_add(p, ssq_enc(v), __ATOMIC_RELAXED, __HIP_MEMORY_SCOPE_AGENT); }
struct EpiSwiGLU {
    static constexpr bool PERM = true, AFTER_DRAIN = false;
    bf16_t* O; int ldc; const ssq_t* ss; float inv_k;
    const PG8_LAS float* rstab; int rowbase;
    __device__ __forceinline__ void operator()(const f32x4 (&acc)[2][2][4][2], const Unit& u, int wr, int wc, int fr, int fq) const {
        const int row0 = u.pm * BM + wr * 64 + fr, col0 = u.pn * HALF + wc * 32 + 8 * fq;
        float rsv[8];
        if (rstab) {
#pragma unroll
            for (int i = 0; i < 8; ++i) rsv[i] = rstab[row0 - rowbase + (i >> 2) * HALF + (i & 3) * 16];
        } else { ssq_t sv[8];
#pragma unroll
            for (int i = 0; i < 8; ++i) sv[i] = ss[row0 + (i >> 2) * HALF + (i & 3) * 16];
#pragma unroll
            for (int i = 0; i < 8; ++i) rsv[i] = __builtin_amdgcn_rsqf(ssq_dec(sv[i]) * inv_k + RMS_EPS); }
#pragma unroll
        for (int ai = 0; ai < 2; ++ai)
#pragma unroll
            for (int m = 0; m < 4; ++m) { const int row = row0 + ai * HALF + m * 16; const float rs = rsv[ai * 4 + m];
                const float k1 = rs * -1.4426950408889634f, k2 = rs * rs; f32x2 o[4];
#pragma unroll
                for (int n = 0; n < 2; ++n)
#pragma unroll
                    for (int h = 0; h < 2; ++h) { const f32x2 g = (f32x2){acc[ai][0][m][n][2 * h], acc[ai][0][m][n][2 * h + 1]}, up = (f32x2){acc[ai][1][m][n][2 * h], acc[ai][1][m][n][2 * h + 1]};
                        const f32x2 t = g * k1; f32x2 e; e.x = __builtin_amdgcn_exp2f(t.x); e.y = __builtin_amdgcn_exp2f(t.y);
                        const f32x2 d = e + 1.0f; f32x2 r; r.x = __builtin_amdgcn_rcpf(d.x); r.y = __builtin_amdgcn_rcpf(d.y);
                        o[2 * n + h] = ((g * up) * k2) * r; }
                u32x4 w; w.x = cvt_pk_bf16(o[0].x, o[0].y); w.y = cvt_pk_bf16(o[1].x, o[1].y); w.z = cvt_pk_bf16(o[2].x, o[2].y); w.w = cvt_pk_bf16(o[3].x, o[3].y);
                *(u32x4*)(O + (size_t)row * ldc + col0) = w; }
    }
};
constexpr int NRM_K_WORD = 64 * 32;
struct EpiProj {
    static constexpr bool PERM = true, AFTER_DRAIN = false;
    bf16_t* O; int ldc; const ssq_t* ss; float inv_k; ssq_t* ssv; float qscale; int q_lo, q_hi, v_lo, v_hi;
    const PG8_LAS float* rstab; int rowbase;
    unsigned* nrm = nullptr;
    __device__ __forceinline__ void operator()(const f32x4 (&acc)[2][2][4][2], const Unit& u, int wr, int wc, int fr, int fq) const {
        const int row0 = u.pm * BM + wr * 64 + fr, col0 = u.pn * BM + wc * 32 + 8 * fq;
        const float cs = (u.pn >= q_lo && u.pn < q_hi) ? qscale : 1.0f; const bool isv = (u.pn >= v_lo && u.pn < v_hi);
        const bool isn = nrm && (u.pn >= q_lo && u.pn < 2 * q_hi - q_lo); float nmx0 = 0.f, nmx1 = 0.f;
        float rsv[8];
        if (rstab) {
#pragma unroll
            for (int i = 0; i < 8; ++i) rsv[i] = rstab[row0 - rowbase + (i >> 2) * HALF + (i & 3) * 16];
        } else { ssq_t sv[8];
#pragma unroll
            for (int i = 0; i < 8; ++i) sv[i] = ss[row0 + (i >> 2) * HALF + (i & 3) * 16];
#pragma unroll
            for (int i = 0; i < 8; ++i) rsv[i] = __builtin_amdgcn_rsqf(ssq_dec(sv[i]) * inv_k + RMS_EPS); }
#pragma unroll
        for (int ai = 0; ai < 2; ++ai)
#pragma unroll
            for (int m = 0; m < 4; ++m) { const int row = row0 + ai * HALF + m * 16; const float rs = rsv[ai * 4 + m] * cs; float sqb[2];
#pragma unroll
                for (int bj = 0; bj < 2; ++bj) { const f32x4 v0 = acc[ai][bj][m][0] * rs, v1 = acc[ai][bj][m][1] * rs;
                    sqb[bj] = (v0[0] * v0[0] + v0[1] * v0[1]) + (v0[2] * v0[2] + v0[3] * v0[3]) + (v1[0] * v1[0] + v1[1] * v1[1]) + (v1[2] * v1[2] + v1[3] * v1[3]);
                    u32x4 w; w.x = cvt_pk_bf16(v0[0], v0[1]); w.y = cvt_pk_bf16(v0[2], v0[3]); w.z = cvt_pk_bf16(v1[0], v1[1]); w.w = cvt_pk_bf16(v1[2], v1[3]);
                    *(u32x4*)(O + (size_t)row * ldc + col0 + bj * HALF) = w; }
                if (isv) { float sq = sqb[0] + sqb[1]; sq += __shfl_xor(sq, 16); sq += __shfl_xor(sq, 32); if (fq == 0) ssq_add(ssv + row, sq); }
                if (isn) { float a = sqb[0], b = sqb[1]; a += __shfl_xor(a, 16); b += __shfl_xor(b, 16); a += __shfl_xor(a, 32); b += __shfl_xor(b, 32);
                    nmx0 = fmaxf(nmx0, a); nmx1 = fmaxf(nmx1, b); } }
        if (isn) {
#pragma unroll
            for (int d = 1; d < 16; d <<= 1) { nmx0 = fmaxf(nmx0, __shfl_xor(nmx0, d)); nmx1 = fmaxf(nmx1, __shfl_xor(nmx1, d)); }
            const bool isq = u.pn < q_hi; const int g8 = (u.pn - (isq ? q_lo : q_hi)) * 8 + wc;
            unsigned* t = nrm + (isq ? (u.pm * 32) : (NRM_K_WORD + (u.pm >> 4) * 32)) + g8;
            if (fr == 0 && fq == 0) { (void)__hip_atomic_fetch_max(t, __float_as_uint(nmx0), __ATOMIC_RELAXED, __HIP_MEMORY_SCOPE_AGENT); (void)__hip_atomic_fetch_max(t + 4, __float_as_uint(nmx1), __ATOMIC_RELAXED, __HIP_MEMORY_SCOPE_AGENT); } }
    }
};
struct EpiResid {
    static constexpr bool PERM = true, AFTER_DRAIN = false;
    const float* xin_f32; bf16_t* xb; ssq_t* ss_out; float alpha; int ldc; int do_ss;
    __device__ __forceinline__ void operator()(const f32x4 (&acc)[2][2][4][2], const Unit& u, int wr, int wc, int fr, int fq) const {
        const int row0 = u.pm * BM + wr * 64 + fr, col0 = u.pn * BM + wc * 32 + 8 * fq;
#pragma unroll
        for (int ai = 0; ai < 2; ++ai)
#pragma unroll
            for (int m = 0; m < 4; ++m) { const int row = row0 + ai * HALF + m * 16; const size_t off = (size_t)row * ldc + col0; float sq = 0.f;
#pragma unroll
                for (int bj = 0; bj < 2; ++bj) { f32x4 b0, b1;
                    if (xin_f32) { b0 = *(const f32x4*)(xin_f32 + off + bj * HALF); b1 = *(const f32x4*)(xin_f32 + off + bj * HALF + 4); }
                    else { const u32x4 x = *(const u32x4*)(xb + off + bj * HALF);
                        b0 = (f32x4){__uint_as_float(x.x << 16), __uint_as_float(x.x & 0xffff0000u), __uint_as_float(x.y << 16), __uint_as_float(x.y & 0xffff0000u)};
                        b1 = (f32x4){__uint_as_float(x.z << 16), __uint_as_float(x.z & 0xffff0000u), __uint_as_float(x.w << 16), __uint_as_float(x.w & 0xffff0000u)}; }
                    const f32x4 v0 = b0 + acc[ai][bj][m][0] * alpha, v1 = b1 + acc[ai][bj][m][1] * alpha;
                    u32x4 w; w.x = cvt_pk_bf16(v0[0], v0[1]); w.y = cvt_pk_bf16(v0[2], v0[3]); w.z = cvt_pk_bf16(v1[0], v1[1]); w.w = cvt_pk_bf16(v1[2], v1[3]);
                    *(u32x4*)(xb + off + bj * HALF) = w;
                    const float r0 = __uint_as_float(w.x << 16), r1 = __uint_as_float(w.x & 0xffff0000u), r2 = __uint_as_float(w.y << 16), r3 = __uint_as_float(w.y & 0xffff0000u),
                                r4 = __uint_as_float(w.z << 16), r5 = __uint_as_float(w.z & 0xffff0000u), r6 = __uint_as_float(w.w << 16), r7 = __uint_as_float(w.w & 0xffff0000u);
                    sq += (r0 * r0 + r1 * r1) + (r2 * r2 + r3 * r3) + (r4 * r4 + r5 * r5) + (r6 * r6 + r7 * r7); }
                sq += __shfl_xor(sq, 16); sq += __shfl_xor(sq, 32); if (fq == 0 && do_ss) ssq_add(ss_out + row, sq);
                if (m & 1) asm volatile("" ::: "memory"); }
    }
};

template <class Epi, class Sched, bool ALIGN_EPI = false, bool SP2 = false>
__device__ __forceinline__ void gemm_phase(PG8_LAS unsigned char* lds, const Gemm g, const Sched& S, const Epi& E) {
    int tid_ = threadIdx.x; asm volatile("" : "+v"(tid_));
    const int tid = tid_, wid = __builtin_amdgcn_readfirstlane(tid >> 6), lane = tid & 63, wr = wid >> 2, wc = wid & 3, fr = lane & 15, fq = lane >> 4;
    const int K = g.K, nt = K / BK;
    unsigned voffA[2], voffB[2];
#pragma unroll
    for (int i = 0; i < 2; ++i) { int R, C; stage_rc(tid * 16 + i * 8192, R, C); const int Rb = Epi::PERM ? ((R & ~31) + perm32(R & 31)) : R;
        voffA[i] = (unsigned)(R * K + C) * 2u; voffB[i] = (unsigned)(Rb * K + C) * 2u; }
    const size_t kstep = (size_t)(BK * 2);
    const size_t hstep = (size_t)HALF * K * 2;
    const size_t tstep = 2 * hstep;
    const unsigned ldsw = (unsigned)wid * 1024u;
    const unsigned ldsbase = (unsigned)__builtin_amdgcn_readfirstlane((int)((unsigned)(uintptr_t)lds + (unsigned)wid * 1024u));
    const int aoff = lds_byte(wr * 64 + fr, fq * 8), boff = lds_byte(wc * 32 + fr, fq * 8);
#define PG8_SA(b, h) (((b) * 2 + (h)) * HTB)
#define PG8_SB(b, h) ((4 + (b) * 2 + (h)) * HTB)
#define PG8_STAGE(bufoff, gbase, voff) do { _Pragma("unroll") for (int _i = 0; _i < 2; ++_i) { \
        const unsigned long long _gb = (unsigned long long)(uintptr_t)(gbase); const unsigned _ld = ldsbase + (unsigned)((bufoff) + _i * 8192); \
        asm volatile("s_mov_b32 m0, %2\n\ts_nop 0\n\tglobal_load_lds_dwordx4 %0, %1" :: "v"((voff)[_i]), "s"(_gb), "s"(_ld) : "memory", "m0"); } } while (0)
#define PG8_LDA(dst, b, h) do { _Pragma("unroll") for (int m = 0; m < 4; ++m) _Pragma("unroll") for (int k = 0; k < 2; ++k) dst[m][k] = *(const PG8_LAS bf16x8*)(lds + PG8_SA(b, h) + aoff + m * 2048 + k * 1024); } while (0)
#define PG8_LDB(dst, b, h) do { _Pragma("unroll") for (int n = 0; n < 2; ++n) _Pragma("unroll") for (int k = 0; k < 2; ++k) dst[n][k] = *(const PG8_LAS bf16x8*)(lds + PG8_SB(b, h) + boff + n * 2048 + k * 1024); } while (0)
#define PG8_MMA(ai, bj, At, Bt) do { __builtin_amdgcn_s_setprio(1); _Pragma("unroll") for (int n = 0; n < 2; ++n) _Pragma("unroll") for (int m = 0; m < 4; ++m) _Pragma("unroll") for (int k = 0; k < 2; ++k) { \
        acc[ai][bj][m][n] = __builtin_amdgcn_mfma_f32_16x16x32_bf16(Bt[n][k], At[m][k], acc[ai][bj][m][n], 0, 0, 0); __builtin_amdgcn_sched_barrier(0); } __builtin_amdgcn_s_setprio(0); } while (0)
#define PG8_MFMA1(ai, bj, Bt, m, n, k) do { acc[ai][bj][m][n] = __builtin_amdgcn_mfma_f32_16x16x32_bf16(Bt[n][k], At[m][k], acc[ai][bj][m][n], 0, 0, 0); __builtin_amdgcn_sched_barrier(0); } while (0)
#define PG8_MFMA1Z(ai, bj, Bt, m, n, k) do { asm volatile("v_mfma_f32_16x16x32_bf16 %0, %1, %2, 0" : "+v"(acc[ai][bj][m][n]) : "v"(Bt[n][k]), "v"(At[m][k])); __builtin_amdgcn_sched_barrier(0); } while (0)
#define PG8_MMA2Z(ai) do { _Pragma("unroll") for (int m = 0; m < 4; ++m) { PG8_MFMA1Z(ai, 0, B0, m, 0, 0); PG8_MFMA1(ai, 0, B0, m, 0, 1); PG8_MFMA1Z(ai, 0, B0, m, 1, 1); PG8_MFMA1(ai, 0, B0, m, 1, 0); \
        PG8_MFMA1Z(ai, 1, B1, m, 0, 0); PG8_MFMA1(ai, 1, B1, m, 0, 1); PG8_MFMA1Z(ai, 1, B1, m, 1, 1); PG8_MFMA1(ai, 1, B1, m, 1, 0); } } while (0)
#define PG8_MMA2(ai) do { _Pragma("unroll") for (int m = 0; m < 4; ++m) { PG8_MFMA1(ai, 0, B0, m, 0, 0); PG8_MFMA1(ai, 0, B0, m, 0, 1); PG8_MFMA1(ai, 0, B0, m, 1, 1); PG8_MFMA1(ai, 0, B0, m, 1, 0); \
        PG8_MFMA1(ai, 1, B1, m, 0, 0); PG8_MFMA1(ai, 1, B1, m, 0, 1); PG8_MFMA1(ai, 1, B1, m, 1, 1); PG8_MFMA1(ai, 1, B1, m, 1, 0); } } while (0)
#define PG8_WAIT_V(n) asm volatile("s_waitcnt vmcnt(" #n ")" ::: "memory")
#define PG8_WAIT_L(n) asm volatile("s_waitcnt lgkmcnt(" #n ")" ::: "memory")
#define PG8_BAR __builtin_amdgcn_s_barrier()
#define PG8_SCHED __builtin_amdgcn_sched_barrier(0)
#define PG8_KITER_SP2(MZ) do { \
            PG8_LDB(B0, 0, 0); PG8_LDB(B1, 0, 1); PG8_SCHED; PG8_LDA(At, 0, 0); PG8_STAGE(PG8_SA(1, 1), a1 + hstep, voffA); \
            PG8_WAIT_V(8); PG8_WAIT_L(0); __builtin_amdgcn_s_setprio(1); PG8_BAR; PG8_MMA2##MZ(0); PG8_BAR; __builtin_amdgcn_s_setprio(0); PG8_SCHED; \
            PG8_LDA(At, 0, 1); PG8_STAGE(PG8_SB(0, 0), b2, voffB); PG8_STAGE(PG8_SB(0, 1), b2 + hstep, voffB); PG8_STAGE(PG8_SA(0, 0), a2, voffA); \
            PG8_WAIT_V(8); PG8_WAIT_L(0); __builtin_amdgcn_s_setprio(1); PG8_BAR; PG8_MMA2##MZ(1); PG8_BAR; __builtin_amdgcn_s_setprio(0); PG8_SCHED; \
            PG8_LDB(B0, 1, 0); PG8_LDB(B1, 1, 1); PG8_SCHED; PG8_LDA(At, 1, 0); PG8_STAGE(PG8_SA(0, 1), a2 + hstep, voffA); \
            PG8_WAIT_V(8); PG8_WAIT_L(0); __builtin_amdgcn_s_setprio(1); PG8_BAR; PG8_MMA2(0); PG8_BAR; __builtin_amdgcn_s_setprio(0); PG8_SCHED; \
            PG8_LDA(At, 1, 1); PG8_STAGE(PG8_SB(1, 0), b3, voffB); PG8_STAGE(PG8_SB(1, 1), b3 + hstep, voffB); PG8_STAGE(PG8_SA(1, 0), a3, voffA); \
            PG8_WAIT_V(8); PG8_WAIT_L(0); __builtin_amdgcn_s_setprio(1); PG8_BAR; PG8_MMA2(1); PG8_BAR; __builtin_amdgcn_s_setprio(0); PG8_SCHED; \
            } while (0)
    Unit cur, nxt; int ui = 0;
    if (!S.next(0, cur)) return;
    f32x4 acc[2][2][4][2];
#pragma unroll
    for (int a = 0; a < 2; ++a)
#pragma unroll
        for (int b = 0; b < 2; ++b)
#pragma unroll
            for (int m = 0; m < 4; ++m)
#pragma unroll
                for (int n = 0; n < 2; ++n) acc[a][b][m][n] = (f32x4){0.f, 0.f, 0.f, 0.f};
    bf16x8 At[4][2], B0[2][2], B1[2][2];
    const char* cA = (const char*)g.A + (size_t)cur.pm * tstep; const char* cB = (const char*)g.Bt + (size_t)cur.pn * tstep;
    S.a_ready(cur);
    if constexpr (SP2) {
        PG8_STAGE(PG8_SB(0, 0), cB, voffB); PG8_STAGE(PG8_SB(0, 1), cB + hstep, voffB); PG8_STAGE(PG8_SA(0, 0), cA, voffA); PG8_STAGE(PG8_SA(0, 1), cA + hstep, voffA);
        if (wr == 1) PG8_BAR;
        PG8_WAIT_V(2); PG8_BAR;
        PG8_STAGE(PG8_SB(1, 0), cB + kstep, voffB); PG8_STAGE(PG8_SA(1, 0), cA + kstep, voffA); PG8_STAGE(PG8_SB(1, 1), cB + hstep + kstep, voffB);
        PG8_WAIT_V(6); PG8_BAR;
    } else {
        PG8_STAGE(PG8_SB(0, 0), cB, voffB); PG8_STAGE(PG8_SA(0, 0), cA, voffA); PG8_STAGE(PG8_SB(0, 1), cB + hstep, voffB); PG8_STAGE(PG8_SA(0, 1), cA + hstep, voffA);
        if (wr == 1) PG8_BAR;
        PG8_WAIT_V(4); PG8_BAR;
        PG8_STAGE(PG8_SB(1, 0), cB + kstep, voffB); PG8_STAGE(PG8_SA(1, 0), cA + kstep, voffA); PG8_STAGE(PG8_SB(1, 1), cB + hstep + kstep, voffB);
        PG8_WAIT_V(6); PG8_BAR;
    }
    for (;;) {
        const bool has_next = S.next(ui + 1, nxt);
        const char* nA = has_next ? (const char*)g.A + (size_t)nxt.pm * tstep : cA; const char* nB = has_next ? (const char*)g.Bt + (size_t)nxt.pn * tstep : cB;
        if constexpr (SP2) {
            { const int t = 0;
            const bool last = (t == nt - 2);
            const char* a1 = cA + (size_t)(t + 1) * kstep;
            const char* a2 = last ? nA : cA + (size_t)(t + 2) * kstep; const char* b2 = last ? nB : cB + (size_t)(t + 2) * kstep;
            const char* a3 = a2 + kstep; const char* b3 = b2 + kstep;
            if (last && has_next) S.a_ready(nxt);
            PG8_KITER_SP2(Z); }
            for (int t = 2; t < nt; t += 2) {
            const bool last = (t == nt - 2);
            const char* a1 = cA + (size_t)(t + 1) * kstep;
            const char* a2 = last ? nA : cA + (size_t)(t + 2) * kstep; const char* b2 = last ? nB : cB + (size_t)(t + 2) * kstep;
            const char* a3 = a2 + kstep; const char* b3 = b2 + kstep;
            if (last && has_next) S.a_ready(nxt);
            PG8_KITER_SP2(); }
        } else {
        for (int t = 0; t < nt; t += 2) {
            const bool last = (t == nt - 2);
            const char* a1 = cA + (size_t)(t + 1) * kstep;
            const char* a2 = last ? nA : cA + (size_t)(t + 2) * kstep; const char* b2 = last ? nB : cB + (size_t)(t + 2) * kstep;
            const char* a3 = a2 + kstep; const char* b3 = b2 + kstep;
            if (last && has_next) S.a_ready(nxt);
            PG8_LDB(B0, 0, 0); PG8_SCHED; PG8_LDA(At, 0, 0); PG8_STAGE(PG8_SA(1, 1), a1 + hstep, voffA);
            PG8_WAIT_L(8); PG8_BAR; PG8_WAIT_L(0); PG8_MMA(0, 0, At, B0); PG8_BAR; PG8_SCHED;
            PG8_LDB(B1, 0, 1); PG8_STAGE(PG8_SB(0, 0), b2, voffB);
            PG8_BAR; PG8_WAIT_L(0); PG8_MMA(0, 1, At, B1); PG8_BAR;
            PG8_LDA(At, 0, 1); PG8_STAGE(PG8_SA(0, 0), a2, voffA);
            PG8_BAR; PG8_WAIT_L(0); PG8_MMA(1, 0, At, B0); PG8_BAR; PG8_SCHED;
            PG8_STAGE(PG8_SB(0, 1), b2 + hstep, voffB);
            PG8_WAIT_V(6); PG8_BAR; PG8_MMA(1, 1, At, B1); PG8_BAR;
            PG8_LDB(B0, 1, 0); PG8_SCHED; PG8_LDA(At, 1, 0); PG8_STAGE(PG8_SA(0, 1), a2 + hstep, voffA);
            PG8_WAIT_L(8); PG8_BAR; PG8_WAIT_L(0); PG8_MMA(0, 0, At, B0); PG8_BAR; PG8_SCHED;
            PG8_LDB(B1, 1, 1); PG8_STAGE(PG8_SB(1, 0), b3, voffB);
            PG8_BAR; PG8_WAIT_L(0); PG8_MMA(0, 1, At, B1); PG8_BAR;
            PG8_LDA(At, 1, 1); PG8_STAGE(PG8_SA(1, 0), a3, voffA);
            PG8_BAR; PG8_WAIT_L(0); PG8_MMA(1, 0, At, B0); PG8_BAR; PG8_SCHED;
            PG8_STAGE(PG8_SB(1, 1), b3 + hstep, voffB);
            PG8_WAIT_V(6); PG8_BAR; PG8_MMA(1, 1, At, B1); PG8_BAR;
        }
        }
        if constexpr (ALIGN_EPI) { if (wr == 0) PG8_BAR; }
        if constexpr (!Epi::AFTER_DRAIN) { E(acc, cur, wr, wc, fr, fq); S.done(cur); }
        if (!has_next) break;
        if constexpr (!SP2) {
#pragma unroll
        for (int a = 0; a < 2; ++a)
#pragma unroll
            for (int b = 0; b < 2; ++b)
#pragma unroll
                for (int m = 0; m < 4; ++m)
#pragma unroll
                    for (int n = 0; n < 2; ++n) acc[a][b][m][n] = (f32x4){0.f, 0.f, 0.f, 0.f};
        }
        cur = nxt; cA = nA; cB = nB; ++ui;
        if constexpr (ALIGN_EPI) { if (wr == 1) PG8_BAR; }
    }
    PG8_WAIT_V(0);
    if constexpr (!ALIGN_EPI) { if (wr == 0) PG8_BAR; }
    PG8_BAR;
    if constexpr (Epi::AFTER_DRAIN) { E.fused(acc, cur, wr, wc, fr, fq, lds, wid, lane); S.done(cur); }
#undef PG8_SA
#undef PG8_SB
#undef PG8_STAGE
#undef PG8_LDA
#undef PG8_LDB
#undef PG8_MMA
#undef PG8_MMA2
#undef PG8_MMA2Z
#undef PG8_KITER_SP2
#undef PG8_MFMA1Z
#undef PG8_MFMA1
#undef PG8_WAIT_V
#undef PG8_WAIT_L
#undef PG8_BAR
#undef PG8_SCHED
}
}
#include <hip/hip_bf16.h>
#include <cmath>
namespace attn_body {
using bf16=__hip_bfloat16;
using bf16x8=__attribute__((ext_vector_type(8)))short;
using s16x4=__attribute__((ext_vector_type(4)))short;
using f32x16=__attribute__((ext_vector_type(16)))float;
using u32x4=__attribute__((ext_vector_type(4)))unsigned;
constexpr int SEQ=4096,D=64,DM=5632,DMO=2048;
constexpr int NW=8,QBLK=32,QB=QBLK*NW,KVBLK=64,NQB=SEQ/QB;
constexpr int ATTN_PITCH=DM, ATTN_UNIT_ROWS=QB;
constexpr float LOG2E=1.4426950408889634f;
__device__ __forceinline__ int crow(int r,int hi){return (r&3)+8*(r>>2)+4*hi;}
#define SBAR() __builtin_amdgcn_sched_barrier(0)
__device__ __forceinline__ void cmask(f32x16&p0,f32x16&p1,int jb,int qrel,int hi){
  const float NEG=-INFINITY; int kb=64*jb+4*hi;
  #pragma unroll
  for(int r=0;r<16;++r){int kv=kb+(r&3)+8*(r>>2); if(kv>qrel)p0[r]=NEG; if(kv+32>qrel)p1[r]=NEG;}
}

constexpr int NSLOT=3, SLOTB=8192, VSLOTB=16384;
constexpr int LDS_K=0, LDS_V=NSLOT*SLOTB, LDS_WS=LDS_V+NSLOT*VSLOTB, LDS_OST=LDS_WS+NW*64*4, LDS_BYTES=LDS_OST+NW*4096;
constexpr float C2=0.125f*1.4426950408889634f;
__device__ __forceinline__ void glds16(const void*gsrc,unsigned lds_dst){unsigned keep;
  asm volatile("s_mov_b32 %0, m0\n\ts_mov_b32 m0, %2\n\ts_nop 0\n\tglobal_load_lds_dwordx4 %1, off\n\ts_mov_b32 m0, %0":"=&s"(keep):"v"(gsrc),"s"(lds_dst):"memory");}
__device__ __forceinline__ float max3f(float a,float b,float c){float r;asm("v_max3_f32 %0, %1, %2, %3":"=v"(r):"v"(a),"v"(b),"v"(c));return r;}
__device__ __forceinline__ float max2f(float a,float b){float r;asm("v_max_f32_e32 %0, %1, %2":"=v"(r):"v"(a),"v"(b));return r;}
__device__ __forceinline__ float fadd_s(float a,float b){float r;asm("v_add_f32_e32 %0, %1, %2":"=v"(r):"v"(a),"v"(b));return r;}
__device__ __forceinline__ float fsub_s(float a,float b){float r;asm("v_sub_f32_e32 %0, %1, %2":"=v"(r):"v"(a),"v"(b));return r;}
typedef float f32x2_t __attribute__((ext_vector_type(2))); typedef __bf16 bf16x2_t __attribute__((ext_vector_type(2)));
__device__ __forceinline__ unsigned cvtpk_s(float lo,float hi){f32x2_t v={lo,hi};bf16x2_t b=__builtin_convertvector(v,bf16x2_t);return __builtin_bit_cast(unsigned,b);}
#define WAIT_BAR(N) asm volatile("s_waitcnt vmcnt(" #N ") lgkmcnt(0)\n\ts_barrier":::"memory")

__device__ __forceinline__ void qkt(f32x16&p0,f32x16&p1,const char*Kslot,const bf16x8*qr,bf16x8 ka0,bf16x8 ka1,bf16x8 qa,int r32,int hi){
  const char*kb=Kslot+hi*1024+r32*16;
  const f32x16 z=f32x16{};
  p0=__builtin_amdgcn_mfma_f32_32x32x16_bf16(ka0,qa,z,0,0,0);p1=__builtin_amdgcn_mfma_f32_32x32x16_bf16(ka1,qa,z,0,0,0);
  #pragma unroll
  for(int d0=0;d0<4;++d0){
    const bf16x8 b0=*reinterpret_cast<const bf16x8*>(kb+d0*2048);
    const bf16x8 b1=*reinterpret_cast<const bf16x8*>(kb+d0*2048+512);
    p0=__builtin_amdgcn_mfma_f32_32x32x16_bf16(b0,qr[d0],p0,0,0,0);p1=__builtin_amdgcn_mfma_f32_32x32x16_bf16(b1,qr[d0],p1,0,0,0);}
}
typedef __attribute__((address_space(3))) const char* lds_cptr;
typedef short v4i16_t __attribute__((ext_vector_type(4)));
__device__ __forceinline__ void kload8(bf16x8*kf,lds_cptr kp){
  kf[0]=*(const __attribute__((address_space(3))) bf16x8*)(kp);      kf[1]=*(const __attribute__((address_space(3))) bf16x8*)(kp+512);
  kf[2]=*(const __attribute__((address_space(3))) bf16x8*)(kp+2048); kf[3]=*(const __attribute__((address_space(3))) bf16x8*)(kp+2560);
  kf[4]=*(const __attribute__((address_space(3))) bf16x8*)(kp+4096); kf[5]=*(const __attribute__((address_space(3))) bf16x8*)(kp+4608);
  kf[6]=*(const __attribute__((address_space(3))) bf16x8*)(kp+6144); kf[7]=*(const __attribute__((address_space(3))) bf16x8*)(kp+6656);
}
__device__ __forceinline__ void kload2(bf16x8*kf,lds_cptr kp,int j){ kf[2*j]=*(const __attribute__((address_space(3))) bf16x8*)(kp+j*2048); kf[2*j+1]=*(const __attribute__((address_space(3))) bf16x8*)(kp+j*2048+512); }
__device__ __forceinline__ s16x4 vtr(lds_cptr p){ return __builtin_bit_cast(s16x4,__builtin_amdgcn_ds_read_tr16_b64_v4i16((__attribute__((address_space(3))) v4i16_t*)p)); }
__device__ __forceinline__ float rowmax(const f32x16&p0,const f32x16&p1){
  float a=max3f(p0[0],p0[1],p1[0]),b=max3f(p0[2],p0[3],p1[1]);a=max3f(a,p1[2],p1[3]);
  #pragma unroll
  for(int r=4;r<16;r+=4){a=max3f(a,p0[r],p0[r+1]);b=max3f(b,p0[r+2],p0[r+3]);a=max3f(a,p1[r],p1[r+1]);b=max3f(b,p1[r+2],p1[r+3]);}
  const float m=max2f(a,b);
  auto rr=__builtin_amdgcn_permlane32_swap(__float_as_uint(m),__float_as_uint(m),false,false);
  return max2f(__uint_as_float(rr[0]),__uint_as_float(rr[1]));
}
__device__ __forceinline__ void pv(f32x16*o,int vb,bf16x8 pa0,bf16x8 pa1,bf16x8 pa2,bf16x8 pa3){
  #pragma unroll
  for(int d0=0;d0<4;++d0){s16x4 lo[4],hi[4];
    #pragma unroll
    for(int ks=0;ks<4;++ks){
      asm volatile("ds_read_b64_tr_b16 %0,%1 offset:%c2":"=&v"(lo[ks]):"v"(vb),"i"(d0*4096+ks*1024):"memory");
      asm volatile("ds_read_b64_tr_b16 %0,%1 offset:%c2":"=&v"(hi[ks]):"v"(vb),"i"(d0*4096+ks*1024+512):"memory");}
    asm volatile("s_waitcnt lgkmcnt(0)":::"memory");SBAR();
    #define PK(k) (bf16x8){lo[k][0],lo[k][1],lo[k][2],lo[k][3],hi[k][0],hi[k][1],hi[k][2],hi[k][3]}
    o[d0]=__builtin_amdgcn_mfma_f32_32x32x16_bf16(pa0,PK(0),o[d0],0,0,0);
    o[d0]=__builtin_amdgcn_mfma_f32_32x32x16_bf16(pa1,PK(1),o[d0],0,0,0);
    o[d0]=__builtin_amdgcn_mfma_f32_32x32x16_bf16(pa2,PK(2),o[d0],0,0,0);
    o[d0]=__builtin_amdgcn_mfma_f32_32x32x16_bf16(pa3,PK(3),o[d0],0,0,0);
    #undef PK
  }
}

#ifndef ATTN_STORE16
#define ATTN_STORE16(p,v) (*(u32x4*)(p)=(v))
#endif
template<int THRL> __device__ __forceinline__ void attn_unit(int qb,const bf16*Qh,const bf16*__restrict__ Kh,const bf16*__restrict__ Vh,bf16*Oh,float sl2,char*shm,int nte,float bnd,float inv64c){
  int tid_=threadIdx.x; asm volatile("":"+v"(tid_)); const int tid=tid_,lane=tid&63,r32=lane&31,hi=lane>>5; const int wid=__builtin_amdgcn_readfirstlane(tid>>6);
  const int q0=qb*QB;
  const bf16*Qw=Qh+(long)(q0+wid*QBLK)*DM;
  const unsigned lds0=(unsigned)(uintptr_t)shm;
  float*wsf=(float*)(shm+LDS_WS)+wid*64;
  const bf16*ksrc=Kh+(long)lane*DM+wid*8;
  const bf16*vsrc=Vh+(long)(16*(wid&3)+(lane>>2))*DM+(wid>>2)*32+(lane&3)*8;
  const unsigned kdst=lds0+LDS_K+wid*1024, vdst=lds0+LDS_V+wid*1024;
  #define DMA_K(t,slot) glds16(ksrc+(long)(NTF-1-(t))*KVBLK*DM,(unsigned)__builtin_amdgcn_readfirstlane(kdst+(slot)))
  #define DMA_V(t,slot) do{ glds16(vsrc+(long)(NTF-1-(t))*KVBLK*DM,(unsigned)__builtin_amdgcn_readfirstlane(vdst+2*(slot))); glds16(vsrc+(long)(NTF-1-(t))*KVBLK*DM+64,(unsigned)__builtin_amdgcn_readfirstlane(vdst+2*(slot)+8192)); }while(0)
  const char*Kbase=shm+LDS_K; bf16x8 kf[8];
  const lds_cptr shm3=(lds_cptr)shm; const lds_cptr kp0=shm3+LDS_K+hi*1024+r32*16; const lds_cptr vp0=shm3+LDS_V+((lane>>4)&1)*32+(lane&3)*8+(4*hi+((lane&15)>>2))*64; const int vb0=(int)(unsigned)(uintptr_t)vp0;
  const int NTF=(q0+QB)/KVBLK;
  int NT=__builtin_amdgcn_readfirstlane(nte<NTF?nte:NTF);
  DMA_K(0,0);DMA_V(0,0);DMA_K(1,SLOTB);
  bf16x8 qr[4];
  #pragma unroll
  for(int d0=0;d0<4;++d0)qr[d0]=*reinterpret_cast<const bf16x8*>(&Qw[(long)r32*DM+d0*16+hi*8]);
  float mhat=0.f,l_reg=0.f;f32x16 o[4];o[0]=f32x16{};o[1]=f32x16{};o[2]=f32x16{};o[3]=f32x16{};
  const int qrel=wid*QBLK+r32;
  #define CMASK(P0,P1,t) do{int jb_=3-(t); if(jb_>=0)cmask(P0,P1,jb_,qrel,hi);}while(0)
  const unsigned hm=hi?0u:0xffffffffu;
  const unsigned c_pk=cvtpk_s(sl2,0.f)&0xffffu; const float c_hif=__uint_as_float(c_pk<<16); const unsigned c_pl=cvtpk_s(sl2-c_hif,0.f)&0xffffu;
  const unsigned qa_c=((c_pl^0x8000u)<<16)|(c_pk^0x8000u);
  u32x4 qaw=(u32x4){qa_c,qa_c,0x80008000u,0u};
  const unsigned ka_j0=hm&(cvtpk_s((float)(63-r32),0.f)&0xffffu)*0x10001u, ka_j1=hm&(cvtpk_s((float)(31-r32),0.f)&0xffffu)*0x10001u, ka_one=hm&0x3f803f80u;
  #define KA_D0(t) (hm&((__float_as_uint((float)(64*(t)))>>16)*0x10001u))
  #define KAF(d0,j) __builtin_bit_cast(bf16x8,(u32x4){(d0),(j),ka_one,0u})
  #define QAF() __builtin_bit_cast(bf16x8,qaw)
  #define SET_REF(m,out) do{ const unsigned h_=cvtpk_s((m),0.f)&0xffffu; const float hf_=__uint_as_float(h_<<16); const unsigned l_=cvtpk_s((m)-hf_,0.f)&0xffffu; \
      out=hf_+__uint_as_float(l_<<16); qaw[2]=((l_^0x8000u)<<16)|(h_^0x8000u); }while(0)
  bool started=false;
  bool resc=false;
  #define START(P0,P1) do{ const float rm=rowmax(P0,P1); resc=false; started=(rm>-INFINITY); \
    { float dl=0.f; if(started){ SET_REF(rm,dl); } mhat=dl; \
      _Pragma("unroll") for(int r=0;r<16;++r){P0[r]=fsub_s(P0[r],dl);P1[r]=fsub_s(P1[r],dl);} } \
    _Pragma("unroll") for(int r=0;r<16;++r)P0[r]=__builtin_amdgcn_exp2f(P0[r]); }while(0)
  #define RESC() do{ if(resc){ asm volatile("s_waitcnt lgkmcnt(0)":::"memory"); \
      _Pragma("unroll") for(int d_=0;d_<4;++d_) _Pragma("unroll") for(int r=0;r<16;++r)o[d_][r]*=wsf[crow(r,hi)]; } }while(0)
  f32x16 pA0,pA1,pB0,pB1;
  int sl_prev=0,sl_cur=0,sl_next=SLOTB;
  #define ROT() do{sl_prev=sl_cur;sl_cur=sl_next;sl_next=(sl_next==(NSLOT-1)*SLOTB)?0:sl_next+SLOTB;}while(0)
  DMA_K(2,2*SLOTB);
  WAIT_BAR(4);
  qkt(pA0,pA1,Kbase,qr,KAF(0u,ka_j0),KAF(0u,ka_j1),QAF(),r32,hi);asm volatile("s_nop 15\n\ts_nop 7":"+v"(pA0),"+v"(pA1));CMASK(pA0,pA1,0);
  START(pA0,pA1);
  _Pragma("unroll") for(int r=0;r<16;++r)pA1[r]=__builtin_amdgcn_exp2f(pA1[r]);
  WAIT_BAR(0);
  DMA_K(3,0);DMA_V(1,SLOTB);
  ROT();
  kload8(kf,kp0+sl_cur);
  WAIT_BAR(3);
  s16x4 vlo[8],vhi[8]; u32x4 pw0,pw1,pw2,pw3;
  #define PKW(P,B) cvtpk_s(P[B],P[B+1])
  #define PAF(k) __builtin_bit_cast(bf16x8,pw##k)
  #define VFR(i) (bf16x8){vlo[i][0],vlo[i][1],vlo[i][2],vlo[i][3],vhi[i][0],vhi[i][1],vhi[i][2],vhi[i][3]}
  #define PIN(x) asm volatile("":"+v"(x))
  #define MX3(a,b,c) __builtin_fmaxf(__builtin_fmaxf((a),(b)),(c))
  #define GAPA(MF,A0,A1,A2,A3,W0,W1,PW) do{ MF; sacc+=A0; sacc+=A1; sacc+=A2; sacc+=A3; PIN(sacc); W0; W1; PIN(PW); SBAR(); }while(0)
  #define EX(v) __builtin_amdgcn_exp2f(v)
  #define GAPB(MF,X,B) do{ MF; X[B]=EX(X[B]); X[B+1]=EX(X[B+1]); PIN(X); SBAR(); }while(0)
  #define VRDX(i,db,ks) do{ vlo[i]=vtr(vp_+((db)*4096+(ks)*1024)); vhi[i]=vtr(vp_+((db)*4096+(ks)*1024+512)); }while(0)
  #define VRD(i) VRDX(i,(i)>>2,(i)&3)
  #define VRD2(i) do{ VRDX(i,((i)>>2)+2,(i)&3); SBAR(); }while(0)
  #define KRD(G,j) do{ if(G){ kload2(kf,kp0+sl_next,j); SBAR(); } }while(0)
  #define ROWMAX(C0,C1,rm) do{ float a=MX3(C0[0],C0[1],C1[0]),b=MX3(C0[2],C0[3],C1[1]); a=MX3(a,C1[2],C1[3]); \
      _Pragma("unroll") for(int r=4;r<16;r+=4){a=MX3(a,C0[r],C0[r+1]);b=MX3(b,C0[r+2],C0[r+3]);a=MX3(a,C1[r],C1[r+1]);b=MX3(b,C1[r+2],C1[r+3]);} \
      rm=__builtin_fmaxf(a,b); { auto rr=__builtin_amdgcn_permlane32_swap(__float_as_uint(rm),__float_as_uint(rm),false,false); rm=__builtin_fmaxf(__uint_as_float(rr[0]),__uint_as_float(rr[1])); } }while(0)
  #define DECIDE(C0,C1,rm) do{ resc=false; const bool fin_=(rm>-INFINITY); \
      if(__builtin_expect(__any(started?(rm>(float)THRL):fin_),0)){ const float want=mhat+(started?__builtin_fmaxf(rm,0.f):(fin_?rm:0.f)); float nref; SET_REF(want,nref); \
        const float dl=nref-mhat; mhat=nref; \
        _Pragma("unroll") for(int r=0;r<16;++r){C0[r]-=dl;C1[r]-=dl;} \
        const float f=started?__builtin_amdgcn_exp2f(-dl):1.f; l_reg*=f; if(hi==0)wsf[r32]=f; resc=true; } \
      started=started||fin_; }while(0)
  bool dead=false;
  #define LSTEP(C0,C1,t) do{ SBAR(); \
    { const unsigned kd0_=KA_D0(t); const f32x16 z_=f32x16{}; \
      C0=__builtin_amdgcn_mfma_f32_32x32x16_bf16(KAF(kd0_,ka_j0),QAF(),z_,0,0,0); C1=__builtin_amdgcn_mfma_f32_32x32x16_bf16(KAF(kd0_,ka_j1),QAF(),z_,0,0,0); } \
    C0=__builtin_amdgcn_mfma_f32_32x32x16_bf16(kf[0],qr[0],C0,0,0,0); C1=__builtin_amdgcn_mfma_f32_32x32x16_bf16(kf[1],qr[0],C1,0,0,0); \
    C0=__builtin_amdgcn_mfma_f32_32x32x16_bf16(kf[2],qr[1],C0,0,0,0); C1=__builtin_amdgcn_mfma_f32_32x32x16_bf16(kf[3],qr[1],C1,0,0,0); \
    C0=__builtin_amdgcn_mfma_f32_32x32x16_bf16(kf[4],qr[2],C0,0,0,0); C1=__builtin_amdgcn_mfma_f32_32x32x16_bf16(kf[5],qr[2],C1,0,0,0); \
    C0=__builtin_amdgcn_mfma_f32_32x32x16_bf16(kf[6],qr[3],C0,0,0,0); C1=__builtin_amdgcn_mfma_f32_32x32x16_bf16(kf[7],qr[3],C1,0,0,0); \
    SBAR(); kload2(kf,kp0+sl_next,0); kload2(kf,kp0+sl_next,1); kload2(kf,kp0+sl_next,2); kload2(kf,kp0+sl_next,3); SBAR();     \
    DMA_K((t)+3,sl_cur); DMA_V((t)+1,sl_next); \
    resc=false; \
    { float rm; ROWMAX(C0,C1,rm); \
      if(__builtin_expect(!__all(rm<-160.f),0)){ DECIDE(C0,C1,rm); \
        _Pragma("unroll") for(int r=0;r<16;++r){C0[r]=EX(C0[r]);C1[r]=EX(C1[r]);} dead=false; } } \
    SBAR(); \
    }while(0)
  #define STEP(C0,C1,P0,P1,t,GK,GV,GL) do{ SBAR(); \
    const lds_cptr vp_=vp0+2*sl_prev; \
    { const unsigned kd0_=KA_D0(t); const f32x16 z_=f32x16{}; \
      C0=__builtin_amdgcn_mfma_f32_32x32x16_bf16(KAF(kd0_,ka_j0),QAF(),z_,0,0,0); C1=__builtin_amdgcn_mfma_f32_32x32x16_bf16(KAF(kd0_,ka_j1),QAF(),z_,0,0,0); } \
    VRD(0); SBAR(); float sacc=(P0[0]+P0[1]); \
    GAPA(C0=__builtin_amdgcn_mfma_f32_32x32x16_bf16(kf[0],qr[0],C0,0,0,0), P0[2],P0[3],P0[4],P0[5],     pw0[0]=PKW(P0,0), pw0[1]=PKW(P0,2), pw0); \
    VRD(4); SBAR(); GAPA(C1=__builtin_amdgcn_mfma_f32_32x32x16_bf16(kf[1],qr[0],C1,0,0,0), P0[6],P0[7],P0[8],P0[9],     pw0[2]=PKW(P0,4), pw0[3]=PKW(P0,6), pw0); \
    VRD(1); SBAR(); GAPA(C0=__builtin_amdgcn_mfma_f32_32x32x16_bf16(kf[2],qr[1],C0,0,0,0),   P0[10],P0[11],P0[12],P0[13], pw1[0]=PKW(P0,8), pw1[1]=PKW(P0,10), pw1); \
    VRD(5); SBAR(); GAPA(C1=__builtin_amdgcn_mfma_f32_32x32x16_bf16(kf[3],qr[1],C1,0,0,0),   P0[14],P0[15],P1[0],P1[1],   pw1[2]=PKW(P0,12),pw1[3]=PKW(P0,14), pw1); \
    VRD(2); SBAR(); GAPA(C0=__builtin_amdgcn_mfma_f32_32x32x16_bf16(kf[4],qr[2],C0,0,0,0),   P1[2],P1[3],P1[4],P1[5],     pw2[0]=PKW(P1,0), pw2[1]=PKW(P1,2), pw2); \
    VRD(6); SBAR(); GAPA(C1=__builtin_amdgcn_mfma_f32_32x32x16_bf16(kf[5],qr[2],C1,0,0,0),   P1[6],P1[7],P1[8],P1[9],     pw2[2]=PKW(P1,4), pw2[3]=PKW(P1,6), pw2); \
    VRD(3); SBAR(); GAPA(C0=__builtin_amdgcn_mfma_f32_32x32x16_bf16(kf[6],qr[3],C0,0,0,0),   P1[10],P1[11],P1[12],P1[13], pw3[0]=PKW(P1,8), pw3[1]=PKW(P1,10), pw3); \
    VRD(7); SBAR(); GAPA(C1=__builtin_amdgcn_mfma_f32_32x32x16_bf16(kf[7],qr[3],C1,0,0,0),   P1[14],P1[15],0.f,0.f,       pw3[2]=PKW(P1,12),pw3[3]=PKW(P1,14), pw3); \
    l_reg+=sacc; \
    if(GK){DMA_K((t)+3,sl_cur);} if(GV){DMA_V((t)+1,sl_next);} \
    CMASK(C0,C1,t); \
    { float rm; ROWMAX(C0,C1,rm); DECIDE(C0,C1,rm); dead=__all(rm<-160.f); } \
    SBAR(); \
    GAPB(o[0]=__builtin_amdgcn_mfma_f32_32x32x16_bf16(PAF(0),VFR(0),o[0],0,0,0), C0,0); \
    VRD2(0); GAPB(o[1]=__builtin_amdgcn_mfma_f32_32x32x16_bf16(PAF(0),VFR(4),o[1],0,0,0), C0,2); \
    VRD2(4); GAPB(o[0]=__builtin_amdgcn_mfma_f32_32x32x16_bf16(PAF(1),VFR(1),o[0],0,0,0), C0,4); \
    VRD2(1); GAPB(o[1]=__builtin_amdgcn_mfma_f32_32x32x16_bf16(PAF(1),VFR(5),o[1],0,0,0), C0,6); \
    VRD2(5); GAPB(o[0]=__builtin_amdgcn_mfma_f32_32x32x16_bf16(PAF(2),VFR(2),o[0],0,0,0), C0,8); \
    VRD2(2); GAPB(o[1]=__builtin_amdgcn_mfma_f32_32x32x16_bf16(PAF(2),VFR(6),o[1],0,0,0), C0,10); \
    VRD2(6); GAPB(o[0]=__builtin_amdgcn_mfma_f32_32x32x16_bf16(PAF(3),VFR(3),o[0],0,0,0), C0,12); \
    VRD2(3); GAPB(o[1]=__builtin_amdgcn_mfma_f32_32x32x16_bf16(PAF(3),VFR(7),o[1],0,0,0), C0,14); \
    VRD2(7); GAPB(o[2]=__builtin_amdgcn_mfma_f32_32x32x16_bf16(PAF(0),VFR(0),o[2],0,0,0), C1,0); \
    KRD(GL,0); GAPB(o[3]=__builtin_amdgcn_mfma_f32_32x32x16_bf16(PAF(0),VFR(4),o[3],0,0,0), C1,2); \
    KRD(GL,1); GAPB(o[2]=__builtin_amdgcn_mfma_f32_32x32x16_bf16(PAF(1),VFR(1),o[2],0,0,0), C1,4); \
    KRD(GL,2); GAPB(o[3]=__builtin_amdgcn_mfma_f32_32x32x16_bf16(PAF(1),VFR(5),o[3],0,0,0), C1,6); \
    KRD(GL,3); GAPB(o[2]=__builtin_amdgcn_mfma_f32_32x32x16_bf16(PAF(2),VFR(2),o[2],0,0,0), C1,8); \
    GAPB(o[3]=__builtin_amdgcn_mfma_f32_32x32x16_bf16(PAF(2),VFR(6),o[3],0,0,0), C1,10); \
    GAPB(o[2]=__builtin_amdgcn_mfma_f32_32x32x16_bf16(PAF(3),VFR(3),o[2],0,0,0), C1,12); \
    GAPB(o[3]=__builtin_amdgcn_mfma_f32_32x32x16_bf16(PAF(3),VFR(7),o[3],0,0,0), C1,14); \
    }while(0)
  int t=1;
  #define ENDW(tt) do{ if((tt)+3<NT){WAIT_BAR(3);} else if((tt)+2<NT){WAIT_BAR(2);} else {WAIT_BAR(0);} }while(0)
  for(;t<5&&t+1<NT;t+=2){
    STEP(pB0,pB1,pA0,pA1,t,(t+3<NT),(t+1<NT),(t+1<NT));       ENDW(t);   RESC(); ROT();
    STEP(pA0,pA1,pB0,pB1,t+1,(t+4<NT),(t+2<NT),(t+2<NT));     ENDW(t+1); RESC(); ROT();
  }
  if(NT>=10){
    float v_=-mhat;
    _Pragma("unroll") for(int o_=1;o_<32;o_<<=1)v_=__builtin_fmaxf(v_,__shfl_xor(v_,o_));
    if(lane==0)wsf[48]=v_;
    asm volatile("s_waitcnt lgkmcnt(0)\n\ts_barrier":::"memory");
    const float*wsx_=(const float*)(shm+LDS_WS); float mx_=wsx_[48];
    _Pragma("unroll") for(int w_=1;w_<NW;++w_)mx_=__builtin_fmaxf(mx_,wsx_[w_*64+48]);
    const float tb_=(bnd+mx_)*inv64c; int n2_=(tb_<1000.f)?2*((int)(tb_*0.5f))+2:4096; n2_=n2_<8?8:n2_;
    NT=__builtin_amdgcn_readfirstlane(n2_<NT?n2_:NT);
  }
  #undef CMASK
  #define CMASK(P0,P1,t) do{}while(0)
  while(t+5<NT){
    STEP(pB0,pB1,pA0,pA1,t,true,true,true);     WAIT_BAR(3); RESC(); ROT();
    STEP(pA0,pA1,pB0,pB1,t+1,true,true,true);   WAIT_BAR(3); RESC(); ROT();
    t+=2; if(dead) break;
  }
  if(dead){
    for(;t+5<NT;++t){
      dead=true; LSTEP(pA0,pA1,t); WAIT_BAR(3); RESC();
      if(!dead){ float sacc=pA0[0]+pA0[1]; _Pragma("unroll") for(int r=2;r<16;++r)sacc+=pA0[r]; _Pragma("unroll") for(int r=0;r<16;++r)sacc+=pA1[r]; l_reg+=sacc;
        pw0=(u32x4){PKW(pA0,0),PKW(pA0,2),PKW(pA0,4),PKW(pA0,6)};pw1=(u32x4){PKW(pA0,8),PKW(pA0,10),PKW(pA0,12),PKW(pA0,14)};pw2=(u32x4){PKW(pA1,0),PKW(pA1,2),PKW(pA1,4),PKW(pA1,6)};pw3=(u32x4){PKW(pA1,8),PKW(pA1,10),PKW(pA1,12),PKW(pA1,14)};
        SBAR(); pv(o,vb0+2*sl_cur,PAF(0),PAF(1),PAF(2),PAF(3)); }
      ROT();
    }
    dead=true; pA0=f32x16{}; pA1=f32x16{}; pB0=f32x16{}; pB1=f32x16{};
    if(!(t&1)){   }
  }
  #undef CMASK
  #define CMASK(P0,P1,t) do{int jb_=3-(t); if(jb_>=0)cmask(P0,P1,jb_,qrel,hi);}while(0)
  for(;t+1<NT;t+=2){
    STEP(pB0,pB1,pA0,pA1,t,(t+3<NT),(t+1<NT),(t+1<NT));       ENDW(t);   RESC(); ROT();
    STEP(pA0,pA1,pB0,pB1,t+1,(t+4<NT),(t+2<NT),(t+2<NT));     ENDW(t+1); RESC(); ROT();
  }
  STEP(pB0,pB1,pA0,pA1,NT-1,false,false,false); RESC();
  { float sacc=pB0[0]+pB0[1]; _Pragma("unroll") for(int r=2;r<16;++r)sacc+=pB0[r]; _Pragma("unroll") for(int r=0;r<16;++r)sacc+=pB1[r]; l_reg+=sacc;
    pw0=(u32x4){PKW(pB0,0),PKW(pB0,2),PKW(pB0,4),PKW(pB0,6)};pw1=(u32x4){PKW(pB0,8),PKW(pB0,10),PKW(pB0,12),PKW(pB0,14)};pw2=(u32x4){PKW(pB1,0),PKW(pB1,2),PKW(pB1,4),PKW(pB1,6)};pw3=(u32x4){PKW(pB1,8),PKW(pB1,10),PKW(pB1,12),PKW(pB1,14)};
    SBAR(); pv(o,vb0+2*sl_cur,PAF(0),PAF(1),PAF(2),PAF(3)); }
  #undef PKW
  #undef PAF
  #undef VFR
  #undef PIN
  #undef MX3
  #undef GAPA
  #undef GAPB
  #undef EX
  #undef VRD
  #undef VRD2
  #undef VRDX
  #undef KRD
  #undef STEP
  #undef LSTEP
  #undef ROWMAX
  #undef DECIDE
  #undef ENDW
  {auto rr=__builtin_amdgcn_permlane32_swap(__float_as_uint(l_reg),__float_as_uint(l_reg),false,false);l_reg=__uint_as_float(rr[0])+__uint_as_float(rr[1]);}
  if(hi==0)wsf[32+r32]=l_reg;asm volatile("s_waitcnt lgkmcnt(0)":::"memory");
  float rli[16];
  #pragma unroll
  for(int r=0;r<16;++r)rli[r]=__builtin_amdgcn_rcpf(wsf[32+crow(r,hi)]);
  bf16*Ow=Oh+(long)(q0+wid*QBLK)*DMO;
  { bf16*stg=(bf16*)(shm+LDS_OST)+wid*2048;
    #pragma unroll
    for(int pass=0;pass<2;++pass){
      #pragma unroll
      for(int r=0;r<16;++r){const int orow=crow(r,hi);
        #pragma unroll
        for(int d0=0;d0<2;++d0)stg[orow*64+d0*32+r32]=__float2bfloat16(o[2*pass+d0][r]*rli[r]);}
      asm volatile("s_waitcnt lgkmcnt(0)":::"memory");
      #pragma unroll
      for(int i=0;i<4;++i){const int row=i*8+(lane>>3),ch=lane&7; const u32x4 v=*(const u32x4*)(stg+row*64+ch*8); ATTN_STORE16(Ow+(long)row*DMO+pass*64+ch*8,v);}
      asm volatile("s_waitcnt lgkmcnt(0)":::"memory"); } }
  asm volatile("s_waitcnt lgkmcnt(0)\n\ts_barrier":::"memory");
  #undef DMA_K
  #undef DMA_V
  #undef CMASK
  #undef KA_D0
  #undef KAF
  #undef QAF
  #undef SET_REF
  #undef START
  #undef RESC
  #undef ROT
}
constexpr int ATTN_LDS_BYTES=LDS_BYTES;
struct AttnTensors { const bf16* P; bf16* O; const unsigned* nrm; };
struct AttnUnit { int combo; int qb; };
__device__ const unsigned char ATT_TAB[256] = {123, 45, 21, 112, 255, 255, 255, 255, 127, 55, 50, 65, 255, 255, 255, 255, 75, 44, 20, 64, 255, 255, 255, 255, 79, 118, 115, 49, 255, 255, 255, 255, 122, 68, 29, 15, 255, 255, 255, 255, 126, 119, 67, 14, 255, 255, 255, 255, 74, 52, 28, 13, 255, 255, 255, 255, 78, 71, 51, 12, 255, 255, 255, 255, 121, 69, 27, 11, 255, 255, 255, 255, 125, 59, 114, 113, 255, 255, 255, 255, 73, 53, 26, 10, 255, 255, 255, 255, 77, 58, 66, 97, 255, 255, 255, 255, 120, 70, 25, 9, 255, 255, 255, 255, 124, 63, 41, 8, 255, 255, 255, 255, 72, 54, 24, 7, 255, 255, 255, 255, 76, 62, 40, 6, 255, 255, 255, 255, 107, 47, 23, 96, 255, 255, 255, 255, 111, 102, 39, 80, 255, 255, 255, 255, 91, 46, 22, 48, 255, 255, 255, 255, 95, 86, 38, 32, 255, 255, 255, 255, 106, 100, 34, 81, 255, 255, 255, 255, 110, 103, 37, 16, 255, 255, 255, 255, 90, 84, 31, 33, 255, 255, 255, 255, 94, 87, 36, 0, 255, 255, 255, 255, 105, 85, 30, 17, 255, 255, 255, 255, 109, 57, 99, 5, 255, 255, 255, 255, 89, 116, 83, 4, 255, 255, 255, 255, 93, 56, 35, 3, 255, 255, 255, 255, 104, 117, 98, 19, 255, 255, 255, 255, 108, 61, 43, 2, 255, 255, 255, 255, 88, 101, 82, 18, 255, 255, 255, 255, 92, 60, 42, 1, 255, 255, 255, 255};
struct StaticOrder {
  int vcu, G;
  __device__ __forceinline__ explicit StaticOrder(int grid,int block):vcu((grid%8==0)?(block%8)*(grid/8)+block/8:block),G(grid){}
  __device__ __forceinline__ bool next(int i,AttnUnit&u)const{
    if(G==256){ if(i>=8)return false; const int g=vcu>>5, c=vcu&31; const int e=__builtin_amdgcn_readfirstlane((int)ATT_TAB[((g&1)*16+(c&15))*8+i]); if(e==255)return false;
      u.combo=(((g>>1)*8+(e>>4))<<1)|(c>>4); u.qb=e&15; return true; }
    const int L=i*G+vcu; if(L>=64*16)return false; u.combo=L>>4; u.qb=L&15; return true; }
};
template<class Sched,int THRL=8> __device__ __forceinline__ void attn_phase(char*lds,const AttnTensors&T,const Sched&S){
  AttnUnit u;
  for(int i=0;S.next(i,u);++i){
    const int m=u.combo&1, h=(u.combo>>1)&7, b=u.combo>>4;
    const bf16*rowp=T.P+(long)b*SEQ*DM;
    const float sl2=LOG2E*__builtin_amdgcn_exp2f(-(float)(h+1));
    int nte; float bnd, inv64c;
    { const int hm=2*h+m; const unsigned*qt=T.nrm+(b*16+u.qb)*32+2*hm, *kt=T.nrm+64*32+b*32+2*hm;
      const float q2=__uint_as_float(__hip_atomic_load(qt,__ATOMIC_RELAXED,__HIP_MEMORY_SCOPE_AGENT))+__uint_as_float(__hip_atomic_load(qt+1,__ATOMIC_RELAXED,__HIP_MEMORY_SCOPE_AGENT));
      const float k2=__uint_as_float(__hip_atomic_load(kt,__ATOMIC_RELAXED,__HIP_MEMORY_SCOPE_AGENT))+__uint_as_float(__hip_atomic_load(kt+1,__ATOMIC_RELAXED,__HIP_MEMORY_SCOPE_AGENT));
      const float B=__builtin_sqrtf(q2*k2);
      const float tb=((170.f+2.04f*B)/(0.999f*sl2)+255.f)*(1.f/64.f);
      nte=(tb<1000.f)?2*((int)(tb*0.5f))+2:4096;
      nte=__builtin_amdgcn_readfirstlane(nte);
      bnd=162.f+1.02f*B; inv64c=1.f/(64.f*0.999f*sl2); }
    attn_unit<THRL>(u.qb, rowp+1024+(2*h+m)*64, rowp+2048+(2*h+m)*64, rowp+3072+h*128, T.O+(long)b*SEQ*DMO+m*1024+h*128, sl2, lds, nte, bnd, inv64c); }
}
#undef SBAR
#undef WAIT_BAR
}
#define GAS __attribute__((address_space(1)))
#define LAS __attribute__((address_space(3)))
typedef unsigned short bf16;
typedef unsigned v4u __attribute__((ext_vector_type(4)));
typedef float f32x4 __attribute__((ext_vector_type(4)));
typedef short bf16x8 __attribute__((ext_vector_type(8)));
typedef GAS unsigned gu32;
typedef GAS unsigned long long gu64;
#define RLX_AGENT __ATOMIC_RELAXED, __HIP_MEMORY_SCOPE_AGENT
#define LDS_WAIT() asm volatile("s_waitcnt lgkmcnt(0)" ::: "memory")
#define VM_WAIT() asm volatile("s_waitcnt vmcnt(0)" ::: "memory")
__device__ __forceinline__ unsigned long long rt() { return __builtin_amdgcn_s_memrealtime(); }
__device__ __forceinline__ unsigned f2bf(float f) { unsigned u = __builtin_bit_cast(unsigned, f); return (u + 0x7fffu + ((u >> 16) & 1u)) >> 16; }
__device__ __forceinline__ unsigned pk2(float lo, float hi) { return f2bf(lo) | (f2bf(hi) << 16); }

#define XB_TMO      128
#define XB_XCNT(j)  (256  + 64 * (j))
#define XB_XSUB(j)  (1280 + 64 * (j))
#define XB_XGEN(j)  (2304 + 64 * (j))
#define XB_TOP      3328
#define XB_TOPGEN   3392
#define XCD_BAR_WORDS 3456
#define XB_SPIN_CAP (1u << 18)

__device__ __forceinline__ unsigned xb_ld(unsigned* p)              { return __hip_atomic_load(p, __ATOMIC_RELAXED, __HIP_MEMORY_SCOPE_AGENT); }
__device__ __forceinline__ unsigned xb_add(unsigned* p, unsigned v) { return __hip_atomic_fetch_add(p, v, __ATOMIC_RELAXED, __HIP_MEMORY_SCOPE_AGENT); }
__device__ __forceinline__ unsigned xb_xcc_id() { return (unsigned)__builtin_amdgcn_s_getreg((3 << 11) | 20) & 0xFu; }
#define XB_SPIN(cond, bar) do { unsigned _sp = 0; while (cond) { __builtin_amdgcn_s_sleep(1); \
    if ((++_sp & 255u) == 0u) { if (xb_ld(&(bar)[XB_TMO])) break; if (_sp > XB_SPIN_CAP) { atomicAdd(&(bar)[XB_TMO], 1u); break; } } } } while (0)

struct XcdBarrier {
    unsigned* bar; unsigned x;
    volatile LAS unsigned* st;
};

__device__ __forceinline__ XcdBarrier xcd_barrier_post(unsigned* bar, volatile LAS unsigned* st) {
    XcdBarrier b; b.bar = bar; b.x = xb_xcc_id(); b.st = st;
    if (threadIdx.x == 0) (void)xb_add(&bar[XB_XCNT(b.x)], 1u);
    return b;
}
__device__ __forceinline__ void xcd_barrier_complete(unsigned* bar, unsigned x, unsigned& nloc, unsigned& nx) {
    const unsigned G = gridDim.x * gridDim.y * gridDim.z;
    unsigned sum, cnt, mine, sp = 0u;
    for (;;) {
        sum = 0u; cnt = 0u; mine = 0u;
#pragma unroll
        for (unsigned j = 0; j < 16; ++j) { const unsigned c = xb_ld(&bar[XB_XCNT(j)]); sum += c; cnt += (c > 0u) ? 1u : 0u; mine = (j == x) ? c : mine; }
        if (sum == G) break;
        __builtin_amdgcn_s_sleep(1);
        if ((++sp & 255u) == 0u) { if (xb_ld(&bar[XB_TMO])) break; if (sp > XB_SPIN_CAP) { atomicAdd(&bar[XB_TMO], 1u); break; } }
    }
    nloc = mine > 0u ? mine : 1u; nx = cnt > 0u ? cnt : 1u;
}

__device__ __forceinline__ void xcd_barrier(const XcdBarrier& b) {
    asm volatile("s_waitcnt vmcnt(0)" ::: "memory");
    __syncthreads();
    if (threadIdx.x == 0) {
        unsigned* bar = b.bar; unsigned bx_ = b.x;
        asm volatile("" : "+s"(bar), "+s"(bx_));
        __builtin_amdgcn_s_waitcnt(0);
        unsigned nloc = b.st[0], nx = b.st[1];
        if (nloc == 0u) { xcd_barrier_complete(bar, bx_, nloc, nx); b.st[0] = nloc; b.st[1] = nx; }
        const unsigned old = xb_add(&bar[XB_XSUB(bx_)], 1u);
        const unsigned gen = old / nloc;
        if (old + 1u == (gen + 1u) * nloc) {
            __builtin_amdgcn_fence(__ATOMIC_RELEASE, "agent");
            asm volatile("s_waitcnt vmcnt(0)" ::: "memory");
            const unsigned og = xb_add(&bar[XB_TOP], 1u);
            const unsigned tg = og / nx;
            if (og + 1u == (tg + 1u) * nx) xb_add(&bar[XB_TOPGEN], 1u);
            else XB_SPIN(xb_ld(&bar[XB_TOPGEN]) == tg, bar);
            __builtin_amdgcn_fence(__ATOMIC_ACQUIRE, "agent");
            xb_add(&bar[XB_XGEN(bx_)], 1u);
            asm volatile("s_waitcnt vmcnt(0)" ::: "memory");
        } else {
            XB_SPIN(xb_ld(&bar[XB_XGEN(bx_)]) == gen, bar);
            __builtin_amdgcn_fence(__ATOMIC_ACQUIRE, "agent");
            asm volatile("s_waitcnt vmcnt(0)" ::: "memory");
        }
    }
    __syncthreads();
}

constexpr int NWAVES = 8;
struct Frame {
    LAS unsigned char* lds;
    volatile LAS unsigned* MISC;
    gu32* ctl;
    int tid, lane, wave;
    int vcu, G;
};
__device__ __forceinline__ float wave_sum(float v) {
#pragma unroll
    for (int o = 1; o < 64; o <<= 1) v += __shfl_xor(v, o);
    return v;
}
__device__ __forceinline__ float bf_lo(unsigned w) { return __uint_as_float(w << 16); }
__device__ __forceinline__ float bf_hi(unsigned w) { return __uint_as_float(w & 0xffff0000u); }

__device__ __forceinline__ void w_transpose_item(const float* W, int K, int N, const float* gain, bf16* WT, int k0, int n0, int dst_row0, LAS float* scr, int lane) {
    const GAS float* src = (const GAS float*)W + (size_t)(k0 + (lane >> 5)) * N + n0 + (lane & 31);
    float w[32];
#pragma unroll
    for (int i = 0; i < 32; ++i) w[i] = __builtin_nontemporal_load(src + (size_t)(2 * i) * N);
    const int c = lane & 7;
    f32x4 g0 = (f32x4){1.f, 1.f, 1.f, 1.f}, g1 = g0;
    if (gain) { g0 = *(const GAS f32x4*)(gain + k0 + 8 * c); g1 = *(const GAS f32x4*)(gain + k0 + 8 * c + 4); }
#pragma unroll
    for (int i = 0; i < 32; ++i) scr[(2 * i + (lane >> 5)) * 33 + (lane & 31)] = w[i];
    LDS_WAIT(); asm volatile("" ::: "memory");
#pragma unroll
    for (int j = 0; j < 4; ++j) { const int n = (lane >> 3) + 8 * j; const LAS float* s = scr + (8 * c) * 33 + n;
        v4u o; o.x = pg8::cvt_pk_bf16(s[0 * 33] * g0.x, s[1 * 33] * g0.y); o.y = pg8::cvt_pk_bf16(s[2 * 33] * g0.z, s[3 * 33] * g0.w);
        o.z = pg8::cvt_pk_bf16(s[4 * 33] * g1.x, s[5 * 33] * g1.y); o.w = pg8::cvt_pk_bf16(s[6 * 33] * g1.z, s[7 * 33] * g1.w);
        *(GAS v4u*)(WT + (size_t)(dst_row0 + n) * K + k0 + 8 * c) = o; }
    LDS_WAIT(); asm volatile("" ::: "memory");
}

constexpr int DM = 2048, NB = 4, SEQ = 4096, M = NB * SEQ, DEPTH = 4, FF = 5632, NIN = 5632, WA = 512, WBW = 1024, WC = 512;
constexpr float EPS = 1e-6f;
constexpr size_t MiB = 1u << 20;
constexpr size_t WS_CTL = 0, CTL_ZERO_BYTES = 4 * MiB;
constexpr int CW_BAR = 4096;
constexpr size_t NRM_OFF = 3 * MiB, NRM_LAYER_BYTES = 16384;
constexpr size_t SS_OFF = 64 * 1024;
static_assert(CW_BAR * 4 + XCD_BAR_WORDS * 4 <= SS_OFF && SS_OFF + 17 * (size_t)M * 8 <= NRM_OFF && NRM_OFF + 4 * NRM_LAYER_BYTES <= CTL_ZERO_BYTES && (pg8::NRM_K_WORD + 4 * 32) * 4 <= (int)NRM_LAYER_BYTES, "ctl map");
constexpr size_t WS_WGU1 = 4 * MiB, WS_WD1 = WS_WGU1 + 44 * MiB, WS_WIN = WS_WD1 + 22 * MiB, WS_WOUT = WS_WIN + 22 * MiB, WS_WGU2 = WS_WOUT + 8 * MiB, WS_WD2 = WS_WGU2 + 44 * MiB;
constexpr size_t WL_STRIDE = 162 * MiB;
constexpr size_t WS_XB = WS_WGU1 + 4 * WL_STRIDE;
constexpr size_t WS_ACT = WS_XB + 64 * MiB;
constexpr size_t WS_OB = WS_ACT + 176 * MiB;
constexpr size_t WS_YM = WS_OB + 64 * MiB;
constexpr size_t WS_END = WS_YM + 64 * MiB;
static_assert((size_t)FF * 2 * DM * 2 == 44 * MiB && (size_t)M * FF * 2 == 176 * MiB, "sizes");
constexpr int RING_OFF = 0, RING_BYTES = 131072;
constexpr int LDSCTL_OFF = RING_BYTES, MISC_OFF = LDSCTL_OFF + 320;
constexpr int LDS_BYTES = 147456;
constexpr int RSTAB_OFF = RING_BYTES + 1024;

struct Args { const float* in[19]; float* out; unsigned char* ws; };
typedef const __attribute__((address_space(4))) Args* ArgsP;
__device__ __forceinline__ ArgsP get_args() { ArgsP p = (ArgsP)__builtin_amdgcn_kernarg_segment_ptr(); asm volatile("" : "+s"(p)); return p; }

__device__ __forceinline__ const LAS float* fill_rstab(Frame& F, const pg8::ssq_t* ss, float inv_k, int* rowbase) {
    if (F.G != 256) { *rowbase = 0; return nullptr; }
    LAS float* tab = (LAS float*)(F.lds + RSTAB_OFF); const int base = 2048 * ((int)blockIdx.x & 7); *rowbase = base;
    int t_ = threadIdx.x; asm volatile("" : "+v"(t_));
#pragma unroll
    for (int i = 0; i < 4; ++i) tab[t_ + 512 * i] = __builtin_amdgcn_rsqf(pg8::ssq_dec(ss[base + t_ + 512 * i]) * inv_k + pg8::RMS_EPS);
    __syncthreads();
    return tab;
}

__device__ __forceinline__ void phase_weights(Frame& F0, int l_in, bool do_x = true, size_t dst_shift = 0) {
    int l = l_in; asm volatile("" : "+s"(l));
    Frame F = F0; asm volatile("" : "+v"(F.tid), "+v"(F.lane));
    const ArgsP ap = get_args();
    LAS float* scr = (LAS float*)(F.lds + RING_OFF + F.wave * 16384);
    const int gw = F.vcu * NWAVES + F.wave, NGW = F.G * NWAVES;
    unsigned char* ws = ap->ws + dst_shift;
    constexpr int I_BIG = (DM / 64) * (FF / 32);
    constexpr int I_OUT = (DM / 64) * (DM / 32);
    constexpr int NITEMS = 7 * I_BIG + I_OUT;
    const size_t wbig = (size_t)l * DM * FF;
    for (int it = gw; it < NITEMS; it += NGW) {
        const int which = it / I_BIG, r = it % I_BIG;
        if (which == 0 || which == 1 || which == 4 || which == 5) {
            const int f2 = which >= 4, up = which & 1;
            const float* W = ap->in[(f2 ? 15 : 2) + up] + wbig; const float* g = ap->in[f2 ? 14 : 1] + (size_t)l * DM;
            bf16* WT = (bf16*)(ws + (f2 ? WS_WGU2 : WS_WGU1));
            const int nblk = FF / 32, kb = r / nblk, nb = r % nblk, n0 = 32 * nb;
            w_transpose_item(W, DM, FF, g, WT, 64 * kb, n0, (n0 / 128) * 256 + (n0 % 128) + up * 128, scr, F.lane);
        } else if (which == 2 || which == 6) {
            const int f2 = which == 6;
            const float* W = ap->in[f2 ? 17 : 4] + wbig; bf16* WT = (bf16*)(ws + (f2 ? WS_WD2 : WS_WD1));
            const int nblk = DM / 32, kb = r / nblk, nb = r % nblk;
            w_transpose_item(W, FF, DM, nullptr, WT, 64 * kb, 32 * nb, 32 * nb, scr, F.lane);
        } else if (which == 3) {
            const float* W = ap->in[6] + wbig; const float* g = ap->in[5] + (size_t)l * DM; bf16* WT = (bf16*)(ws + WS_WIN);
            const int nblk = NIN / 32, kb = r / nblk, nb = r % nblk;
            w_transpose_item(W, DM, NIN, g, WT, 64 * kb, 32 * nb, 32 * nb, scr, F.lane);
        } else {
            const float* W = ap->in[13] + (size_t)l * DM * DM; bf16* WT = (bf16*)(ws + WS_WOUT);
            const int nblk = DM / 32, kb = r / nblk, nb = r % nblk;
            w_transpose_item(W, DM, DM, nullptr, WT, 64 * kb, 32 * nb, 32 * nb, scr, F.lane);
        }
    }
    if (l == 0 && do_x) {
        const float* x = ap->in[0]; bf16* xb = (bf16*)(ws + WS_XB); pg8::ssq_t* ss0 = (pg8::ssq_t*)(ws + SS_OFF);
        for (int m = gw; m < M; m += NGW) {
            const GAS f32x4* xr = (const GAS f32x4*)(x + (size_t)m * DM) + F.lane; GAS unsigned long long* o8 = (GAS unsigned long long*)(xb + (size_t)m * DM) + F.lane;
            float s = 0.f;
#pragma unroll
            for (int j = 0; j < 8; ++j) { const f32x4 v = xr[64 * j]; s += (v.x * v.x + v.y * v.y) + (v.z * v.z + v.w * v.w);
                o8[64 * j] = (unsigned long long)pk2(v.x, v.y) | ((unsigned long long)pk2(v.z, v.w) << 32); }
            s = wave_sum(s); if (F.lane == 0) ss0[m] = pg8::ssq_enc(s);
        }
    }
}

__device__ __forceinline__ void phase_mixer_post(Frame& F0, int l_in) {
    int l = l_in; asm volatile("" : "+s"(l));
    Frame F = F0; asm volatile("" : "+v"(F.tid), "+v"(F.lane));
    const ArgsP ap = get_args();
    unsigned char* ws = ap->ws;
    const bf16* P = (const bf16*)(ws + WS_ACT); const bf16* OB = (const bf16*)(ws + WS_OB); bf16* YM = (bf16*)(ws + WS_YM);
    const int gw = F.vcu * NWAVES + F.wave, NGW = F.G * NWAVES, lane = F.lane;
    const float* lq = ap->in[10] + (size_t)l * 4 * 64;
    const float s01 = wave_sum(lq[lane] * lq[64 + lane]), s23 = wave_sum(lq[128 + lane] * lq[192 + lane]);
    const float lam_init = 0.8f - 0.6f * __expf(-0.3f * (float)l);
    const float lam = __expf(s01) - __expf(s23) + lam_init, oml = 1.0f - lam_init;
    {
        const float* gsub = ap->in[11] + (size_t)l * 128; const float* wcv = ap->in[12] + (size_t)l * 3 * WC;
        float gs[16]; { const int c0 = (lane & 7) * 16;
#pragma unroll
            for (int i = 0; i < 16; ++i) gs[i] = gsub[c0 + i] * oml; }
        float w0[8], w1[8], w2[8]; { const int c = lane * 8;
#pragma unroll
            for (int i = 0; i < 8; ++i) { w0[i] = wcv[c + i]; w1[i] = wcv[WC + c + i]; w2[i] = wcv[2 * WC + c + i]; } }
        for (int row = gw; row < M; row += NGW) {
            { const v4u* p1 = (const v4u*)(OB + (size_t)row * 2048 + lane * 16); const v4u* p2 = (const v4u*)(OB + (size_t)row * 2048 + 1024 + lane * 16);
              const v4u a0 = p1[0], a1 = p1[1], b0 = p2[0], b1 = p2[1];
              const unsigned aw[8] = {a0.x, a0.y, a0.z, a0.w, a1.x, a1.y, a1.z, a1.w}, bw[8] = {b0.x, b0.y, b0.z, b0.w, b1.x, b1.y, b1.z, b1.w};
              float d[16]; float s = 0.f;
#pragma unroll
              for (int i = 0; i < 8; ++i) { d[2 * i] = bf_lo(aw[i]) - lam * bf_lo(bw[i]); d[2 * i + 1] = bf_hi(aw[i]) - lam * bf_hi(bw[i]); s += d[2 * i] * d[2 * i] + d[2 * i + 1] * d[2 * i + 1]; }
              s += __shfl_xor(s, 1); s += __shfl_xor(s, 2); s += __shfl_xor(s, 4);
              const float rs = __builtin_amdgcn_rsqf(s * (1.0f / 128.0f) + EPS);
              v4u o0, o1;
              o0.x = pk2(d[0] * rs * gs[0], d[1] * rs * gs[1]); o0.y = pk2(d[2] * rs * gs[2], d[3] * rs * gs[3]); o0.z = pk2(d[4] * rs * gs[4], d[5] * rs * gs[5]); o0.w = pk2(d[6] * rs * gs[6], d[7] * rs * gs[7]);
              o1.x = pk2(d[8] * rs * gs[8], d[9] * rs * gs[9]); o1.y = pk2(d[10] * rs * gs[10], d[11] * rs * gs[11]); o1.z = pk2(d[12] * rs * gs[12], d[13] * rs * gs[13]); o1.w = pk2(d[14] * rs * gs[14], d[15] * rs * gs[15]);
              v4u* yo = (v4u*)(YM + (size_t)row * 2048 + WA + lane * 16); yo[0] = o0; yo[1] = o1; }
            { const int t = row & (SEQ - 1); const bf16* pr = P + (size_t)row * NIN + lane * 8;
              const v4u bg = *(const v4u*)(pr + 4096), cg0 = *(const v4u*)(pr + 4608), xc0 = *(const v4u*)(pr + 5120);
              v4u cg1 = (v4u){0u, 0u, 0u, 0u}, xc1 = cg1, cg2 = cg1, xc2 = cg1;
              if (t >= 1) { cg1 = *(const v4u*)(pr - NIN + 4608); xc1 = *(const v4u*)(pr - NIN + 5120); }
              if (t >= 2) { cg2 = *(const v4u*)(pr - 2 * NIN + 4608); xc2 = *(const v4u*)(pr - 2 * NIN + 5120); }
              const unsigned bgw[4] = {bg.x, bg.y, bg.z, bg.w}, c0w[4] = {cg0.x, cg0.y, cg0.z, cg0.w}, x0w[4] = {xc0.x, xc0.y, xc0.z, xc0.w},
                             c1w[4] = {cg1.x, cg1.y, cg1.z, cg1.w}, x1w[4] = {xc1.x, xc1.y, xc1.z, xc1.w}, c2w[4] = {cg2.x, cg2.y, cg2.z, cg2.w}, x2w[4] = {xc2.x, xc2.y, xc2.z, xc2.w};
              unsigned ow[4];
#pragma unroll
              for (int i = 0; i < 4; ++i) {
                  const float ylo = bf_lo(bgw[i]) * (w0[2 * i] * (bf_lo(c2w[i]) * bf_lo(x2w[i])) + w1[2 * i] * (bf_lo(c1w[i]) * bf_lo(x1w[i])) + w2[2 * i] * (bf_lo(c0w[i]) * bf_lo(x0w[i])));
                  const float yhi = bf_hi(bgw[i]) * (w0[2 * i + 1] * (bf_hi(c2w[i]) * bf_hi(x2w[i])) + w1[2 * i + 1] * (bf_hi(c1w[i]) * bf_hi(x1w[i])) + w2[2 * i + 1] * (bf_hi(c0w[i]) * bf_hi(x0w[i])));
                  ow[i] = pk2(ylo, yhi); }
              *(v4u*)(YM + (size_t)row * 2048 + WA + WBW + lane * 8) = (v4u){ow[0], ow[1], ow[2], ow[3]}; }
        }
    }
    {
        constexpr int PITCH = 136;
        LAS bf16* WT = (LAS bf16*)(F.lds + RING_OFF);
        LAS bf16* VT = (LAS bf16*)(F.lds + RING_OFF + 128 * PITCH * 2);
        LAS float* RS = (LAS float*)(F.lds + RING_OFF + 2 * 128 * PITCH * 2);
        const pg8::ssq_t* ssv = (const pg8::ssq_t*)(ws + SS_OFF) + (size_t)(13 + l) * M;
        const float* wsg = ap->in[8] + (size_t)l * 4 * 128 * 128; const float* bsg = ap->in[9] + (size_t)l * 4 * 128; const float* gv = ap->in[7] + (size_t)l * WA;
        const int tid = F.tid, wave = F.wave, fr = lane & 15, fq = lane >> 4;
        for (int unit = blockIdx.x; unit < 512; unit += F.G) {
            const int ch = unit >> 2, g = unit & 3, r0 = ch * 128;
            __syncthreads();
            if (tid < 128) RS[tid] = __builtin_amdgcn_rsqf(pg8::ssq_dec(ssv[r0 + tid]) * (1.0f / WA) + EPS);
            __syncthreads();
            { const int t = tid >> 2, s0 = (tid & 3) * 32; const float* wrow = wsg + ((size_t)g * 128 + t) * 128 + s0;
#pragma unroll
              for (int j = 0; j < 4; ++j) { const f32x4 wa = *(const f32x4*)(wrow + 8 * j), wb = *(const f32x4*)(wrow + 8 * j + 4); const int s = s0 + 8 * j;
                  float e[8] = {wa.x, wa.y, wa.z, wa.w, wb.x, wb.y, wb.z, wb.w};
#pragma unroll
                  for (int i = 0; i < 8; ++i) e[i] = (s + i <= t) ? e[i] * RS[s + i] : 0.f;
                  *(LAS v4u*)(WT + t * PITCH + s) = (v4u){pk2(e[0], e[1]), pk2(e[2], e[3]), pk2(e[4], e[5]), pk2(e[6], e[7])}; } }
            { const int s = tid >> 2, c0 = (tid & 3) * 32; const bf16* vrow = P + (size_t)(r0 + s) * NIN + WA + g * 128 + c0;
#pragma unroll
              for (int j = 0; j < 4; ++j) { const v4u v = *(const v4u*)(vrow + 8 * j); const unsigned vw[4] = {v.x, v.y, v.z, v.w};
#pragma unroll
                  for (int i = 0; i < 4; ++i) { VT[(c0 + 8 * j + 2 * i) * PITCH + s] = (bf16)(vw[i] & 0xffffu); VT[(c0 + 8 * j + 2 * i + 1) * PITCH + s] = (bf16)(vw[i] >> 16); } } }
            __syncthreads();
            f32x4 acc[8];
#pragma unroll
            for (int j = 0; j < 8; ++j) acc[j] = (f32x4){0.f, 0.f, 0.f, 0.f};
#pragma unroll
            for (int kk = 0; kk < 4; ++kk) { const bf16x8 af = *(const LAS bf16x8*)(WT + (16 * wave + fr) * PITCH + kk * 32 + fq * 8);
#pragma unroll
                for (int j = 0; j < 8; ++j) { const bf16x8 bfv = *(const LAS bf16x8*)(VT + (16 * j + fr) * PITCH + kk * 32 + fq * 8);
                    acc[j] = __builtin_amdgcn_mfma_f32_16x16x32_bf16(bfv, af, acc[j], 0, 0, 0); } }
            const int t = 16 * wave + fr; const float bt = bsg[g * 128 + t];
#pragma unroll
            for (int j = 0; j < 8; ++j) { const int c = 16 * j + 4 * fq; const f32x4 gvv = *(const f32x4*)(gv + g * 128 + c);
                const unsigned long long uu = *(const unsigned long long*)(P + (size_t)(r0 + t) * NIN + g * 128 + c); const unsigned ulo = (unsigned)uu, uhi = (unsigned)(uu >> 32);
                const float y0 = bf_lo(ulo) * (acc[j][0] * gvv.x + bt), y1 = bf_hi(ulo) * (acc[j][1] * gvv.y + bt), y2 = bf_lo(uhi) * (acc[j][2] * gvv.z + bt), y3 = bf_hi(uhi) * (acc[j][3] * gvv.w + bt);
                *(unsigned long long*)(YM + (size_t)(r0 + t) * 2048 + g * 128 + c) = (unsigned long long)pk2(y0, y1) | ((unsigned long long)pk2(y2, y3) << 32); }
        }
        __syncthreads();
    }
}

__device__ __forceinline__ void phase_final(Frame& F0) {
    Frame F = F0; asm volatile("" : "+v"(F.tid), "+v"(F.lane));
    const ArgsP ap = get_args();
    const int gw = F.vcu * NWAVES + F.wave, NGW = F.G * NWAVES;
    const bf16* xb = (const bf16*)(ap->ws + WS_XB); const pg8::ssq_t* ss = (const pg8::ssq_t*)(ap->ws + SS_OFF) + (size_t)12 * M; const float* gf = ap->in[18];
    f32x4 g[8];
#pragma unroll
    for (int j = 0; j < 4; ++j) { g[2 * j] = *(const f32x4*)(gf + 8 * F.lane + 512 * j); g[2 * j + 1] = *(const f32x4*)(gf + 8 * F.lane + 512 * j + 4); }
    for (int m = gw; m < M; m += NGW) { const float rs = __builtin_amdgcn_rsqf(pg8::ssq_dec(ss[m]) * (1.0f / DM) + EPS);
        const GAS v4u* xi = (const GAS v4u*)(xb + (size_t)m * DM) + F.lane; GAS f32x4* xo = (GAS f32x4*)(ap->out + (size_t)m * DM) + 2 * F.lane;
#pragma unroll
        for (int j = 0; j < 4; ++j) { const v4u x = xi[64 * j];
            xo[128 * j] = (f32x4){bf_lo(x.x), bf_hi(x.x), bf_lo(x.y), bf_hi(x.y)} * rs * g[2 * j];
            xo[128 * j + 1] = (f32x4){bf_lo(x.z), bf_hi(x.z), bf_lo(x.w), bf_hi(x.w)} * rs * g[2 * j + 1]; } }
}

__global__ void __launch_bounds__(NWAVES * 64, 2) mega_fwd(Args args) {
    extern __shared__ __attribute__((aligned(16))) unsigned char lds[];
    Frame F;
    F.lds = (LAS unsigned char*)lds;
    F.MISC = (volatile LAS unsigned*)(F.lds + MISC_OFF);
    F.tid = threadIdx.x; F.lane = F.tid & 63; F.wave = __builtin_amdgcn_readfirstlane(F.tid >> 6);
    F.G = gridDim.x; { const int bx = blockIdx.x; F.vcu = (F.G % 8 == 0) ? (bx % 8) * (F.G / 8) + bx / 8 : bx; }
    F.ctl = (gu32*)(get_args()->ws + WS_CTL);
    for (int u = F.tid; u < (LDS_BYTES - LDSCTL_OFF) / 4; u += NWAVES * 64) ((LAS unsigned*)(F.lds + LDSCTL_OFF))[u] = 0u;
    __syncthreads();
    XcdBarrier bar = xcd_barrier_post((unsigned*)(F.ctl + CW_BAR), F.MISC + 8);
#define GRID_BAR() xcd_barrier(bar)
#define WSP(T, off) ((T*)(ws + (off)))

#if W_UPFRONT
    for (int l = 0; l < DEPTH; ++l) phase_weights(F, l, l == 0, (size_t)l * WL_STRIDE);
    GRID_BAR();
#endif
    for (int l = 0; l < DEPTH; ++l) {
        const size_t wl = W_UPFRONT ? (size_t)l * WL_STRIDE : 0;
#if !W_UPFRONT
        phase_weights(F, l);
        GRID_BAR();
#endif
        for (int rep_ = 0; rep_ < PROBE_W; ++rep_) { phase_weights(F, l, false, wl); GRID_BAR(); }
        for (int half = 0; half < 2; ++half) {
            for (int rep_ = 0; rep_ < PROBE_BAR; ++rep_) GRID_BAR();
            if (half == 1) {
#ifndef SKIP_GIN
                for (int part = 0; part < 2; ++part) {
                  unsigned char* ws = get_args()->ws; pg8::ssq_t* SS = WSP(pg8::ssq_t, SS_OFF); const bool split = (F.G == 256);
                  pg8::Gemm g{WSP(bf16, WS_XB), (const bf16*)(ws + wl + WS_WIN), M, NIN, DM}; pg8::StaticOrder S; S.init(M, split ? NIN - 512 : NIN, F.G, (int)blockIdx.x);
                  if (part == 1) { S.tail = split ? 1 : 2; S.tail_vcu = F.vcu; S.pn_off = (NIN - 512) / 256; }
                  int rb_ = 0; const LAS float* rt_ = (part == 0) ? fill_rstab(F, SS + (size_t)(3 * l + 1) * M, 1.0f / DM, &rb_) : ((F.G == 256) ? (const LAS float*)(F.lds + RSTAB_OFF) : nullptr); if (part == 1) rb_ = (F.G == 256) ? 2048 * ((int)blockIdx.x & 7) : 0;
                  pg8::EpiProj E{WSP(bf16, WS_ACT), NIN, SS + (size_t)(3 * l + 1) * M, 1.0f / DM, SS + (size_t)(13 + l) * M, attn_body::C2, 4, 8, 2, 4, rt_, rb_, WSP(unsigned, NRM_OFF + (size_t)l * NRM_LAYER_BYTES)};
                  for (int rep_ = 0; rep_ < PROBE_GIN; ++rep_) { pg8::EpiProj E0 = E; E0.v_lo = 0; E0.v_hi = 0; pg8::gemm_phase<pg8::EpiProj, pg8::StaticOrder, true, true>(F.lds + RING_OFF, g, S, E0); GRID_BAR(); }
                  pg8::gemm_phase<pg8::EpiProj, pg8::StaticOrder, true, true>(F.lds + RING_OFF, g, S, E);
                  if (part == 0) GRID_BAR();
                }
#else
                GRID_BAR();
#endif
#ifndef SKIP_ATT
                { unsigned char* ws = get_args()->ws;
                  const attn_body::AttnTensors AT{WSP(const attn_body::bf16, WS_ACT), WSP(attn_body::bf16, WS_OB), WSP(const unsigned, NRM_OFF + (size_t)l * NRM_LAYER_BYTES)};
                  const attn_body::StaticOrder S((int)F.G, (int)blockIdx.x);
                  attn_body::attn_phase<attn_body::StaticOrder>((char*)lds + RING_OFF, AT, S);
                  for (int rep_ = 0; rep_ < PROBE_ATT; ++rep_) { GRID_BAR(); attn_body::attn_phase<attn_body::StaticOrder>((char*)lds + RING_OFF, AT, S); } }
#endif
                GRID_BAR();
#ifndef SKIP_MIX
                phase_mixer_post(F, l);
#endif
                GRID_BAR();
                for (int rep_ = 0; rep_ < PROBE_MIX; ++rep_) { phase_mixer_post(F, l); GRID_BAR(); }
#ifndef SKIP_GOUT
                { unsigned char* ws = get_args()->ws; pg8::ssq_t* SS = WSP(pg8::ssq_t, SS_OFF);
                  pg8::Gemm g{WSP(bf16, WS_YM), (const bf16*)(ws + wl + WS_WOUT), M, DM, DM}; pg8::StaticOrder S; S.init(M, DM, F.G, (int)blockIdx.x);
                  pg8::EpiResid E{nullptr, WSP(bf16, WS_XB), SS + (size_t)(3 * l + 2) * M, 1.0f, DM, 1};
                  for (int rep_ = 0; rep_ < PROBE_GOUT; ++rep_) { pg8::EpiResid E0 = E; E0.alpha = 0.f; E0.do_ss = 0; pg8::gemm_phase<pg8::EpiResid, pg8::StaticOrder, true, true>(F.lds + RING_OFF, g, S, E0); GRID_BAR(); }
                  pg8::gemm_phase<pg8::EpiResid, pg8::StaticOrder, true, true>(F.lds + RING_OFF, g, S, E); }
#endif
                GRID_BAR();
            }
#ifndef SKIP_GGU
            { unsigned char* ws = get_args()->ws; pg8::ssq_t* SS = WSP(pg8::ssq_t, SS_OFF);
              pg8::Gemm g{WSP(bf16, WS_XB), (const bf16*)(ws + wl + (half ? WS_WGU2 : WS_WGU1)), M, 2 * FF, DM}; pg8::StaticOrder S; S.init(M, 2 * FF, F.G, (int)blockIdx.x);
              int rb_ = 0; const LAS float* rt_ = fill_rstab(F, SS + (size_t)(3 * l + 2 * half) * M, 1.0f / DM, &rb_);
              pg8::EpiSwiGLU E{WSP(bf16, WS_ACT), FF, SS + (size_t)(3 * l + 2 * half) * M, 1.0f / DM, rt_, rb_};
#if PROBE_SPLIT
              S.i_hi = 6; pg8::gemm_phase<pg8::EpiSwiGLU, pg8::StaticOrder, true, true>(F.lds + RING_OFF, g, S, E); GRID_BAR(); S.i_lo = 6; S.i_hi = 1 << 30;
#endif
              pg8::gemm_phase<pg8::EpiSwiGLU, pg8::StaticOrder, true, true>(F.lds + RING_OFF, g, S, E);
              for (int rep_ = 0; rep_ < PROBE_GGU; ++rep_) { GRID_BAR(); pg8::gemm_phase<pg8::EpiSwiGLU, pg8::StaticOrder, true, true>(F.lds + RING_OFF, g, S, E); } }
#endif
            GRID_BAR();
#ifndef SKIP_GDN
            { const ArgsP ap = get_args(); unsigned char* ws = ap->ws; pg8::ssq_t* SS = WSP(pg8::ssq_t, SS_OFF);
              pg8::Gemm g{WSP(bf16, WS_ACT), (const bf16*)(ws + wl + (half ? WS_WD2 : WS_WD1)), M, DM, FF}; pg8::StaticOrder S; S.init(M, DM, F.G, (int)blockIdx.x);
              pg8::EpiResid E{(l == 0 && half == 0) ? ap->in[0] : (const float*)nullptr, WSP(bf16, WS_XB), SS + (size_t)(3 * l + 2 * half + 1) * M, 0.5f, DM, 1};
              for (int rep_ = 0; rep_ < PROBE_GDN; ++rep_) { pg8::EpiResid E0 = E; E0.alpha = 0.f; E0.do_ss = 0; pg8::gemm_phase<pg8::EpiResid, pg8::StaticOrder, true, true>(F.lds + RING_OFF, g, S, E0); GRID_BAR(); }
              pg8::gemm_phase<pg8::EpiResid, pg8::StaticOrder, true, true>(F.lds + RING_OFF, g, S, E); }
#endif
            GRID_BAR();
        }
    }
#ifndef SKIP_FIN
    phase_final(F);
#endif
}

extern "C" void kernel_launch(void* const* d_in, const int* in_sizes, int n_in, void* d_out, int out_size, void* d_ws, size_t ws_size, hipStream_t stream) {
    static int grid = 0;
    if (grid == 0) {
        if (n_in != 19 || in_sizes[0] != M * DM || out_size != M * DM || ws_size < WS_END) { fprintf(stderr, "kernel_launch: unexpected shapes / workspace (%zu < %zu)\n", ws_size, (size_t)WS_END); grid = -1; return; }
        int dev = 0, cus = 0, per_cu = 0;
        if (hipGetDevice(&dev) != hipSuccess || hipDeviceGetAttribute(&cus, hipDeviceAttributeMultiprocessorCount, dev) != hipSuccess) { grid = -1; return; }
        if (hipFuncSetAttribute((const void*)mega_fwd, hipFuncAttributeMaxDynamicSharedMemorySize, LDS_BYTES) != hipSuccess) { grid = -1; return; }
        if (hipOccupancyMaxActiveBlocksPerMultiprocessor(&per_cu, (const void*)mega_fwd, NWAVES * 64, LDS_BYTES) != hipSuccess || per_cu < 1) { fprintf(stderr, "kernel_launch: occupancy query says %d\n", per_cu); }
        (void)hipGetLastError();
        grid = cus;
    }
    if (grid < 0) return;
    if (hipMemsetAsync((char*)d_ws + WS_CTL, 0, CTL_ZERO_BYTES, stream) != hipSuccess) return;
    Args a{};
    for (int i = 0; i < 19; ++i) a.in[i] = (const float*)d_in[i];
    a.out = (float*)d_out; a.ws = (unsigned char*)d_ws;
    hipLaunchKernelGGL(mega_fwd, dim3(grid), dim3(NWAVES * 64), LDS_BYTES, stream, a);
}
```
